# Optimizing an MI355X kernel written in HIP

```python
import jax, jax.numpy as jnp
from jax import lax
import numpy as np

D_MODEL = 1024
BATCH = 16
SEQ = 2048
DEPTH = 1

CTX_LEN = 256
GRID_W = 64
D_MIX = 2 * D_MODEL
D_SSD = D_MIX // 2
D_SC = D_MIX - D_SSD
SSD_HEAD_DIM = 64
SSD_HEADS = D_SSD // SSD_HEAD_DIM
SSD_GROUPS = 2
SSD_STATE = 128
SSD_CONV = 3
SSD_CHUNK = 128
SC_CONV = 3
SC_GROUPS = D_SC // 64
N_EXPERTS = 32
TOP_K = 4
D_FF = D_MODEL
SWIGLU_LIMIT = 7.0
SWIGLU_ALPHA = 1.702
MOE_BLOCK = 256
NORM_EPS = 1e-6
N_MOD = 6

Z0 = 0
X0 = Z0 + D_SSD
B0 = X0 + D_SSD
C0 = B0 + SSD_GROUPS * SSD_STATE
DT0 = C0 + SSD_GROUPS * SSD_STATE
SC0 = DT0 + 2 * SSD_HEADS
IN_W = SC0 + 3 * D_SC
XBC_W = DT0 - X0

kernel_name = "hybrid_ssd_shortconv_moe_dit_layer"


def rmsnorm(x, g):
    xf = x.astype(jnp.float32)
    y = xf * lax.rsqrt(jnp.mean(xf * xf, axis=-1, keepdims=True) + NORM_EPS)
    return (y * g.astype(jnp.float32)).astype(x.dtype)


def group_rmsnorm(x, g, groups):
    shp = x.shape
    xf = x.astype(jnp.float32).reshape(*shp[:-1], groups, shp[-1] // groups)
    y = xf * lax.rsqrt(jnp.mean(xf * xf, axis=-1, keepdims=True) + NORM_EPS)
    return (y.reshape(shp) * g.astype(jnp.float32)).astype(x.dtype)


def modulate(h, shift, scale):
    return h * (1 + scale) + shift


def flip(t):
    return t[:, ::-1]


def conv_seq(u, w):
    k_w = w.shape[0]
    pad = k_w // 2
    l = u.shape[1]
    up = jnp.pad(u, ((0, 0), (pad, pad), (0, 0)))
    return sum(up[:, k:k + l] * w[k] for k in range(k_w))


def conv_grid_cols(u, w):
    b, l, ch = u.shape
    rows = l // GRID_W
    k_w = w.shape[0]
    pad = k_w // 2
    ug = jnp.pad(u.reshape(b, rows, GRID_W, ch), ((0, 0), (pad, pad), (0, 0), (0, 0)))
    out = sum(ug[:, k:k + rows] * w[k] for k in range(k_w))
    return out.reshape(b, l, ch)


def ssd_decays(dt_raw, dt_bias, a_log):
    b, l, _ = dt_raw.shape
    dt = jax.nn.softplus(dt_raw.astype(jnp.float32).reshape(b, l, 2, SSD_HEADS) + dt_bias.astype(jnp.float32))
    a = -jnp.exp(a_log.astype(jnp.float32))
    return dt[:, :, 0], dt[:, :, 1], a[0], a[1]


def ssd_chunked(xs, dt, a, bm, cm, h0):
    b, l, h, p = xs.shape
    g, n = bm.shape[2], bm.shape[3]
    r = h // g
    nc = l // SSD_CHUNK
    q = SSD_CHUNK
    xdt = (xs.astype(jnp.float32) * dt[..., None]).reshape(b, nc, q, g, r, p)
    acs = jnp.cumsum((dt * a).reshape(b, nc, q, g, r), axis=2)
    bc = bm.astype(jnp.float32).reshape(b, nc, q, g, n)
    cc = cm.astype(jnp.float32).reshape(b, nc, q, g, n)
    seg = acs[:, :, :, None] - acs[:, :, None, :]
    lower = jnp.tril(jnp.ones((q, q), dtype=bool))[:, :, None, None]
    decay_ij = jnp.exp(jnp.where(lower, seg, -jnp.inf))
    cb = jnp.einsum('bcign,bcjgn->bcijg', cc, bc)
    y_diag = jnp.einsum('bcijg,bcijgr,bcjgrp->bcigrp', cb, decay_ij, xdt)
    decay_to_end = jnp.exp(acs[:, :, -1:] - acs)
    states = jnp.einsum('bcqgn,bcqgr,bcqgrp->bcgrpn', bc, decay_to_end, xdt)
    chunk_decay = jnp.exp(acs[:, :, -1])

    def step(hc, inp):
        dec, st = inp
        return hc * dec[..., None, None] + st, hc

    h_final, starts = lax.scan(step, h0.astype(jnp.float32).reshape(b, g, r, p, n),
                               (jnp.moveaxis(chunk_decay, 1, 0), jnp.moveaxis(states, 1, 0)))
    starts = jnp.moveaxis(starts, 0, 1)
    y_off = jnp.einsum('bcign,bcgrpn,bcigr->bcigrp', cc, starts, jnp.exp(acs))
    y = (y_diag + y_off).reshape(b, l, h, p).astype(xs.dtype)
    return y, h_final.reshape(b, h, p, n)


def ssd_final_state(xs, dt, a, bm):
    b, l, h, p = xs.shape
    g, n = bm.shape[2], bm.shape[3]
    r = h // g
    acs = jnp.cumsum(dt * a, axis=1)
    w = (jnp.exp(acs[:, -1:] - acs) * dt).reshape(b, l, g, r)
    st = jnp.einsum('blgn,blgr,blgrp->bgrpn', bm.astype(jnp.float32), w,
                    xs.astype(jnp.float32).reshape(b, l, g, r, p))
    return st.reshape(b, h, p, n)


def ssd_bidir(xs, bm, cm, dt_f, dt_b, a_f, a_b, d_skip, h0_f, h0_b):
    y_f, hf = ssd_chunked(xs, dt_f, a_f, bm, cm, h0_f)
    y_b, hb = ssd_chunked(flip(xs), flip(dt_b), a_b, flip(bm), flip(cm), h0_b)
    y = y_f + flip(y_b) + d_skip[:, None].astype(xs.dtype) * xs
    return y, hf, hb


def token_mixers(h, w_in, ssd_conv_w, ssd_conv_b, dt_bias, a_log, d_skip, ssd_norm_g, sc_conv_w, w_out,
                 sc_conv, h0_f, h0_b):
    b, l, _ = h.shape
    proj = h @ w_in
    z = proj[..., Z0:X0]
    xbc = jax.nn.silu(conv_seq(proj[..., X0:DT0], ssd_conv_w) + ssd_conv_b)
    xs = xbc[..., :B0 - X0].reshape(b, l, SSD_HEADS, SSD_HEAD_DIM)
    bm = xbc[..., B0 - X0:C0 - X0].reshape(b, l, SSD_GROUPS, SSD_STATE)
    cm = xbc[..., C0 - X0:].reshape(b, l, SSD_GROUPS, SSD_STATE)
    dt_f, dt_b, a_f, a_b = ssd_decays(proj[..., DT0:SC0], dt_bias, a_log)
    y, hf, hb = ssd_bidir(xs, bm, cm, dt_f, dt_b, a_f, a_b, d_skip, h0_f, h0_b)
    y_ssd = group_rmsnorm(y.reshape(b, l, D_SSD) * jax.nn.silu(z), ssd_norm_g, SSD_GROUPS)
    sc_b = proj[..., SC0:SC0 + D_SC]
    sc_c = proj[..., SC0 + D_SC:SC0 + 2 * D_SC]
    sc_u = proj[..., SC0 + 2 * D_SC:]
    y_sc = sc_b * sc_conv(sc_c * sc_u, sc_conv_w)
    out = jnp.concatenate([y_ssd, y_sc], axis=-1) @ w_out
    return out, hf, hb


def context_ssd_states(hc, w_in, ssd_conv_w, ssd_conv_b, dt_bias, a_log):
    b, l, _ = hc.shape
    xb = jax.nn.silu(conv_seq(hc @ w_in[:, X0:C0], ssd_conv_w[:, :C0 - X0]) + ssd_conv_b[:C0 - X0])
    xs = xb[..., :B0 - X0].reshape(b, l, SSD_HEADS, SSD_HEAD_DIM)
    bm = xb[..., B0 - X0:].reshape(b, l, SSD_GROUPS, SSD_STATE)
    dt_f, dt_b, a_f, a_b = ssd_decays(hc @ w_in[:, DT0:SC0], dt_bias, a_log)
    h_f = ssd_final_state(xs, dt_f, a_f, bm)
    h_b = ssd_final_state(flip(xs), flip(dt_b), a_b, flip(bm))
    return h_f, h_b


def moe(h, w_router, b_router, w_gate_up, b_gate_up, w_down, b_down):
    shp = h.shape
    d = shp[-1]
    t = h.reshape(-1, d)
    n_tok = t.shape[0]
    n_assign = n_tok * TOP_K
    logits = (t @ w_router + b_router).astype(jnp.float32)
    top_logits, top_idx = lax.top_k(logits, TOP_K)
    gates = jax.nn.softmax(top_logits, axis=-1).astype(h.dtype)
    expert = top_idx.reshape(-1).astype(jnp.int32)
    order = jnp.argsort(expert)
    expert_sorted = expert[order]
    counts = jnp.bincount(expert, length=N_EXPERTS).astype(jnp.int32)
    padded = (counts + MOE_BLOCK - 1) // MOE_BLOCK * MOE_BLOCK
    group_start = jnp.cumsum(counts) - counts
    pad_end = jnp.cumsum(padded)
    pad_start = pad_end - padded
    dest_sorted = (pad_start[expert_sorted] + jnp.arange(n_assign, dtype=jnp.int32)
                   - group_start[expert_sorted]).astype(jnp.int32)
    dest = jnp.zeros((n_assign,), jnp.int32).at[order].set(dest_sorted)
    n_blocks = -(-n_assign // MOE_BLOCK) + N_EXPERTS
    row_token = jnp.full((n_blocks * MOE_BLOCK,), n_tok, jnp.int32).at[dest].set(
        jnp.arange(n_assign, dtype=jnp.int32) // TOP_K)
    t_ext = jnp.concatenate([t, jnp.zeros((1, d), t.dtype)], axis=0)
    blocks = t_ext[row_token].reshape(n_blocks, MOE_BLOCK, d)
    block_expert = jnp.minimum(
        jnp.searchsorted(pad_end, jnp.arange(n_blocks, dtype=jnp.int32) * MOE_BLOCK, side='right'),
        N_EXPERTS - 1)

    def expert_block(args):
        xb, e = args
        gu = xb @ w_gate_up[e] + b_gate_up[e]
        glu = jnp.minimum(gu[:, :D_FF], SWIGLU_LIMIT)
        lin = jnp.clip(gu[:, D_FF:], -SWIGLU_LIMIT, SWIGLU_LIMIT)
        act = glu * jax.nn.sigmoid(SWIGLU_ALPHA * glu) * (lin + 1)
        return act @ w_down[e] + b_down[e]

    y_rows = lax.map(expert_block, (blocks, block_expert)).reshape(-1, d)
    y = y_rows[dest].reshape(n_tok, TOP_K, d)
    return jnp.einsum('tk,tkd->td', gates, y).reshape(shp)


def setup_inputs(seed: int = 0) -> dict:
    key = jax.random.key(seed)
    ks = jax.random.split(key, 26)

    def nrm(k, shape, scale):
        return jax.random.normal(k, shape, jnp.float32) * scale

    dt0 = jnp.exp(jax.random.uniform(ks[10], (DEPTH, 2, SSD_HEADS), jnp.float32,
                                     minval=float(np.log(1e-3)), maxval=float(np.log(1e-1))))
    dt_bias = dt0 + jnp.log(-jnp.expm1(-dt0))
    a_log = jnp.log(jax.random.uniform(ks[11], (DEPTH, 2, SSD_HEADS), jnp.float32, minval=1.0, maxval=16.0))
    return {
        "x": nrm(ks[0], (BATCH, SEQ, D_MODEL), 1.0),
        "c": nrm(ks[1], (BATCH, D_MODEL), 1.0),
        "ctx": nrm(ks[2], (BATCH, CTX_LEN, D_MODEL), 1.0),
        "c_ctx": nrm(ks[3], (D_MODEL,), 1.0),
        "w_mod": nrm(ks[4], (DEPTH, D_MODEL, N_MOD * D_MODEL), 0.5 * D_MODEL ** -0.5),
        "b_mod": nrm(ks[5], (DEPTH, N_MOD * D_MODEL), 0.02),
        "norm1_g": 1.0 + nrm(ks[6], (DEPTH, D_MODEL), 0.02),
        "w_in": nrm(ks[7], (DEPTH, D_MODEL, IN_W), D_MODEL ** -0.5),
        "ssd_conv_w": nrm(ks[8], (DEPTH, SSD_CONV, XBC_W), SSD_CONV ** -0.5),
        "ssd_conv_b": nrm(ks[9], (DEPTH, XBC_W), 0.02),
        "ssd_dt_bias": dt_bias,
        "ssd_a_log": a_log,
        "ssd_d": 1.0 + nrm(ks[12], (DEPTH, SSD_HEADS), 0.1),
        "ssd_norm_g": 1.0 + nrm(ks[13], (DEPTH, D_SSD), 0.02),
        "sc_conv_w": nrm(ks[14], (DEPTH, SC_CONV, D_SC), SC_CONV ** -0.5),
        "w_out": nrm(ks[15], (DEPTH, D_MIX, D_MODEL), D_MIX ** -0.5),
        "norm2_g": 1.0 + nrm(ks[16], (DEPTH, D_MODEL), 0.02),
        "w_router": nrm(ks[17], (DEPTH, D_MODEL, N_EXPERTS), D_MODEL ** -0.5),
        "b_router": nrm(ks[18], (DEPTH, N_EXPERTS), 0.01),
        "w_gate_up": nrm(ks[19], (DEPTH, N_EXPERTS, D_MODEL, 2 * D_FF), D_MODEL ** -0.5),
        "b_gate_up": nrm(ks[20], (DEPTH, N_EXPERTS, 2 * D_FF), 0.02),
        "w_down": nrm(ks[21], (DEPTH, N_EXPERTS, D_FF, D_MODEL), D_FF ** -0.5),
        "b_down": nrm(ks[22], (DEPTH, N_EXPERTS, D_MODEL), 0.02),
        "final_g": 1.0 + nrm(ks[23], (D_MODEL,), 0.02),
    }


def reference(x, c, ctx, c_ctx, w_mod, b_mod, norm1_g, w_in, ssd_conv_w, ssd_conv_b, ssd_dt_bias, ssd_a_log,
              ssd_d, ssd_norm_g, sc_conv_w, w_out, norm2_g, w_router, b_router, w_gate_up, b_gate_up, w_down,
              b_down, final_g):
    b = x.shape[0]
    ctx_s = ctx
    for i in range(DEPTH):
        mod_x = (jax.nn.silu(c) @ w_mod[i] + b_mod[i]).reshape(b, N_MOD, 1, D_MODEL)
        mod_c = (jax.nn.silu(c_ctx) @ w_mod[i] + b_mod[i]).reshape(N_MOD, 1, 1, D_MODEL)
        mix_w = (w_in[i], ssd_conv_w[i], ssd_conv_b[i], ssd_dt_bias[i], ssd_a_log[i], ssd_d[i],
                 ssd_norm_g[i], sc_conv_w[i], w_out[i])
        moe_w = (w_router[i], b_router[i], w_gate_up[i], b_gate_up[i], w_down[i], b_down[i])
        hc = modulate(rmsnorm(ctx_s, norm1_g[i]), mod_c[0], mod_c[1])
        if i == DEPTH - 1:
            h0_f, h0_b = context_ssd_states(hc, w_in[i], ssd_conv_w[i], ssd_conv_b[i],
                                            ssd_dt_bias[i], ssd_a_log[i])
        else:
            zero = jnp.zeros((ctx_s.shape[0], SSD_HEADS, SSD_HEAD_DIM, SSD_STATE), jnp.float32)
            oc, h0_f, h0_b = token_mixers(hc, *mix_w, conv_seq, zero, zero)
            ctx_s = ctx_s + mod_c[2] * oc
            ctx_s = ctx_s + mod_c[5] * moe(modulate(rmsnorm(ctx_s, norm2_g[i]), mod_c[3], mod_c[4]), *moe_w)
        hx = modulate(rmsnorm(x, norm1_g[i]), mod_x[:, 0], mod_x[:, 1])
        ox, _, _ = token_mixers(hx, *mix_w, conv_grid_cols, h0_f, h0_b)
        x = x + mod_x[:, 2] * ox
        x = x + mod_x[:, 5] * moe(modulate(rmsnorm(x, norm2_g[i]), mod_x[:, 3], mod_x[:, 4]), *moe_w)
    return rmsnorm(x, final_g)
```

```cpp
#include <hip/hip_runtime.h>
#include <cstdio>
#include <cstdint>

#ifndef MK_ONE_LAUNCH
#define MK_ONE_LAUNCH 0
#endif

#define LAS __attribute__((address_space(3)))
#define GAS __attribute__((address_space(1)))
typedef unsigned short bf16;
typedef short bf16x8 __attribute__((ext_vector_type(8)));
typedef float f32x4 __attribute__((ext_vector_type(4)));
typedef float f32x2 __attribute__((ext_vector_type(2)));
typedef unsigned u32x4 __attribute__((ext_vector_type(4)));
typedef unsigned u32x2 __attribute__((ext_vector_type(2)));
typedef GAS unsigned gu32;

constexpr int D = 1024, NB = 16, SEQ = 2048, CTXL = 256;
constexpr int TL = NB * SEQ;
constexpr int TC = NB * CTXL;
constexpr int TT = TL + TC;
constexpr int IN_W = 5664, X0 = 1024, B0 = 2048, C0 = 2304, DT0 = 2560, SC0 = 2592;
constexpr int NE = 32, TOPK = 4, DFF = 1024;
constexpr int XBCW = 1536;
constexpr int NT_IN = 23;
constexpr int CAP = TL;
constexpr int ACT_ROWS = TL * TOPK + NE * 256;
constexpr float NORM_EPS = 1e-6f;

constexpr size_t MiB = 1u << 20;
constexpr size_t WS_CTL = 0, CTL_ZERO_BYTES = 1 * MiB;
constexpr size_t WS_MOD = 1 * MiB;
constexpr size_t WS_TOKES = 2 * MiB;
constexpr size_t WS_TOKG = 2 * MiB + 512 * 1024;
constexpr size_t WS_ROWTOK = 3 * MiB;
constexpr size_t WS_WIN = 7 * MiB;
constexpr size_t WS_WOUT = 19 * MiB;
constexpr size_t WS_WGU = 23 * MiB;
constexpr size_t WS_WDN = 151 * MiB;
constexpr size_t WS_HX = 215 * MiB;
constexpr size_t WS_XRAW = 287 * MiB;
constexpr size_t WS_XBC = 395 * MiB;
constexpr size_t WS_DT = 503 * MiB;
constexpr size_t WS_SZ = 508 * MiB;
constexpr size_t WS_SCB = 572 * MiB;
constexpr size_t WS_CU = 636 * MiB;
constexpr size_t WS_YF = 700 * MiB;
constexpr size_t WS_YB = 764 * MiB;
constexpr size_t WS_A2 = 828 * MiB;
constexpr size_t WS_ACT = 287 * MiB;
constexpr size_t WS_YROWS = 572 * MiB;
constexpr size_t WS_END = 956 * MiB;
constexpr int CW_ECNT = 64;
constexpr int CW_BAR = 4096;

constexpr int LDS_BYTES = 147456;
constexpr int CTLDS_OFF = 146432;
constexpr int LW_BARST = 0;
constexpr int LW_MTS = 16;
constexpr int LW_CNT = 64;

constexpr int NWAVES = 8;

#define LDS_WAIT() asm volatile("s_waitcnt lgkmcnt(0)" ::: "memory")
#define VM_WAIT() asm volatile("s_waitcnt vmcnt(0)" ::: "memory")
#define RLX_AGENT __ATOMIC_RELAXED, __HIP_MEMORY_SCOPE_AGENT

__device__ __forceinline__ unsigned f2bf(float f) { unsigned u = __builtin_bit_cast(unsigned, f); return (u + 0x7fffu + ((u >> 16) & 1u)) >> 16; }
__device__ __forceinline__ unsigned pk2(float lo, float hi) { return f2bf(lo) | (f2bf(hi) << 16); }
__device__ __forceinline__ float bf2f(unsigned b) { return __builtin_bit_cast(float, b << 16); }
__device__ __forceinline__ float bflo(unsigned w) { return __builtin_bit_cast(float, w << 16); }
__device__ __forceinline__ float bfhi(unsigned w) { return __builtin_bit_cast(float, w & 0xffff0000u); }
__device__ __forceinline__ float fsilu(float x) { return x * __builtin_amdgcn_rcpf(1.0f + __expf(-x)); }
__device__ __forceinline__ float wave_sum(float v) {
#pragma unroll
    for (int o = 1; o < 64; o <<= 1) v += __shfl_xor(v, o);
    return v;
}

#define XB_TMO      128
#define XB_XCNT(j)  (256  + 64 * (j))
#define XB_XSUB(j)  (1280 + 64 * (j))
#define XB_XGEN(j)  (2304 + 64 * (j))
#define XB_TOP      3328
#define XB_TOPGEN   3392
#define XCD_BAR_WORDS 3456
#define XB_SPIN_CAP (1u << 18)
__device__ __forceinline__ unsigned xb_ld(unsigned* p)              { return __hip_atomic_load(p, __ATOMIC_RELAXED, __HIP_MEMORY_SCOPE_AGENT); }
__device__ __forceinline__ unsigned xb_add(unsigned* p, unsigned v) { return __hip_atomic_fetch_add(p, v, __ATOMIC_RELAXED, __HIP_MEMORY_SCOPE_AGENT); }
__device__ __forceinline__ unsigned xb_xcc_id() { return (unsigned)__builtin_amdgcn_s_getreg((3 << 11) | 20) & 0xFu; }
#define XB_SPIN(cond, bar) do { unsigned _sp = 0; while (cond) { __builtin_amdgcn_s_sleep(1); \
    if ((++_sp & 255u) == 0u) { if (xb_ld(&(bar)[XB_TMO])) break; if (_sp > XB_SPIN_CAP) { atomicAdd(&(bar)[XB_TMO], 1u); break; } } } } while (0)
struct XcdBarrier { unsigned* bar; unsigned x; volatile LAS unsigned* st; };
__device__ __forceinline__ XcdBarrier xcd_barrier_post(unsigned* bar, volatile LAS unsigned* st) {
    XcdBarrier b; b.bar = bar; b.x = xb_xcc_id(); b.st = st;
    if (threadIdx.x == 0) (void)xb_add(&bar[XB_XCNT(b.x)], 1u);
    return b;
}
__device__ __forceinline__ void xcd_barrier_complete(unsigned* bar, unsigned x, unsigned& nloc, unsigned& nx) {
    const unsigned G = gridDim.x * gridDim.y * gridDim.z;
    unsigned sum, cnt, mine, sp = 0u;
    for (;;) {
        sum = 0u; cnt = 0u; mine = 0u;
#pragma unroll
        for (unsigned j = 0; j < 16; ++j) { const unsigned c = xb_ld(&bar[XB_XCNT(j)]); sum += c; cnt += (c > 0u) ? 1u : 0u; mine = (j == x) ? c : mine; }
        if (sum == G) break;
        __builtin_amdgcn_s_sleep(1);
        if ((++sp & 255u) == 0u) { if (xb_ld(&bar[XB_TMO])) break; if (sp > XB_SPIN_CAP) { atomicAdd(&bar[XB_TMO], 1u); break; } }
    }
    nloc = mine > 0u ? mine : 1u; nx = cnt > 0u ? cnt : 1u;
}
__device__ __forceinline__ void xcd_barrier(const XcdBarrier& b) {
    asm volatile("s_waitcnt vmcnt(0)" ::: "memory");
    __syncthreads();
    if (threadIdx.x == 0) {
        unsigned* bar = b.bar;
        __builtin_amdgcn_s_waitcnt(0);
        unsigned nloc = b.st[0], nx = b.st[1];
        if (nloc == 0u) { xcd_barrier_complete(bar, b.x, nloc, nx); b.st[0] = nloc; b.st[1] = nx; }
        const unsigned old = xb_add(&bar[XB_XSUB(b.x)], 1u);
        const unsigned gen = old / nloc;
        if (old + 1u == (gen + 1u) * nloc) {
            __builtin_amdgcn_fence(__ATOMIC_RELEASE, "agent");
            asm volatile("s_waitcnt vmcnt(0)" ::: "memory");
            const unsigned og = xb_add(&bar[XB_TOP], 1u);
            const unsigned tg = og / nx;
            if (og + 1u == (tg + 1u) * nx) xb_add(&bar[XB_TOPGEN], 1u);
            else XB_SPIN(xb_ld(&bar[XB_TOPGEN]) == tg, bar);
            __builtin_amdgcn_fence(__ATOMIC_ACQUIRE, "agent");
            xb_add(&bar[XB_XGEN(b.x)], 1u);
            asm volatile("s_waitcnt vmcnt(0)" ::: "memory");
        } else {
            XB_SPIN(xb_ld(&bar[XB_XGEN(b.x)]) == gen, bar);
            __builtin_amdgcn_fence(__ATOMIC_ACQUIRE, "agent");
            asm volatile("s_waitcnt vmcnt(0)" ::: "memory");
        }
    }
    __syncthreads();
}

struct Args { const float* in[24]; float* out; unsigned char* ws; int ph_lo, ph_hi; };
struct Frame {
    LAS unsigned char* lds;
    volatile LAS unsigned* cl;
    unsigned char* ws;
    gu32* ctl;
    int tid, lane, wave, vcu, G;
    const float *x, *c, *ctx, *c_ctx, *w_mod, *b_mod, *norm1_g, *w_in, *conv_w, *conv_b, *dt_bias, *a_log, *ssd_d, *ssd_norm_g, *sc_conv_w, *w_out, *norm2_g, *w_router, *b_router, *w_gu, *b_gu, *w_dn, *b_dn, *final_g;
    float* out;
};

namespace pg8 {
constexpr int BM = 256, BK = 64, HALF = 128, HTB = HALF * BK * 2, STAGE_BYTES = 8 * HTB;
__device__ __forceinline__ int lds_byte(int r, int c) { const int st = (r >> 4) * 2 + (c >> 5), rr = r & 15, cc = c & 31, ob = rr * 64 + cc * 2; return st * 1024 + (ob ^ (((ob >> 9) & 1) << 5)); }
__device__ __forceinline__ void stage_rc(int b, int& R, int& C) { const int st = b / 1024, sb = b % 1024, swz = sb ^ (((sb >> 9) & 1) << 5); R = (st >> 1) * 16 + swz / 64; C = (st & 1) * 32 + (swz % 64) / 2; }
__device__ __forceinline__ int perm32(int rho) { const int n = rho >> 4, i = rho & 15; return 8 * (i >> 2) + 4 * n + (i & 3); }
__device__ __forceinline__ unsigned cvt_pk_bf16(float lo, float hi) { unsigned r; asm volatile("v_cvt_pk_bf16_f32 %0, %1, %2" : "=v"(r) : "v"(lo), "v"(hi)); return r; }

struct Unit { int pm, pn, e; };

template <class Epi, class Sched>
__device__ __forceinline__ void gemm_phase(LAS unsigned char* lds, const bf16* Aptr, const int K, const Sched& S, const Epi& E) {
    const int tid = threadIdx.x, wid = __builtin_amdgcn_readfirstlane(tid >> 6), lane = tid & 63, wr = wid >> 2, wc = wid & 3, fr = lane & 15, fq = lane >> 4;
    const int nt = K / BK;
    int sR[2], sC[2];
    unsigned voffB[2];
#pragma unroll
    for (int i = 0; i < 2; ++i) { int R, C; stage_rc(tid * 16 + i * 8192, R, C); const int Rb = Epi::PERM ? ((R & ~31) + perm32(R & 31)) : R;
        sR[i] = R; sC[i] = C; voffB[i] = (unsigned)(Rb * K + C) * 2u; }
    const size_t kstep = (size_t)(BK * 2);
    const size_t hstep = (size_t)HALF * K * 2;
    const unsigned ldsw = (unsigned)wid * 1024u;
    const int aoff = lds_byte(wr * 64 + fr, fq * 8), boff = lds_byte(wc * 32 + fr, fq * 8);
    const char* const Abase = (const char*)Aptr;
#define PG8_SA(b, h) (((b) * 2 + (h)) * HTB)
#define PG8_SB(b, h) ((4 + (b) * 2 + (h)) * HTB)
#define PG8_STAGE(bufoff, gbase, voff) do { _Pragma("unroll") for (int _i = 0; _i < 2; ++_i) \
        __builtin_amdgcn_global_load_lds((const unsigned*)((const char*)(gbase) + (voff)[_i]), (LAS unsigned*)(lds + (bufoff) + ldsw + _i * 8192), 16, 0, 0); } while (0)
#define PG8_LDA(dst, b, h) do { _Pragma("unroll") for (int m = 0; m < 4; ++m) _Pragma("unroll") for (int k = 0; k < 2; ++k) dst[m][k] = *(const LAS bf16x8*)(lds + PG8_SA(b, h) + aoff + m * 2048 + k * 1024); } while (0)
#define PG8_LDB(dst, b, h) do { _Pragma("unroll") for (int n = 0; n < 2; ++n) _Pragma("unroll") for (int k = 0; k < 2; ++k) dst[n][k] = *(const LAS bf16x8*)(lds + PG8_SB(b, h) + boff + n * 2048 + k * 1024); } while (0)
#define PG8_MMA(ai, bj, At, Bt) do { __builtin_amdgcn_s_setprio(1); _Pragma("unroll") for (int m = 0; m < 4; ++m) _Pragma("unroll") for (int n = 0; n < 2; ++n) _Pragma("unroll") for (int k = 0; k < 2; ++k) \
        acc[ai][bj][m][n] = __builtin_amdgcn_mfma_f32_16x16x32_bf16(Bt[n][k], At[m][k], acc[ai][bj][m][n], 0, 0, 0); __builtin_amdgcn_s_setprio(0); } while (0)
#define PG8_WAIT_V(n) asm volatile("s_waitcnt vmcnt(" #n ")" ::: "memory")
#define PG8_WAIT_L(n) asm volatile("s_waitcnt lgkmcnt(" #n ")" ::: "memory")
#define PG8_BAR __builtin_amdgcn_s_barrier()
#define PG8_SCHED __builtin_amdgcn_sched_barrier(0)
    Unit cur, nxt; int ui = 0;
    if (!S.next(0, cur)) return;
    f32x4 acc[2][2][4][2];
#pragma unroll
    for (int a = 0; a < 2; ++a)
#pragma unroll
        for (int b = 0; b < 2; ++b)
#pragma unroll
            for (int m = 0; m < 4; ++m)
#pragma unroll
                for (int n = 0; n < 2; ++n) acc[a][b][m][n] = (f32x4){0.f, 0.f, 0.f, 0.f};
    bf16x8 At[4][2], B0[2][2], B1[2][2];
    unsigned va0[2], va1[2];
    S.aoff(cur, sR, sC, va0, va1);
    if (Sched::GATHER) { asm volatile("s_waitcnt vmcnt(0)" ::: "memory"); asm volatile("" : "+v"(va0[0]), "+v"(va0[1]), "+v"(va1[0]), "+v"(va1[1])); }
    const char* cB = S.bbase(cur);
    PG8_STAGE(PG8_SB(0, 0), cB, voffB); PG8_STAGE(PG8_SB(0, 1), cB + hstep, voffB); PG8_STAGE(PG8_SA(0, 0), Abase, va0); PG8_STAGE(PG8_SA(0, 1), Abase, va1);
    if (wr == 1) PG8_BAR;
    PG8_WAIT_V(2); PG8_BAR;
    PG8_STAGE(PG8_SB(1, 0), cB + kstep, voffB); PG8_STAGE(PG8_SA(1, 0), Abase + kstep, va0); PG8_STAGE(PG8_SB(1, 1), cB + hstep + kstep, voffB);
    PG8_WAIT_V(6); PG8_BAR;
    for (;;) {
        const bool has_next = S.next(ui + 1, nxt);
        const char* nB = has_next ? S.bbase(nxt) : cB;
        for (int t = 0; t < nt; t += 2) {
            const bool last = (t == nt - 2);
            const char* a1 = Abase + (size_t)(t + 1) * kstep;
            const char* a2 = last ? Abase : Abase + (size_t)(t + 2) * kstep; const char* b2 = last ? nB : cB + (size_t)(t + 2) * kstep;
            const char* a3 = a2 + kstep; const char* b3 = b2 + kstep;
            unsigned nva0[2], nva1[2];
            nva0[0] = va0[0]; nva0[1] = va0[1]; nva1[0] = va1[0]; nva1[1] = va1[1];
            if (last && has_next) {
                S.aoff(nxt, sR, sC, nva0, nva1);
                if (Sched::GATHER) { asm volatile("s_waitcnt vmcnt(0)" ::: "memory"); asm volatile("" : "+v"(nva0[0]), "+v"(nva0[1]), "+v"(nva1[0]), "+v"(nva1[1])); }
            }
            PG8_LDB(B0, 0, 0); PG8_LDB(B1, 0, 1); PG8_SCHED; PG8_LDA(At, 0, 0); PG8_STAGE(PG8_SA(1, 1), a1, va1);
            PG8_WAIT_V(8); PG8_WAIT_L(0); PG8_BAR; PG8_MMA(0, 0, At, B0); PG8_MMA(0, 1, At, B1); PG8_BAR; PG8_SCHED;
            if (last) { va0[0] = nva0[0]; va0[1] = nva0[1]; va1[0] = nva1[0]; va1[1] = nva1[1]; }
            PG8_LDA(At, 0, 1); PG8_STAGE(PG8_SB(0, 0), b2, voffB); PG8_STAGE(PG8_SB(0, 1), b2 + hstep, voffB); PG8_STAGE(PG8_SA(0, 0), a2, va0);
            PG8_WAIT_V(8); PG8_WAIT_L(0); PG8_BAR; PG8_MMA(1, 0, At, B0); PG8_MMA(1, 1, At, B1); PG8_BAR; PG8_SCHED;
            PG8_LDB(B0, 1, 0); PG8_LDB(B1, 1, 1); PG8_SCHED; PG8_LDA(At, 1, 0); PG8_STAGE(PG8_SA(0, 1), a2, va1);
            PG8_WAIT_V(8); PG8_WAIT_L(0); PG8_BAR; PG8_MMA(0, 0, At, B0); PG8_MMA(0, 1, At, B1); PG8_BAR; PG8_SCHED;
            PG8_LDA(At, 1, 1); PG8_STAGE(PG8_SB(1, 0), b3, voffB); PG8_STAGE(PG8_SB(1, 1), b3 + hstep, voffB); PG8_STAGE(PG8_SA(1, 0), a3, va0);
            PG8_WAIT_V(8); PG8_WAIT_L(0); PG8_BAR; PG8_MMA(1, 0, At, B0); PG8_MMA(1, 1, At, B1); PG8_BAR; PG8_SCHED;
        }
        if (wr == 0) PG8_BAR;
        E(acc, cur, wr, wc, fr, fq);
        if (!has_next) break;
#pragma unroll
        for (int a = 0; a < 2; ++a)
#pragma unroll
            for (int b = 0; b < 2; ++b)
#pragma unroll
                for (int m = 0; m < 4; ++m)
#pragma unroll
                    for (int n = 0; n < 2; ++n) acc[a][b][m][n] = (f32x4){0.f, 0.f, 0.f, 0.f};
        cur = nxt; cB = nB; ++ui;
        if (wr == 1) PG8_BAR;
    }
    PG8_WAIT_V(0);
    PG8_BAR;
#undef PG8_SA
#undef PG8_SB
#undef PG8_STAGE
#undef PG8_LDA
#undef PG8_LDB
#undef PG8_MMA
#undef PG8_WAIT_V
#undef PG8_WAIT_L
#undef PG8_BAR
#undef PG8_SCHED
}
}

using pg8::Unit;
struct SchedIn {
    static constexpr bool GATHER = false;
    int G, v, K; const bf16* Bt;
    __device__ __forceinline__ bool next(int i, Unit& u) const {
        int L = i * G + v; if (L >= 3040) return false;
        if (L < 2944) { const int gid = L / 184, l = L % 184; u.pm = gid * 8 + (l & 7); u.pn = l >> 3; }
        else { L -= 2944; const int gid = L / 48, l = L % 48; u.pm = 128 + gid * 8 + (l & 7); u.pn = l >> 3; }
        u.e = 0; return true;
    }
    __device__ __forceinline__ const char* bbase(const Unit& u) const { return (const char*)Bt + (size_t)u.pn * ((size_t)256 * K * 2); }
    __device__ __forceinline__ void aoff(const Unit& u, const int (&R)[2], const int (&C)[2], unsigned (&v0)[2], unsigned (&v1)[2]) const {
#pragma unroll
        for (int i = 0; i < 2; ++i) { v0[i] = (unsigned)(((u.pm * 256 + R[i]) * K + C[i]) * 2); v1[i] = (unsigned)(((u.pm * 256 + 128 + R[i]) * K + C[i]) * 2); }
    }
};
struct SchedPlain {
    static constexpr bool GATHER = false;
    int G, v, K, nN, nwg; const bf16* Bt;
    __device__ __forceinline__ bool next(int i, Unit& u) const {
        const int L = i * G + v; if (L >= nwg) return false;
        const int per = 8 * nN, gid = L / per, l = L % per; u.pm = gid * 8 + (l & 7); u.pn = l >> 3; u.e = 0; return true;
    }
    __device__ __forceinline__ const char* bbase(const Unit& u) const { return (const char*)Bt + (size_t)u.pn * ((size_t)256 * K * 2); }
    __device__ __forceinline__ void aoff(const Unit& u, const int (&R)[2], const int (&C)[2], unsigned (&v0)[2], unsigned (&v1)[2]) const {
#pragma unroll
        for (int i = 0; i < 2; ++i) { v0[i] = (unsigned)(((u.pm * 256 + R[i]) * K + C[i]) * 2); v1[i] = (unsigned)(((u.pm * 256 + 128 + R[i]) * K + C[i]) * 2); }
    }
};
template <bool GATH> struct SchedMoe {
    static constexpr bool GATHER = GATH;
    int G, v, K, NT; const bf16* Bt; const volatile LAS unsigned* cl; const int* rowtok;
    __device__ __forceinline__ bool next(int i, Unit& u) const {
        const int L = i * G + v; const int mt = L / NT; const int tot = (int)cl[LW_MTS + 32];
        if (mt >= tot) return false;
        int e = 0;
        while (e < 31 && (int)cl[LW_MTS + e + 1] <= mt) ++e;
        u.pm = mt; u.pn = L - mt * NT; u.e = e; return true;
    }
    __device__ __forceinline__ const char* bbase(const Unit& u) const { return (const char*)Bt + ((size_t)u.e * NT + u.pn) * ((size_t)256 * K * 2); }
    __device__ __forceinline__ void aoff(const Unit& u, const int (&R)[2], const int (&C)[2], unsigned (&v0)[2], unsigned (&v1)[2]) const {
        if (GATH) {
            const int i0 = (u.pm - (int)cl[LW_MTS + u.e]) * 256, cnt = (int)cl[LW_CNT + u.e];
            const int* rt = rowtok + (size_t)u.e * CAP;
#pragma unroll
            for (int i = 0; i < 2; ++i) {
                int s0 = i0 + R[i], s1 = i0 + 128 + R[i]; s0 = s0 < cnt ? s0 : 0; s1 = s1 < cnt ? s1 : 0;
                const int t0 = rt[s0], t1 = rt[s1];
                v0[i] = (unsigned)((t0 * K + C[i]) * 2); v1[i] = (unsigned)((t1 * K + C[i]) * 2);
            }
        } else {
#pragma unroll
            for (int i = 0; i < 2; ++i) { v0[i] = (unsigned)(((u.pm * 256 + R[i]) * K + C[i]) * 2); v1[i] = (unsigned)(((u.pm * 256 + 128 + R[i]) * K + C[i]) * 2); }
        }
    }
};

__device__ __forceinline__ float softplusf(float x) { return x > 20.f ? x : log1pf(__expf(x)); }

struct EpiIn {
    static constexpr bool PERM = true;
    bf16* xraw; float* dt; bf16* sz; bf16* scb; bf16* cu; const float* dt_bias;
    __device__ __forceinline__ void operator()(const f32x4 (&acc)[2][2][4][2], const Unit& u, int wr, int wc, int fr, int fq) const {
        const int row0 = u.pm * 256 + wr * 64 + fr, pn = u.pn, cl = wc * 32 + 8 * fq;
        if (pn <= 4 || pn == 6 || (pn >= 11 && pn <= 14)) {
            bf16* base; int ld;
            if (pn <= 4) { base = xraw + pn * 256; ld = XBCW; } else if (pn == 6) { base = xraw + 1280; ld = XBCW; } else { base = scb + (pn - 11) * 256; ld = 1024; }
#pragma unroll
            for (int ai = 0; ai < 2; ++ai)
#pragma unroll
                for (int m = 0; m < 4; ++m) { bf16* rowp = base + (size_t)(row0 + ai * 128 + m * 16) * ld + cl;
#pragma unroll
                    for (int bj = 0; bj < 2; ++bj) { const f32x4 v0 = acc[ai][bj][m][0], v1 = acc[ai][bj][m][1];
                        u32x4 w; w.x = pg8::cvt_pk_bf16(v0[0], v0[1]); w.y = pg8::cvt_pk_bf16(v0[2], v0[3]); w.z = pg8::cvt_pk_bf16(v1[0], v1[1]); w.w = pg8::cvt_pk_bf16(v1[2], v1[3]);
                        *(u32x4*)(rowp + bj * 128) = w; } }
        } else if (pn == 5) {
            if (wc == 0) {
                const f32x4 b0 = *(const f32x4*)(dt_bias + 8 * fq), b1 = *(const f32x4*)(dt_bias + 8 * fq + 4);
#pragma unroll
                for (int ai = 0; ai < 2; ++ai)
#pragma unroll
                    for (int m = 0; m < 4; ++m) { float* rowp = dt + (size_t)(row0 + ai * 128 + m * 16) * 32 + 8 * fq;
                        const f32x4 v0 = acc[ai][0][m][0] + b0, v1 = acc[ai][0][m][1] + b1; f32x4 o0, o1;
#pragma unroll
                        for (int j = 0; j < 4; ++j) { o0[j] = softplusf(v0[j]); o1[j] = softplusf(v1[j]); }
                        *(f32x4*)rowp = o0; *(f32x4*)(rowp + 4) = o1; }
            }
        } else if (pn <= 10) {
            bf16* base = sz + (pn - 7) * 256;
#pragma unroll
            for (int ai = 0; ai < 2; ++ai)
#pragma unroll
                for (int m = 0; m < 4; ++m) { bf16* rowp = base + (size_t)(row0 + ai * 128 + m * 16) * 1024 + cl;
#pragma unroll
                    for (int bj = 0; bj < 2; ++bj) { f32x4 v0 = acc[ai][bj][m][0], v1 = acc[ai][bj][m][1];
#pragma unroll
                        for (int j = 0; j < 4; ++j) { v0[j] = fsilu(v0[j]); v1[j] = fsilu(v1[j]); }
                        u32x4 w; w.x = pg8::cvt_pk_bf16(v0[0], v0[1]); w.y = pg8::cvt_pk_bf16(v0[2], v0[3]); w.z = pg8::cvt_pk_bf16(v1[0], v1[1]); w.w = pg8::cvt_pk_bf16(v1[2], v1[3]);
                        *(u32x4*)(rowp + bj * 128) = w; } }
        } else {
            bf16* base = cu + (pn - 15) * 128;
#pragma unroll
            for (int ai = 0; ai < 2; ++ai)
#pragma unroll
                for (int m = 0; m < 4; ++m) { bf16* rowp = base + (size_t)(row0 + ai * 128 + m * 16) * 1024 + cl;
                    const f32x4 v0 = acc[ai][0][m][0] * acc[ai][1][m][0], v1 = acc[ai][0][m][1] * acc[ai][1][m][1];
                    u32x4 w; w.x = pg8::cvt_pk_bf16(v0[0], v0[1]); w.y = pg8::cvt_pk_bf16(v0[2], v0[3]); w.z = pg8::cvt_pk_bf16(v1[0], v1[1]); w.w = pg8::cvt_pk_bf16(v1[2], v1[3]);
                    *(u32x4*)rowp = w; }
        }
    }
};
struct EpiOut {
    static constexpr bool PERM = false;
    const float* x; float* out; const float* mod;
    __device__ __forceinline__ void operator()(const f32x4 (&acc)[2][2][4][2], const Unit& u, int wr, int wc, int fr, int fq) const {
        const int row0 = u.pm * 256 + wr * 64 + fr, col0 = u.pn * 256 + wc * 32 + 4 * fq, b = u.pm >> 3;
        f32x4 gv[2][2];
#pragma unroll
        for (int bj = 0; bj < 2; ++bj)
#pragma unroll
            for (int n = 0; n < 2; ++n) gv[bj][n] = *(const f32x4*)(mod + (size_t)b * 6144 + 2048 + col0 + bj * 128 + n * 16);
#pragma unroll
        for (int ai = 0; ai < 2; ++ai)
#pragma unroll
            for (int m = 0; m < 4; ++m) { const size_t off = (size_t)(row0 + ai * 128 + m * 16) * 1024 + col0;
#pragma unroll
                for (int bj = 0; bj < 2; ++bj)
#pragma unroll
                    for (int n = 0; n < 2; ++n) { const f32x4 xv = *(const f32x4*)(x + off + bj * 128 + n * 16);
                        *(f32x4*)(out + off + bj * 128 + n * 16) = xv + gv[bj][n] * acc[ai][bj][m][n]; }
                asm volatile("" ::: "memory"); }
    }
};
struct EpiGU {
    static constexpr bool PERM = true;
    bf16* act; const float* bgu;
    __device__ __forceinline__ void operator()(const f32x4 (&acc)[2][2][4][2], const Unit& u, int wr, int wc, int fr, int fq) const {
        const int row0 = u.pm * 256 + wr * 64 + fr, cl = wc * 32 + 8 * fq, ch0 = u.pn * 128 + cl;
        const float* bp = bgu + (size_t)u.e * 2048 + ch0;
        const f32x4 bg0 = *(const f32x4*)bp, bg1 = *(const f32x4*)(bp + 4), bl0 = *(const f32x4*)(bp + 1024), bl1 = *(const f32x4*)(bp + 1028);
#pragma unroll
        for (int ai = 0; ai < 2; ++ai)
#pragma unroll
            for (int m = 0; m < 4; ++m) { bf16* rowp = act + (size_t)(row0 + ai * 128 + m * 16) * 1024 + ch0;
                f32x4 g0 = acc[ai][0][m][0] + bg0, g1 = acc[ai][0][m][1] + bg1, l0 = acc[ai][1][m][0] + bl0, l1 = acc[ai][1][m][1] + bl1, o0, o1;
#pragma unroll
                for (int j = 0; j < 4; ++j) {
                    const float ga = fminf(g0[j], 7.f), gb = fminf(g1[j], 7.f);
                    const float la = fminf(fmaxf(l0[j], -7.f), 7.f), lb = fminf(fmaxf(l1[j], -7.f), 7.f);
                    o0[j] = ga * __builtin_amdgcn_rcpf(1.0f + __expf(-1.702f * ga)) * (la + 1.0f);
                    o1[j] = gb * __builtin_amdgcn_rcpf(1.0f + __expf(-1.702f * gb)) * (lb + 1.0f); }
                u32x4 w; w.x = pg8::cvt_pk_bf16(o0[0], o0[1]); w.y = pg8::cvt_pk_bf16(o0[2], o0[3]); w.z = pg8::cvt_pk_bf16(o1[0], o1[1]); w.w = pg8::cvt_pk_bf16(o1[2], o1[3]);
                *(u32x4*)rowp = w; }
    }
};
struct EpiDown {
    static constexpr bool PERM = true;
    bf16* y; const float* bdn;
    __device__ __forceinline__ void operator()(const f32x4 (&acc)[2][2][4][2], const Unit& u, int wr, int wc, int fr, int fq) const {
        const int row0 = u.pm * 256 + wr * 64 + fr, col0 = u.pn * 256 + wc * 32 + 8 * fq;
        const float* bp = bdn + (size_t)u.e * 1024 + col0;
        f32x4 bv[2][2];
#pragma unroll
        for (int bj = 0; bj < 2; ++bj) { bv[bj][0] = *(const f32x4*)(bp + bj * 128); bv[bj][1] = *(const f32x4*)(bp + bj * 128 + 4); }
#pragma unroll
        for (int ai = 0; ai < 2; ++ai)
#pragma unroll
            for (int m = 0; m < 4; ++m) { bf16* rowp = y + (size_t)(row0 + ai * 128 + m * 16) * 1024 + col0;
#pragma unroll
                for (int bj = 0; bj < 2; ++bj) { const f32x4 v0 = acc[ai][bj][m][0] + bv[bj][0], v1 = acc[ai][bj][m][1] + bv[bj][1];
                    u32x4 w; w.x = pg8::cvt_pk_bf16(v0[0], v0[1]); w.y = pg8::cvt_pk_bf16(v0[2], v0[3]); w.z = pg8::cvt_pk_bf16(v1[0], v1[1]); w.w = pg8::cvt_pk_bf16(v1[2], v1[3]);
                    *(u32x4*)(rowp + bj * 128) = w; } }
    }
};

__device__ __forceinline__ void p0_item(const float* W, int ldw, int K, int k0, int n0, bf16* WT, int drow0, const float* kscale, LAS float* scr, int lane) {
#pragma unroll 8
    for (int i = 0; i < 32; ++i) { const int kk = 2 * i + (lane >> 5); float w = W[(size_t)(k0 + kk) * ldw + n0 + (lane & 31)]; if (kscale) w *= kscale[k0 + kk]; scr[kk * 33 + (lane & 31)] = w; }
    LDS_WAIT(); asm volatile("" ::: "memory");
    const int c = lane & 7;
#pragma unroll
    for (int j = 0; j < 4; ++j) { const int n = (lane >> 3) + 8 * j; const LAS float* s = scr + (8 * c) * 33 + n;
        u32x4 o; o.x = pk2(s[0 * 33], s[1 * 33]); o.y = pk2(s[2 * 33], s[3 * 33]); o.z = pk2(s[4 * 33], s[5 * 33]); o.w = pk2(s[6 * 33], s[7 * 33]);
        *(u32x4*)(WT + (size_t)(drow0 + n) * K + k0 + 8 * c) = o; }
    LDS_WAIT(); asm volatile("" ::: "memory");
}
__device__ __forceinline__ int win_drow(int n) {
    if (n < X0) return (7 + (n >> 8)) * 256 + (n & 255);
    if (n < B0) return n - X0;
    if (n < C0) return 4 * 256 + (n - B0);
    if (n < DT0) return 6 * 256 + (n - C0);
    if (n < SC0) return 5 * 256 + (n - DT0);
    n -= SC0;
    if (n < 1024) return (11 + (n >> 8)) * 256 + (n & 255);
    if (n < 2048) { n -= 1024; return (15 + (n >> 7)) * 256 + (n & 127); }
    n -= 2048; return (15 + (n >> 7)) * 256 + 128 + (n & 127);
}
__device__ __forceinline__ void phase0(Frame& F) {
    float* mod = (float*)(F.ws + WS_MOD);
    for (int it = F.vcu; it < 192; it += F.G) {
        LAS float* sc = (LAS float*)F.lds;
        LAS float* red = (LAS float*)(F.lds + 69632);
        for (int i = F.tid; i < 17 * 1024; i += 512) { const int r = i >> 10, k = i & 1023; const float v = (r < 16) ? F.c[r * 1024 + k] : F.c_ctx[k]; sc[i] = fsilu(v); }
        __syncthreads();
        const int col = F.tid & 31, kg = F.tid >> 5, n0 = it * 32;
        float acc[17];
#pragma unroll
        for (int r = 0; r < 17; ++r) acc[r] = 0.f;
        for (int q = 0; q < 16; ++q) {
            const int k = 4 * (kg + 16 * q);
            const float w0 = F.w_mod[(size_t)(k + 0) * 6144 + n0 + col], w1 = F.w_mod[(size_t)(k + 1) * 6144 + n0 + col], w2 = F.w_mod[(size_t)(k + 2) * 6144 + n0 + col], w3 = F.w_mod[(size_t)(k + 3) * 6144 + n0 + col];
#pragma unroll
            for (int r = 0; r < 17; ++r) { const f32x4 s = *(const LAS f32x4*)(sc + r * 1024 + k); acc[r] += s[0] * w0 + s[1] * w1 + s[2] * w2 + s[3] * w3; }
        }
#pragma unroll
        for (int r = 0; r < 17; ++r) red[(kg * 17 + r) * 32 + col] = acc[r];
        __syncthreads();
        for (int o = F.tid; o < 17 * 32; o += 512) { const int r = o >> 5, cc = o & 31; float s = F.b_mod[n0 + cc];
            for (int g = 0; g < 16; ++g) s += red[(g * 17 + r) * 32 + cc];
            mod[(size_t)r * 6144 + n0 + cc] = s; }
        __syncthreads();
    }
    LAS float* scr = (LAS float*)(F.lds + F.wave * 8448);
    const int gw = F.vcu * NWAVES + F.wave, NGW = F.G * NWAVES;
    constexpr int I_IN = 16 * 177, I_OUT = 32 * 32, I_GU = 32 * 16 * 64, I_DN = 32 * 16 * 32;
    bf16* win = (bf16*)(F.ws + WS_WIN); bf16* wout = (bf16*)(F.ws + WS_WOUT); bf16* wgu = (bf16*)(F.ws + WS_WGU); bf16* wdn = (bf16*)(F.ws + WS_WDN);
    for (int it = gw; it < I_IN + I_OUT + I_GU + I_DN; it += NGW) {
        int r = it;
        if (r < I_IN) { const int kb = r / 177, nb = r % 177; p0_item(F.w_in, IN_W, 1024, kb * 64, nb * 32, win, win_drow(nb * 32), nullptr, scr, F.lane); continue; } r -= I_IN;
        if (r < I_OUT) { const int kb = r >> 5, nb = r & 31; p0_item(F.w_out, 1024, 2048, kb * 64, nb * 32, wout, nb * 32, kb < 16 ? F.ssd_norm_g : nullptr, scr, F.lane); continue; } r -= I_OUT;
        if (r < I_GU) { const int e = r >> 10, q = r & 1023, kb = q >> 6, nb = q & 63; const int n = nb * 32;
            const int drow = n < 1024 ? (n >> 7) * 256 + (n & 127) : ((n - 1024) >> 7) * 256 + 128 + ((n - 1024) & 127);
            p0_item(F.w_gu + (size_t)e * 1024 * 2048, 2048, 1024, kb * 64, n, wgu + (size_t)e * 2048 * 1024, drow, nullptr, scr, F.lane); continue; } r -= I_GU;
        { const int e = r >> 9, q = r & 511, kb = q >> 5, nb = q & 31;
            p0_item(F.w_dn + (size_t)e * 1024 * 1024, 1024, 1024, kb * 64, nb * 32, wdn + (size_t)e * 1024 * 1024, nb * 32, nullptr, scr, F.lane); }
    }
}

__device__ __forceinline__ void phase1(Frame& F) {
    const float* mod = (const float*)(F.ws + WS_MOD); bf16* hx = (bf16*)(F.ws + WS_HX);
    const int gw = F.vcu * NWAVES + F.wave, NGW = F.G * NWAVES;
    for (int row = gw; row < TT; row += NGW) {
        const float* src = row < TL ? F.x + (size_t)row * 1024 : F.ctx + (size_t)(row - TL) * 1024;
        const int mb = row < TL ? (row >> 11) : 16;
        const float* shift = mod + (size_t)mb * 6144, *scale = shift + 1024;
        f32x4 v[4]; float s = 0.f;
#pragma unroll
        for (int j = 0; j < 4; ++j) { v[j] = *(const f32x4*)(src + 4 * F.lane + 256 * j); s += (v[j][0] * v[j][0] + v[j][1] * v[j][1]) + (v[j][2] * v[j][2] + v[j][3] * v[j][3]); }
        const float rs = 1.0f / sqrtf(wave_sum(s) * (1.f / 1024.f) + NORM_EPS);
#pragma unroll
        for (int j = 0; j < 4; ++j) { const int c = 4 * F.lane + 256 * j;
            const f32x4 g = *(const f32x4*)(F.norm1_g + c), sh = *(const f32x4*)(shift + c), sc = *(const f32x4*)(scale + c);
            const f32x4 o = v[j] * rs * g * (sc + 1.0f) + sh;
            u32x2 w; w.x = pk2(o[0], o[1]); w.y = pk2(o[2], o[3]);
            *(u32x2*)(hx + (size_t)row * 1024 + c) = w; }
    }
}

__device__ __forceinline__ void unpack8(const u32x4 w, float (&f)[8]) { f[0] = bflo(w.x); f[1] = bfhi(w.x); f[2] = bflo(w.y); f[3] = bfhi(w.y); f[4] = bflo(w.z); f[5] = bfhi(w.z); f[6] = bflo(w.w); f[7] = bfhi(w.w); }
__device__ __forceinline__ void phase_conv(Frame& F) {
    const bf16* xraw = (const bf16*)(F.ws + WS_XRAW); bf16* xbc = (bf16*)(F.ws + WS_XBC);
    if (F.tid >= 384) return;
    const int cp = F.tid % 192, rs = F.tid / 192, c0 = cp * 8;
    float w0[8], w1[8], w2[8], bb[8];
#pragma unroll
    for (int e = 0; e < 8; ++e) { w0[e] = F.conv_w[c0 + e]; w1[e] = F.conv_w[XBCW + c0 + e]; w2[e] = F.conv_w[2 * XBCW + c0 + e]; bb[e] = F.conv_b[c0 + e]; }
    for (int it = F.vcu; it < TT / 32; it += F.G) {
        const int r0 = it * 32 + rs * 16;
        const bool isctx = r0 >= TL;
        if (isctx && c0 >= 1280) continue;
        const int L = isctx ? CTXL : SEQ, t0 = isctx ? ((r0 - TL) & (CTXL - 1)) : (r0 & (SEQ - 1));
        const u32x4 zero = (u32x4){0u, 0u, 0u, 0u};
        u32x4 prev = (t0 > 0) ? *(const u32x4*)(xraw + (size_t)(r0 - 1) * XBCW + c0) : zero;
        u32x4 cur = *(const u32x4*)(xraw + (size_t)r0 * XBCW + c0);
#pragma unroll 4
        for (int i = 0; i < 16; ++i) {
            const u32x4 nxt = (t0 + i + 1 < L) ? *(const u32x4*)(xraw + (size_t)(r0 + i + 1) * XBCW + c0) : zero;
            float a[8], b[8], c[8], o[8]; unpack8(prev, a); unpack8(cur, b); unpack8(nxt, c);
#pragma unroll
            for (int e = 0; e < 8; ++e) o[e] = fsilu(w0[e] * a[e] + w1[e] * b[e] + w2[e] * c[e] + bb[e]);
            u32x4 w; w.x = pk2(o[0], o[1]); w.y = pk2(o[2], o[3]); w.z = pk2(o[4], o[5]); w.w = pk2(o[6], o[7]);
            *(u32x4*)(xbc + (size_t)(r0 + i) * XBCW + c0) = w;
            prev = cur; cur = nxt;
        }
    }
}

namespace ssd {
constexpr int LDC = 136, LDJ = 72;
constexpr int S_CC = 0, S_BC = 17408, S_BT = 34816, S_XT = 53248, S_G = 62464, S_HB = 71680, S_CS = 89088, S_DTV = 89344, S_W = 89600, S_TOT = 89856;
__device__ __forceinline__ bf16x8 ldfrag(const LAS unsigned char* base, int row, int ld, int k) { return *(const LAS bf16x8*)(base + (size_t)(row * ld + k) * 2); }
}
__device__ __forceinline__ void phase_ssd(Frame& F) {
    using namespace ssd;
    const bf16* xbc = (const bf16*)(F.ws + WS_XBC); const float* dtb = (const float*)(F.ws + WS_DT);
    LAS unsigned char* L = F.lds;
    LAS float* cs = (LAS float*)(L + S_CS); LAS float* dtv = (LAS float*)(L + S_DTV); LAS float* wv = (LAS float*)(L + S_W); LAS float* tot = (LAS float*)(L + S_TOT);
    const int tid = F.tid, lane = F.lane, w = F.wave, fr = lane & 15, fq = lane >> 4;
    for (int it = F.vcu; it < 512; it += F.G) {
        const int b = it >> 5, h = (it >> 1) & 15, dir = it & 1, g = h >> 3;
        const float a = -__expf(F.a_log[dir * 16 + h]);
        const int dtcol = dir * 16 + h;
        bf16* ydir = (bf16*)(F.ws + (dir ? WS_YB : WS_YF));
        f32x4 Hacc[4];
#pragma unroll
        for (int tp = 0; tp < 4; ++tp) Hacc[tp] = (f32x4){0.f, 0.f, 0.f, 0.f};
        for (int s = 0; s < 36; ++s) {
            const bool isctx = s < 4;
            int rowbase;
            if (isctx) rowbase = TL + b * CTXL + (dir ? (3 - s) : s) * 64;
            else rowbase = b * SEQ + (dir ? (35 - s) : (s - 4)) * 64;
            if (w == 0) {
                const int j = dir ? (63 - lane) : lane;
                const float dtj = dtb[(size_t)(rowbase + j) * 32 + dtcol];
                float v = dtj * a;
#pragma unroll
                for (int o = 1; o < 64; o <<= 1) { const float t = __shfl_up(v, o); if (lane >= o) v += t; }
                const float total = __shfl(v, 63);
                cs[j] = v; dtv[j] = dtj; wv[j] = __expf(total - v) * dtj;
                if (lane == 0) tot[0] = total;
            }
            u32x4 cR[2], bR[2]; unsigned short btR[2][8], xtR[8];
#pragma unroll
            for (int q2 = 0; q2 < 2; ++q2) { const int q = tid + 512 * q2, row = q >> 4, n8 = q & 15;
                const bf16* p = xbc + (size_t)(rowbase + row) * XBCW + 1024 + g * 128 + n8 * 8;
                bR[q2] = *(const u32x4*)p;
                cR[q2] = isctx ? (u32x4){0u, 0u, 0u, 0u} : *(const u32x4*)(p + 256); }
#pragma unroll
            for (int q2 = 0; q2 < 2; ++q2) { const int q = tid + 512 * q2, n = q & 127, j8 = q >> 7;
                const bf16* p = xbc + (size_t)(rowbase + j8 * 8) * XBCW + 1024 + g * 128 + n;
#pragma unroll
                for (int e = 0; e < 8; ++e) btR[q2][e] = p[(size_t)e * XBCW]; }
            { const int p_ = tid & 63, j8 = tid >> 6;
                const bf16* p = xbc + (size_t)(rowbase + j8 * 8) * XBCW + h * 64 + p_;
#pragma unroll
                for (int e = 0; e < 8; ++e) xtR[e] = p[(size_t)e * XBCW]; }
            __syncthreads();
#pragma unroll
            for (int q2 = 0; q2 < 2; ++q2) { const int q = tid + 512 * q2, row = q >> 4, n8 = q & 15;
                *(LAS u32x4*)(L + S_BC + (size_t)(row * LDC + n8 * 8) * 2) = bR[q2];
                *(LAS u32x4*)(L + S_CC + (size_t)(row * LDC + n8 * 8) * 2) = cR[q2]; }
#pragma unroll
            for (int q2 = 0; q2 < 2; ++q2) { const int q = tid + 512 * q2, n = q & 127, j8 = q >> 7;
                float f[8];
#pragma unroll
                for (int e = 0; e < 8; ++e) f[e] = bf2f(btR[q2][e]) * wv[j8 * 8 + e];
                u32x4 o; o.x = pk2(f[0], f[1]); o.y = pk2(f[2], f[3]); o.z = pk2(f[4], f[5]); o.w = pk2(f[6], f[7]);
                *(LAS u32x4*)(L + S_BT + (size_t)(n * LDJ + j8 * 8) * 2) = o; }
            { const int p_ = tid & 63, j8 = tid >> 6;
                u32x4 o; o.x = (unsigned)xtR[0] | ((unsigned)xtR[1] << 16); o.y = (unsigned)xtR[2] | ((unsigned)xtR[3] << 16); o.z = (unsigned)xtR[4] | ((unsigned)xtR[5] << 16); o.w = (unsigned)xtR[6] | ((unsigned)xtR[7] << 16);
                *(LAS u32x4*)(L + S_XT + (size_t)(p_ * LDJ + j8 * 8) * 2) = o; }
            __syncthreads();
            if (!isctx) {
#pragma unroll
                for (int q2 = 0; q2 < 2; ++q2) { const int q = w + 8 * q2, tj = q >> 2, ti = q & 3;
                    f32x4 acc = (f32x4){0.f, 0.f, 0.f, 0.f};
                    const bool need = dir ? (tj >= ti) : (tj <= ti);
                    if (need) {
#pragma unroll
                        for (int k0 = 0; k0 < 128; k0 += 32) acc = __builtin_amdgcn_mfma_f32_16x16x32_bf16(ldfrag(L + S_BC, 16 * tj + fr, LDC, k0 + 8 * fq), ldfrag(L + S_CC, 16 * ti + fr, LDC, k0 + 8 * fq), acc, 0, 0, 0);
                    }
                    const int i = 16 * ti + fr; const float csi = cs[i]; float gv[4];
#pragma unroll
                    for (int r = 0; r < 4; ++r) { const int j = 16 * tj + 4 * fq + r; const bool ok = dir ? (j >= i) : (j <= i);
                        const float sg = ok ? (csi - cs[j]) : -1e30f;
                        gv[r] = ok ? acc[r] * __expf(sg) * dtv[j] : 0.f; }
                    u32x2 o; o.x = pk2(gv[0], gv[1]); o.y = pk2(gv[2], gv[3]);
                    *(LAS u32x2*)(L + S_G + (size_t)(i * LDJ + 16 * tj + 4 * fq) * 2) = o; }
                __syncthreads();
#pragma unroll
                for (int q2 = 0; q2 < 2; ++q2) { const int q = w + 8 * q2, tp = q >> 2, ti = q & 3;
                    f32x4 yd = (f32x4){0.f, 0.f, 0.f, 0.f}, yo = (f32x4){0.f, 0.f, 0.f, 0.f};
#pragma unroll
                    for (int k0 = 0; k0 < 64; k0 += 32) yd = __builtin_amdgcn_mfma_f32_16x16x32_bf16(ldfrag(L + S_XT, 16 * tp + fr, LDJ, k0 + 8 * fq), ldfrag(L + S_G, 16 * ti + fr, LDJ, k0 + 8 * fq), yd, 0, 0, 0);
#pragma unroll
                    for (int k0 = 0; k0 < 128; k0 += 32) yo = __builtin_amdgcn_mfma_f32_16x16x32_bf16(ldfrag(L + S_HB, 16 * tp + fr, LDC, k0 + 8 * fq), ldfrag(L + S_CC, 16 * ti + fr, LDC, k0 + 8 * fq), yo, 0, 0, 0);
                    const int i = 16 * ti + fr; const float ei = __expf(cs[i]);
                    const f32x4 y = yd + yo * ei;
                    u32x2 o; o.x = pk2(y[0], y[1]); o.y = pk2(y[2], y[3]);
                    *(u32x2*)(ydir + (size_t)(rowbase + i) * 1024 + h * 64 + 16 * tp + 4 * fq) = o; }
            }
            {
                const float dec = __expf(tot[0]);
#pragma unroll
                for (int tp = 0; tp < 4; ++tp) Hacc[tp] = Hacc[tp] * dec;
#pragma unroll
                for (int k0 = 0; k0 < 64; k0 += 32) { const bf16x8 af = ldfrag(L + S_BT, 16 * w + fr, LDJ, k0 + 8 * fq);
#pragma unroll
                    for (int tp = 0; tp < 4; ++tp) Hacc[tp] = __builtin_amdgcn_mfma_f32_16x16x32_bf16(af, ldfrag(L + S_XT, 16 * tp + fr, LDJ, k0 + 8 * fq), Hacc[tp], 0, 0, 0); }
            }
            __syncthreads();
#pragma unroll
            for (int tp = 0; tp < 4; ++tp) { u32x2 o; o.x = pk2(Hacc[tp][0], Hacc[tp][1]); o.y = pk2(Hacc[tp][2], Hacc[tp][3]);
                *(LAS u32x2*)(L + S_HB + (size_t)((16 * tp + fr) * LDC + 16 * w + 4 * fq) * 2) = o; }
        }
        __syncthreads();
    }
}

__device__ __forceinline__ void phase_combine(Frame& F) {
    const bf16* xbc = (const bf16*)(F.ws + WS_XBC); const bf16* yf = (const bf16*)(F.ws + WS_YF); const bf16* yb = (const bf16*)(F.ws + WS_YB);
    const bf16* sz = (const bf16*)(F.ws + WS_SZ); const bf16* scb = (const bf16*)(F.ws + WS_SCB); const bf16* cu = (const bf16*)(F.ws + WS_CU);
    bf16* a2 = (bf16*)(F.ws + WS_A2);
    const int g = F.wave & 1, sub = F.wave >> 1, c = g * 512 + F.lane * 8;
    const float dsk = F.ssd_d[c >> 6];
    const int c2 = (F.tid & 127) * 8, sub2 = F.tid >> 7;
    float k0[8], k1[8], k2[8];
#pragma unroll
    for (int e = 0; e < 8; ++e) { k0[e] = F.sc_conv_w[c2 + e]; k1[e] = F.sc_conv_w[1024 + c2 + e]; k2[e] = F.sc_conv_w[2048 + c2 + e]; }
    for (int it = F.vcu; it < TL / 64; it += F.G) {
        const int tb = it * 64;
        for (int i = 0; i < 16; ++i) {
            const int t = tb + sub * 16 + i;
            float a[8], b2[8], x[8], z[8], v[8]; float ss = 0.f;
            unpack8(*(const u32x4*)(yf + (size_t)t * 1024 + c), a); unpack8(*(const u32x4*)(yb + (size_t)t * 1024 + c), b2);
            unpack8(*(const u32x4*)(xbc + (size_t)t * XBCW + c), x); unpack8(*(const u32x4*)(sz + (size_t)t * 1024 + c), z);
#pragma unroll
            for (int e = 0; e < 8; ++e) { v[e] = (a[e] + b2[e] + dsk * x[e]) * z[e]; ss += v[e] * v[e]; }
            const float rs = 1.0f / sqrtf(wave_sum(ss) * (1.f / 512.f) + NORM_EPS);
            u32x4 o; o.x = pk2(v[0] * rs, v[1] * rs); o.y = pk2(v[2] * rs, v[3] * rs); o.z = pk2(v[4] * rs, v[5] * rs); o.w = pk2(v[6] * rs, v[7] * rs);
            *(u32x4*)(a2 + (size_t)t * 2048 + c) = o;
        }
        for (int i = 0; i < 16; ++i) {
            const int t = tb + sub2 * 16 + i, tt = t & (SEQ - 1);
            const u32x4 zero = (u32x4){0u, 0u, 0u, 0u};
            float p[8], q[8], n[8], sb[8], o8[8];
            unpack8(tt >= 64 ? *(const u32x4*)(cu + (size_t)(t - 64) * 1024 + c2) : zero, p);
            unpack8(*(const u32x4*)(cu + (size_t)t * 1024 + c2), q);
            unpack8(tt + 64 < SEQ ? *(const u32x4*)(cu + (size_t)(t + 64) * 1024 + c2) : zero, n);
            unpack8(*(const u32x4*)(scb + (size_t)t * 1024 + c2), sb);
#pragma unroll
            for (int e = 0; e < 8; ++e) o8[e] = sb[e] * (k0[e] * p[e] + k1[e] * q[e] + k2[e] * n[e]);
            u32x4 o; o.x = pk2(o8[0], o8[1]); o.y = pk2(o8[2], o8[3]); o.z = pk2(o8[4], o8[5]); o.w = pk2(o8[6], o8[7]);
            *(u32x4*)(a2 + (size_t)t * 2048 + 1024 + c2) = o;
        }
    }
}

__device__ __forceinline__ void phase_router(Frame& F) {
    const float* mod = (const float*)(F.ws + WS_MOD); bf16* h2 = (bf16*)(F.ws + WS_HX);
    int* rowtok = (int*)(F.ws + WS_ROWTOK); int* tokes = (int*)(F.ws + WS_TOKES); float* tokg = (float*)(F.ws + WS_TOKG);
    LAS unsigned char* L = F.lds;
    LAS f32x4* WR = (LAS f32x4*)L;
    LAS float* mulv = (LAS float*)(L + 131072);
    LAS float* shv = (LAS float*)(L + 131072 + 4096);
    LAS int* tinfo = (LAS int*)(L + 131072 + 8192);
    LAS int* lcnt = (LAS int*)(L + 131072 + 8192 + 6144);
    LAS int* lbase = lcnt + 32;
    for (int i = F.tid; i < 8192; i += 512) { const int k = i >> 3, e4 = i & 7; WR[e4 * 1024 + k] = *(const f32x4*)(F.w_router + (size_t)k * 32 + e4 * 4); }
    if (F.tid < 32) lcnt[F.tid] = 0;
    const int lane = F.lane;
    const int myexp = ((lane >> 5) & 1) * 16 + ((lane >> 4) & 1) * 8 + ((lane >> 3) & 1) * 4 + ((lane >> 2) & 1) * 2 + ((lane >> 1) & 1);
    const float mybias = F.b_router[myexp];
    for (int blk = F.vcu; blk < TL / 128; blk += F.G) {
        const int bb = (blk * 128) >> 11;
        __syncthreads();
        for (int k = F.tid; k < 1024; k += 512) { mulv[k] = F.norm2_g[k] * (1.0f + mod[(size_t)bb * 6144 + 4 * 1024 + k]); shv[k] = mod[(size_t)bb * 6144 + 3 * 1024 + k]; }
        __syncthreads();
        for (int i = 0; i < 16; ++i) {
            const int tl = F.wave * 16 + i, t = blk * 128 + tl;
            const float* xr = F.out + (size_t)t * 1024;
            float hv[16]; float ss = 0.f;
#pragma unroll
            for (int jj = 0; jj < 16; ++jj) { hv[jj] = xr[lane + 64 * jj]; ss += hv[jj] * hv[jj]; }
            const float rs = 1.0f / sqrtf(wave_sum(ss) * (1.f / 1024.f) + NORM_EPS);
            float acc[32];
#pragma unroll
            for (int e = 0; e < 32; ++e) acc[e] = 0.f;
#pragma unroll
            for (int jj = 0; jj < 16; ++jj) { const int k = lane + 64 * jj;
                const float hval = hv[jj] * rs * mulv[k] + shv[k];
                h2[(size_t)t * 1024 + k] = (bf16)f2bf(hval);
#pragma unroll
                for (int e4 = 0; e4 < 8; ++e4) { const f32x4 wq = WR[e4 * 1024 + k];
                    acc[4 * e4 + 0] += hval * wq[0]; acc[4 * e4 + 1] += hval * wq[1]; acc[4 * e4 + 2] += hval * wq[2]; acc[4 * e4 + 3] += hval * wq[3]; } }
            float r16[16], r8[8], r4[4], r2[2], r1;
            { const bool hi = (lane & 32) != 0;
#pragma unroll
              for (int e = 0; e < 16; ++e) { const float send = hi ? acc[e] : acc[e + 16]; const float recv = __shfl_xor(send, 32); r16[e] = (hi ? acc[e + 16] : acc[e]) + recv; } }
            { const bool hi = (lane & 16) != 0;
#pragma unroll
              for (int e = 0; e < 8; ++e) { const float send = hi ? r16[e] : r16[e + 8]; const float recv = __shfl_xor(send, 16); r8[e] = (hi ? r16[e + 8] : r16[e]) + recv; } }
            { const bool hi = (lane & 8) != 0;
#pragma unroll
              for (int e = 0; e < 4; ++e) { const float send = hi ? r8[e] : r8[e + 4]; const float recv = __shfl_xor(send, 8); r4[e] = (hi ? r8[e + 4] : r8[e]) + recv; } }
            { const bool hi = (lane & 4) != 0;
#pragma unroll
              for (int e = 0; e < 2; ++e) { const float send = hi ? r4[e] : r4[e + 2]; const float recv = __shfl_xor(send, 4); r2[e] = (hi ? r4[e + 2] : r4[e]) + recv; } }
            { const bool hi = (lane & 2) != 0; const float send = hi ? r2[0] : r2[1]; const float recv = __shfl_xor(send, 2); r1 = (hi ? r2[1] : r2[0]) + recv; }
            r1 += __shfl_xor(r1, 1);
            float val = r1 + mybias;
            int sel[4]; float sv[4];
#pragma unroll
            for (int kk = 0; kk < 4; ++kk) {
                float bv = val; int bi = myexp;
#pragma unroll
                for (int o = 1; o < 64; o <<= 1) { const float ov = __shfl_xor(bv, o); const int oi = __shfl_xor(bi, o); if (ov > bv || (ov == bv && oi < bi)) { bv = ov; bi = oi; } }
                sel[kk] = bi; sv[kk] = bv; if (myexp == bi) val = -3.0e38f;
            }
            const float p1 = __expf(sv[1] - sv[0]), p2 = __expf(sv[2] - sv[0]), p3 = __expf(sv[3] - sv[0]);
            const float inv = 1.0f / (1.0f + p1 + p2 + p3);
            const float gt[4] = {inv, p1 * inv, p2 * inv, p3 * inv};
            if (lane < 4) {
                const int e = lane == 0 ? sel[0] : lane == 1 ? sel[1] : lane == 2 ? sel[2] : sel[3];
                const float gg = lane == 0 ? gt[0] : lane == 1 ? gt[1] : lane == 2 ? gt[2] : gt[3];
                const int ls = atomicAdd((int*)&lcnt[e], 1);
                tinfo[(tl * 4 + lane) * 3 + 0] = e; tinfo[(tl * 4 + lane) * 3 + 1] = ls; tinfo[(tl * 4 + lane) * 3 + 2] = __float_as_int(gg);
            }
        }
        __syncthreads();
        if (F.tid < 32) { const int n = lcnt[F.tid]; lbase[F.tid] = (int)__hip_atomic_fetch_add((unsigned*)(F.ctl + CW_ECNT + F.tid), (unsigned)n, RLX_AGENT); }
        __syncthreads();
        { const int tl = F.tid >> 2, kk = F.tid & 3, t = blk * 128 + tl;
          const int e = tinfo[(tl * 4 + kk) * 3 + 0], ls = tinfo[(tl * 4 + kk) * 3 + 1]; const float gg = __int_as_float(tinfo[(tl * 4 + kk) * 3 + 2]);
          const int slot = lbase[e] + ls;
          rowtok[(size_t)e * CAP + slot] = t; tokes[t * 4 + kk] = e * CAP + slot; tokg[t * 4 + kk] = gg; }
        __syncthreads();
        if (F.tid < 32) lcnt[F.tid] = 0;
    }
    __syncthreads();
}

__device__ __forceinline__ void build_mt_table(Frame& F) {
    __syncthreads();
    if (F.tid == 0) { int s = 0;
        for (int e = 0; e < 32; ++e) { const int c = (int)__hip_atomic_load(F.ctl + CW_ECNT + e, RLX_AGENT); F.cl[LW_CNT + e] = (unsigned)c; F.cl[LW_MTS + e] = (unsigned)s; s += (c + 255) >> 8; }
        F.cl[LW_MTS + 32] = (unsigned)s; }
    __syncthreads();
}

__device__ __forceinline__ void phase_final(Frame& F) {
    const float* mod = (const float*)(F.ws + WS_MOD); const bf16* yrows = (const bf16*)(F.ws + WS_YROWS);
    const int* tokes = (const int*)(F.ws + WS_TOKES); const float* tokg = (const float*)(F.ws + WS_TOKG);
    const int gw = F.vcu * NWAVES + F.wave, NGW = F.G * NWAVES, lane = F.lane;
    for (int t = gw; t < TL; t += NGW) {
        const int b = t >> 11;
        float m[16];
#pragma unroll
        for (int e = 0; e < 16; ++e) m[e] = 0.f;
#pragma unroll
        for (int kk = 0; kk < 4; ++kk) {
            const int es = tokes[t * 4 + kk]; const float gg = tokg[t * 4 + kk];
            const int e = es >> 15, slot = es & (CAP - 1);
            const size_t pos = (size_t)F.cl[LW_MTS + e] * 256 + slot;
            float y0[8], y1[8];
            unpack8(*(const u32x4*)(yrows + pos * 1024 + lane * 8), y0); unpack8(*(const u32x4*)(yrows + pos * 1024 + 512 + lane * 8), y1);
#pragma unroll
            for (int q = 0; q < 8; ++q) { m[q] += gg * y0[q]; m[8 + q] += gg * y1[q]; }
        }
        float x2[16]; float ss = 0.f;
#pragma unroll
        for (int hf = 0; hf < 2; ++hf)
#pragma unroll
            for (int q4 = 0; q4 < 2; ++q4) { const int c = hf * 512 + lane * 8 + q4 * 4;
                const f32x4 xv = *(const f32x4*)(F.out + (size_t)t * 1024 + c), gv = *(const f32x4*)(mod + (size_t)b * 6144 + 5 * 1024 + c);
#pragma unroll
                for (int j = 0; j < 4; ++j) { const float v = xv[j] + gv[j] * m[hf * 8 + q4 * 4 + j]; x2[hf * 8 + q4 * 4 + j] = v; ss += v * v; } }
        const float rs = 1.0f / sqrtf(wave_sum(ss) * (1.f / 1024.f) + NORM_EPS);
#pragma unroll
        for (int hf = 0; hf < 2; ++hf)
#pragma unroll
            for (int q4 = 0; q4 < 2; ++q4) { const int c = hf * 512 + lane * 8 + q4 * 4;
                const f32x4 fg = *(const f32x4*)(F.final_g + c); f32x4 o;
#pragma unroll
                for (int j = 0; j < 4; ++j) o[j] = x2[hf * 8 + q4 * 4 + j] * rs * fg[j];
                *(f32x4*)(F.out + (size_t)t * 1024 + c) = o; }
    }
}

constexpr int NPHASE = 11;
__global__ void __launch_bounds__(NWAVES * 64, 2) mk_fwd(Args args) {
    extern __shared__ __attribute__((aligned(16))) unsigned char lds_raw[];
    Frame F;
    F.lds = (LAS unsigned char*)lds_raw;
    F.cl = (volatile LAS unsigned*)(F.lds + CTLDS_OFF);
    F.tid = threadIdx.x; F.lane = F.tid & 63; F.wave = __builtin_amdgcn_readfirstlane(F.tid >> 6);
    F.G = gridDim.x; { const int bx = blockIdx.x; F.vcu = (F.G % 8 == 0) ? (bx % 8) * (F.G / 8) + bx / 8 : bx; }
    F.ws = args.ws; F.ctl = (gu32*)(args.ws + WS_CTL); F.out = args.out;
    F.x = args.in[0]; F.c = args.in[1]; F.ctx = args.in[2]; F.c_ctx = args.in[3]; F.w_mod = args.in[4]; F.b_mod = args.in[5]; F.norm1_g = args.in[6]; F.w_in = args.in[7];
    F.conv_w = args.in[8]; F.conv_b = args.in[9]; F.dt_bias = args.in[10]; F.a_log = args.in[11]; F.ssd_d = args.in[12]; F.ssd_norm_g = args.in[13]; F.sc_conv_w = args.in[14];
    F.w_out = args.in[15]; F.norm2_g = args.in[16]; F.w_router = args.in[17]; F.b_router = args.in[18]; F.w_gu = args.in[19]; F.b_gu = args.in[20]; F.w_dn = args.in[21]; F.b_dn = args.in[22]; F.final_g = args.in[23];
    for (int u = F.tid; u < (LDS_BYTES - CTLDS_OFF) / 4; u += NWAVES * 64) ((LAS unsigned*)(F.lds + CTLDS_OFF))[u] = 0u;
    __syncthreads();
    const int lo = args.ph_lo, hi = args.ph_hi;
    XcdBarrier bar; bar.bar = (unsigned*)(F.ctl + CW_BAR); bar.x = 0; bar.st = nullptr;
    if (hi - lo > 1) bar = xcd_barrier_post((unsigned*)(F.ctl + CW_BAR), F.cl + LW_BARST);
#define IN(k) (lo <= (k) && (k) < hi)
#define SEAM(k) do { if (IN(k) && IN((k) + 1)) xcd_barrier(bar); } while (0)

    if (IN(0)) { phase0(F); SEAM(0); }
    if (IN(1)) { phase1(F); SEAM(1); }
    if (IN(2)) {
        SchedIn S{F.G, F.vcu, 1024, (const bf16*)(F.ws + WS_WIN)};
        EpiIn E{(bf16*)(F.ws + WS_XRAW), (float*)(F.ws + WS_DT), (bf16*)(F.ws + WS_SZ), (bf16*)(F.ws + WS_SCB), (bf16*)(F.ws + WS_CU), F.dt_bias};
        pg8::gemm_phase<EpiIn, SchedIn>(F.lds, (const bf16*)(F.ws + WS_HX), 1024, S, E);
        SEAM(2);
    }
    if (IN(3)) { phase_conv(F); SEAM(3); }
    if (IN(4)) { phase_ssd(F); SEAM(4); }
    if (IN(5)) { phase_combine(F); SEAM(5); }
    if (IN(6)) {
        SchedPlain S{F.G, F.vcu, 2048, 4, 512, (const bf16*)(F.ws + WS_WOUT)};
        EpiOut E{F.x, F.out, (const float*)(F.ws + WS_MOD)};
        pg8::gemm_phase<EpiOut, SchedPlain>(F.lds, (const bf16*)(F.ws + WS_A2), 2048, S, E);
        SEAM(6);
    }
    if (IN(7)) { phase_router(F); SEAM(7); }
    if (IN(8)) {
        build_mt_table(F);
        SchedMoe<true> S{F.G, F.vcu, 1024, 8, (const bf16*)(F.ws + WS_WGU), F.cl, (const int*)(F.ws + WS_ROWTOK)};
        EpiGU E{(bf16*)(F.ws + WS_ACT), F.b_gu};
        pg8::gemm_phase<EpiGU, SchedMoe<true>>(F.lds, (const bf16*)(F.ws + WS_HX), 1024, S, E);
        SEAM(8);
    }
    if (IN(9)) {
        build_mt_table(F);
        SchedMoe<false> S{F.G, F.vcu, 1024, 4, (const bf16*)(F.ws + WS_WDN), F.cl, nullptr};
        EpiDown E{(bf16*)(F.ws + WS_YROWS), F.b_dn};
        pg8::gemm_phase<EpiDown, SchedMoe<false>>(F.lds, (const bf16*)(F.ws + WS_ACT), 1024, S, E);
        SEAM(9);
    }
    if (IN(10)) { build_mt_table(F); phase_final(F); }
#undef IN
#undef SEAM
}

extern "C" void kernel_launch(void* const* d_in, const int* in_sizes, int n_in, void* d_out, int out_size, void* d_ws, size_t ws_size, hipStream_t stream) {
    static int grid = 0;
    if (grid == 0) {
        if (n_in != 24 || out_size != TL * D || ws_size < WS_END) { fprintf(stderr, "kernel_launch: unexpected shapes (n_in %d out %d ws %zu); nothing launched\n", n_in, out_size, ws_size); grid = -1; return; }
        int dev = 0, cus = 0;
        if (hipGetDevice(&dev) != hipSuccess || hipDeviceGetAttribute(&cus, hipDeviceAttributeMultiprocessorCount, dev) != hipSuccess) { grid = -1; return; }
        if (hipFuncSetAttribute((const void*)mk_fwd, hipFuncAttributeMaxDynamicSharedMemorySize, LDS_BYTES) != hipSuccess) { fprintf(stderr, "kernel_launch: hipFuncSetAttribute failed\n"); grid = -1; return; }
        int per_cu = 0;
        if (hipOccupancyMaxActiveBlocksPerMultiprocessor(&per_cu, (const void*)mk_fwd, NWAVES * 64, LDS_BYTES) != hipSuccess || per_cu < 1) fprintf(stderr, "kernel_launch: occupancy query says %d\n", per_cu);
        (void)hipGetLastError();
        grid = cus;
    }
    if (grid < 0) return;
    (void)hipMemsetAsync((char*)d_ws + WS_CTL, 0, CTL_ZERO_BYTES, stream);
    Args a{};
    for (int i = 0; i < 24; ++i) a.in[i] = (const float*)d_in[i];
    a.out = (float*)d_out; a.ws = (unsigned char*)d_ws;
#if MK_ONE_LAUNCH
    a.ph_lo = 0; a.ph_hi = NPHASE;
    hipLaunchKernelGGL(mk_fwd, dim3(grid), dim3(NWAVES * 64), LDS_BYTES, stream, a);
#else
    for (int p = 0; p < NPHASE; ++p) { a.ph_lo = p; a.ph_hi = p + 1; hipLaunchKernelGGL(mk_fwd, dim3(grid), dim3(NWAVES * 64), LDS_BYTES, stream, a); }
#endif
}
```

```cpp
#include <hip/hip_runtime.h>
#include <cstdio>
#include <cstdint>

#ifndef MK_ONE_LAUNCH
#define MK_ONE_LAUNCH 1
#endif

#define LAS __attribute__((address_space(3)))
#define GAS __attribute__((address_space(1)))
typedef unsigned short bf16;
typedef short bf16x8 __attribute__((ext_vector_type(8)));
typedef float f32x4 __attribute__((ext_vector_type(4)));
typedef float f32x2 __attribute__((ext_vector_type(2)));
typedef unsigned u32x4 __attribute__((ext_vector_type(4)));
typedef unsigned u32x2 __attribute__((ext_vector_type(2)));
typedef GAS unsigned gu32;

constexpr int D = 1024, NB = 16, SEQ = 2048, CTXL = 256;
constexpr int TL = NB * SEQ;
constexpr int TC = NB * CTXL;
constexpr int TT = TL + TC;
constexpr int IN_W = 5664, X0 = 1024, B0 = 2048, C0 = 2304, DT0 = 2560, SC0 = 2592;
constexpr int NE = 32, TOPK = 4, DFF = 1024;
constexpr int XBCW = 1536;
constexpr int NT_IN = 23;
constexpr int CAP = TL;
constexpr int ACT_ROWS = TL * TOPK + NE * 256;
constexpr float NORM_EPS = 1e-6f;

constexpr size_t MiB = 1u << 20;
constexpr size_t WS_CTL = 0, CTL_ZERO_BYTES = 1 * MiB;
constexpr size_t WS_MOD = 1 * MiB;
constexpr size_t WS_TOKES = 2 * MiB;
constexpr size_t WS_TOKG = 2 * MiB + 512 * 1024;
constexpr size_t WS_ROWTOK = 3 * MiB;
constexpr size_t WS_WIN = 7 * MiB;
constexpr size_t WS_WOUT = 19 * MiB;
constexpr size_t WS_WGU = 23 * MiB;
constexpr size_t WS_WDN = 151 * MiB;
constexpr size_t WS_HX = 215 * MiB;
constexpr size_t WS_XRAW = 287 * MiB;
constexpr size_t WS_XBC = 395 * MiB;
constexpr size_t WS_DT = 503 * MiB;
constexpr size_t WS_SZ = 508 * MiB;
constexpr size_t WS_SCB = 572 * MiB;
constexpr size_t WS_CU = 636 * MiB;
constexpr size_t WS_YF = 700 * MiB;
constexpr size_t WS_YB = 764 * MiB;
constexpr size_t WS_A2 = 828 * MiB;
constexpr size_t WS_ACT = 287 * MiB;
constexpr size_t WS_YROWS = 572 * MiB;
constexpr size_t WS_END = 956 * MiB;
constexpr int CW_ECNT = 64;
constexpr int CW_BAR = 4096;

constexpr int LDS_BYTES = 147456;
constexpr int CTLDS_OFF = 146432;
constexpr int LW_BARST = 0;
constexpr int LW_MTS = 16;
constexpr int LW_CNT = 64;

constexpr int NWAVES = 8;

#define LDS_WAIT() asm volatile("s_waitcnt lgkmcnt(0)" ::: "memory")
#define VM_WAIT() asm volatile("s_waitcnt vmcnt(0)" ::: "memory")
#define RLX_AGENT __ATOMIC_RELAXED, __HIP_MEMORY_SCOPE_AGENT

__device__ __forceinline__ unsigned f2bf(float f) { unsigned u = __builtin_bit_cast(unsigned, f); return (u + 0x7fffu + ((u >> 16) & 1u)) >> 16; }
__device__ __forceinline__ unsigned pk2(float lo, float hi) { return f2bf(lo) | (f2bf(hi) << 16); }
__device__ __forceinline__ float bf2f(unsigned b) { return __builtin_bit_cast(float, b << 16); }
__device__ __forceinline__ float bflo(unsigned w) { return __builtin_bit_cast(float, w << 16); }
__device__ __forceinline__ float bfhi(unsigned w) { return __builtin_bit_cast(float, w & 0xffff0000u); }
__device__ __forceinline__ float fsilu(float x) { return x * __builtin_amdgcn_rcpf(1.0f + __expf(-x)); }
__device__ __forceinline__ float wave_sum(float v) {
#pragma unroll
    for (int o = 1; o < 64; o <<= 1) v += __shfl_xor(v, o);
    return v;
}

#define XB_TMO      128
#define XB_XCNT(j)  (256  + 64 * (j))
#define XB_XSUB(j)  (1280 + 64 * (j))
#define XB_XGEN(j)  (2304 + 64 * (j))
#define XB_TOP      3328
#define XB_TOPGEN   3392
#define XCD_BAR_WORDS 3456
#define XB_SPIN_CAP (1u << 18)
__device__ __forceinline__ unsigned xb_ld(unsigned* p)              { return __hip_atomic_load(p, __ATOMIC_RELAXED, __HIP_MEMORY_SCOPE_AGENT); }
__device__ __forceinline__ unsigned xb_add(unsigned* p, unsigned v) { return __hip_atomic_fetch_add(p, v, __ATOMIC_RELAXED, __HIP_MEMORY_SCOPE_AGENT); }
__device__ __forceinline__ unsigned xb_xcc_id() { return (unsigned)__builtin_amdgcn_s_getreg((3 << 11) | 20) & 0xFu; }
#define XB_SPIN(cond, bar) do { unsigned _sp = 0; while (cond) { __builtin_amdgcn_s_sleep(1); \
    if ((++_sp & 255u) == 0u) { if (xb_ld(&(bar)[XB_TMO])) break; if (_sp > XB_SPIN_CAP) { atomicAdd(&(bar)[XB_TMO], 1u); break; } } } } while (0)
struct XcdBarrier { unsigned* bar; unsigned x; volatile LAS unsigned* st; };
__device__ __forceinline__ XcdBarrier xcd_barrier_post(unsigned* bar, volatile LAS unsigned* st) {
    XcdBarrier b; b.bar = bar; b.x = xb_xcc_id(); b.st = st;
    if (threadIdx.x == 0) (void)xb_add(&bar[XB_XCNT(b.x)], 1u);
    return b;
}
__device__ __forceinline__ void xcd_barrier_complete(unsigned* bar, unsigned x, unsigned& nloc, unsigned& nx) {
    const unsigned G = gridDim.x * gridDim.y * gridDim.z;
    unsigned sum, cnt, mine, sp = 0u;
    for (;;) {
        sum = 0u; cnt = 0u; mine = 0u;
#pragma unroll
        for (unsigned j = 0; j < 16; ++j) { const unsigned c = xb_ld(&bar[XB_XCNT(j)]); sum += c; cnt += (c > 0u) ? 1u : 0u; mine = (j == x) ? c : mine; }
        if (sum == G) break;
        __builtin_amdgcn_s_sleep(1);
        if ((++sp & 255u) == 0u) { if (xb_ld(&bar[XB_TMO])) break; if (sp > XB_SPIN_CAP) { atomicAdd(&bar[XB_TMO], 1u); break; } }
    }
    nloc = mine > 0u ? mine : 1u; nx = cnt > 0u ? cnt : 1u;
}
__device__ __forceinline__ void xcd_barrier(const XcdBarrier& b) {
    asm volatile("s_waitcnt vmcnt(0)" ::: "memory");
    __syncthreads();
    if (threadIdx.x == 0) {
        unsigned* bar = b.bar;
        __builtin_amdgcn_s_waitcnt(0);
        unsigned nloc = b.st[0], nx = b.st[1];
        if (nloc == 0u) { xcd_barrier_complete(bar, b.x, nloc, nx); b.st[0] = nloc; b.st[1] = nx; }
        const unsigned old = xb_add(&bar[XB_XSUB(b.x)], 1u);
        const unsigned gen = old / nloc;
        if (old + 1u == (gen + 1u) * nloc) {
            __builtin_amdgcn_fence(__ATOMIC_RELEASE, "agent");
            asm volatile("s_waitcnt vmcnt(0)" ::: "memory");
            const unsigned og = xb_add(&bar[XB_TOP], 1u);
            const unsigned tg = og / nx;
            if (og + 1u == (tg + 1u) * nx) xb_add(&bar[XB_TOPGEN], 1u);
            else XB_SPIN(xb_ld(&bar[XB_TOPGEN]) == tg, bar);
            __builtin_amdgcn_fence(__ATOMIC_ACQUIRE, "agent");
            xb_add(&bar[XB_XGEN(b.x)], 1u);
            asm volatile("s_waitcnt vmcnt(0)" ::: "memory");
        } else {
            XB_SPIN(xb_ld(&bar[XB_XGEN(b.x)]) == gen, bar);
            __builtin_amdgcn_fence(__ATOMIC_ACQUIRE, "agent");
            asm volatile("s_waitcnt vmcnt(0)" ::: "memory");
        }
    }
    __syncthreads();
}

struct Args { const float* in[24]; float* out; unsigned char* ws; int ph_lo, ph_hi; };
struct Frame {
    LAS unsigned char* lds;
    volatile LAS unsigned* cl;
    unsigned char* ws;
    gu32* ctl;
    int tid, lane, wave, vcu, G;
    const float *x, *c, *ctx, *c_ctx, *w_mod, *b_mod, *norm1_g, *w_in, *conv_w, *conv_b, *dt_bias, *a_log, *ssd_d, *ssd_norm_g, *sc_conv_w, *w_out, *norm2_g, *w_router, *b_router, *w_gu, *b_gu, *w_dn, *b_dn, *final_g;
    float* out;
};

namespace pg8 {
constexpr int BM = 256, BK = 64, HALF = 128, HTB = HALF * BK * 2, STAGE_BYTES = 8 * HTB;
__device__ __forceinline__ int lds_byte(int r, int c) { const int st = (r >> 4) * 2 + (c >> 5), rr = r & 15, cc = c & 31, ob = rr * 64 + cc * 2; return st * 1024 + (ob ^ (((ob >> 9) & 1) << 5)); }
__device__ __forceinline__ void stage_rc(int b, int& R, int& C) { const int st = b / 1024, sb = b % 1024, swz = sb ^ (((sb >> 9) & 1) << 5); R = (st >> 1) * 16 + swz / 64; C = (st & 1) * 32 + (swz % 64) / 2; }
__device__ __forceinline__ int perm32(int rho) { const int n = rho >> 4, i = rho & 15; return 8 * (i >> 2) + 4 * n + (i & 3); }
__device__ __forceinline__ unsigned cvt_pk_bf16(float lo, float hi) { unsigned r; asm volatile("v_cvt_pk_bf16_f32 %0, %1, %2" : "=v"(r) : "v"(lo), "v"(hi)); return r; }

struct Unit { int pm, pn, e; };

template <class Epi, class Sched>
__device__ __forceinline__ void gemm_phase(LAS unsigned char* lds, const bf16* Aptr, const int K, const Sched& S, const Epi& E) {
    const int tid = threadIdx.x, wid = __builtin_amdgcn_readfirstlane(tid >> 6), lane = tid & 63, wr = wid >> 2, wc = wid & 3, fr = lane & 15, fq = lane >> 4;
    const int nt = K / BK;
    int sR[2], sC[2];
    unsigned voffB[2];
#pragma unroll
    for (int i = 0; i < 2; ++i) { int R, C; stage_rc(tid * 16 + i * 8192, R, C); const int Rb = Epi::PERM ? ((R & ~31) + perm32(R & 31)) : R;
        sR[i] = R; sC[i] = C; voffB[i] = (unsigned)(Rb * K + C) * 2u; }
    const size_t kstep = (size_t)(BK * 2);
    const size_t hstep = (size_t)HALF * K * 2;
    const unsigned ldsw = (unsigned)wid * 1024u;
    const int aoff = lds_byte(wr * 64 + fr, fq * 8), boff = lds_byte(wc * 32 + fr, fq * 8);
    const char* const Abase = (const char*)Aptr;
#define PG8_SA(b, h) (((b) * 2 + (h)) * HTB)
#define PG8_SB(b, h) ((4 + (b) * 2 + (h)) * HTB)
#define PG8_STAGE(bufoff, gbase, voff) do { _Pragma("unroll") for (int _i = 0; _i < 2; ++_i) \
        __builtin_amdgcn_global_load_lds((const unsigned*)((const char*)(gbase) + (voff)[_i]), (LAS unsigned*)(lds + (bufoff) + ldsw + _i * 8192), 16, 0, 0); } while (0)
#define PG8_LDA(dst, b, h) do { _Pragma("unroll") for (int m = 0; m < 4; ++m) _Pragma("unroll") for (int k = 0; k < 2; ++k) dst[m][k] = *(const LAS bf16x8*)(lds + PG8_SA(b, h) + aoff + m * 2048 + k * 1024); } while (0)
#define PG8_LDB(dst, b, h) do { _Pragma("unroll") for (int n = 0; n < 2; ++n) _Pragma("unroll") for (int k = 0; k < 2; ++k) dst[n][k] = *(const LAS bf16x8*)(lds + PG8_SB(b, h) + boff + n * 2048 + k * 1024); } while (0)
#define PG8_MMA(ai, bj, At, Bt) do { __builtin_amdgcn_s_setprio(1); _Pragma("unroll") for (int m = 0; m < 4; ++m) _Pragma("unroll") for (int n = 0; n < 2; ++n) _Pragma("unroll") for (int k = 0; k < 2; ++k) \
        acc[ai][bj][m][n] = __builtin_amdgcn_mfma_f32_16x16x32_bf16(Bt[n][k], At[m][k], acc[ai][bj][m][n], 0, 0, 0); __builtin_amdgcn_s_setprio(0); } while (0)
#define PG8_WAIT_V(n) asm volatile("s_waitcnt vmcnt(" #n ")" ::: "memory")
#define PG8_WAIT_L(n) asm volatile("s_waitcnt lgkmcnt(" #n ")" ::: "memory")
#define PG8_BAR __builtin_amdgcn_s_barrier()
#define PG8_SCHED __builtin_amdgcn_sched_barrier(0)
    Unit cur, nxt; int ui = 0;
    if (!S.next(0, cur)) return;
    f32x4 acc[2][2][4][2];
#pragma unroll
    for (int a = 0; a < 2; ++a)
#pragma unroll
        for (int b = 0; b < 2; ++b)
#pragma unroll
            for (int m = 0; m < 4; ++m)
#pragma unroll
                for (int n = 0; n < 2; ++n) acc[a][b][m][n] = (f32x4){0.f, 0.f, 0.f, 0.f};
    bf16x8 At[4][2], B0[2][2], B1[2][2];
    unsigned va0[2], va1[2];
    S.aoff(cur, sR, sC, va0, va1);
    if (Sched::GATHER) { asm volatile("s_waitcnt vmcnt(0)" ::: "memory"); asm volatile("" : "+v"(va0[0]), "+v"(va0[1]), "+v"(va1[0]), "+v"(va1[1])); }
    const char* cB = S.bbase(cur);
    PG8_STAGE(PG8_SB(0, 0), cB, voffB); PG8_STAGE(PG8_SB(0, 1), cB + hstep, voffB); PG8_STAGE(PG8_SA(0, 0), Abase, va0); PG8_STAGE(PG8_SA(0, 1), Abase, va1);
    if (wr == 1) PG8_BAR;
    PG8_WAIT_V(2); PG8_BAR;
    PG8_STAGE(PG8_SB(1, 0), cB + kstep, voffB); PG8_STAGE(PG8_SA(1, 0), Abase + kstep, va0); PG8_STAGE(PG8_SB(1, 1), cB + hstep + kstep, voffB);
    PG8_WAIT_V(6); PG8_BAR;
    for (;;) {
        const bool has_next = S.next(ui + 1, nxt);
        const char* nB = has_next ? S.bbase(nxt) : cB;
        for (int t = 0; t < nt; t += 2) {
            const bool last = (t == nt - 2);
            const char* a1 = Abase + (size_t)(t + 1) * kstep;
            const char* a2 = last ? Abase : Abase + (size_t)(t + 2) * kstep; const char* b2 = last ? nB : cB + (size_t)(t + 2) * kstep;
            const char* a3 = a2 + kstep; const char* b3 = b2 + kstep;
            unsigned nva0[2], nva1[2];
            nva0[0] = va0[0]; nva0[1] = va0[1]; nva1[0] = va1[0]; nva1[1] = va1[1];
            if (last && has_next) {
                S.aoff(nxt, sR, sC, nva0, nva1);
                if (Sched::GATHER) { asm volatile("s_waitcnt vmcnt(0)" ::: "memory"); asm volatile("" : "+v"(nva0[0]), "+v"(nva0[1]), "+v"(nva1[0]), "+v"(nva1[1])); }
            }
            PG8_LDB(B0, 0, 0); PG8_LDB(B1, 0, 1); PG8_SCHED; PG8_LDA(At, 0, 0); PG8_STAGE(PG8_SA(1, 1), a1, va1);
            PG8_WAIT_V(8); PG8_WAIT_L(0); PG8_BAR; PG8_MMA(0, 0, At, B0); PG8_MMA(0, 1, At, B1); PG8_BAR; PG8_SCHED;
            if (last) { va0[0] = nva0[0]; va0[1] = nva0[1]; va1[0] = nva1[0]; va1[1] = nva1[1]; }
            PG8_LDA(At, 0, 1); PG8_STAGE(PG8_SB(0, 0), b2, voffB); PG8_STAGE(PG8_SB(0, 1), b2 + hstep, voffB); PG8_STAGE(PG8_SA(0, 0), a2, va0);
            PG8_WAIT_V(8); PG8_WAIT_L(0); PG8_BAR; PG8_MMA(1, 0, At, B0); PG8_MMA(1, 1, At, B1); PG8_BAR; PG8_SCHED;
            PG8_LDB(B0, 1, 0); PG8_LDB(B1, 1, 1); PG8_SCHED; PG8_LDA(At, 1, 0); PG8_STAGE(PG8_SA(0, 1), a2, va1);
            PG8_WAIT_V(8); PG8_WAIT_L(0); PG8_BAR; PG8_MMA(0, 0, At, B0); PG8_MMA(0, 1, At, B1); PG8_BAR; PG8_SCHED;
            PG8_LDA(At, 1, 1); PG8_STAGE(PG8_SB(1, 0), b3, voffB); PG8_STAGE(PG8_SB(1, 1), b3 + hstep, voffB); PG8_STAGE(PG8_SA(1, 0), a3, va0);
            PG8_WAIT_V(8); PG8_WAIT_L(0); PG8_BAR; PG8_MMA(1, 0, At, B0); PG8_MMA(1, 1, At, B1); PG8_BAR; PG8_SCHED;
        }
        if (wr == 0) PG8_BAR;
        E(acc, cur, wr, wc, fr, fq);
        if (!has_next) break;
#pragma unroll
        for (int a = 0; a < 2; ++a)
#pragma unroll
            for (int b = 0; b < 2; ++b)
#pragma unroll
                for (int m = 0; m < 4; ++m)
#pragma unroll
                    for (int n = 0; n < 2; ++n) acc[a][b][m][n] = (f32x4){0.f, 0.f, 0.f, 0.f};
        cur = nxt; cB = nB; ++ui;
        if (wr == 1) PG8_BAR;
    }
    PG8_WAIT_V(0);
    PG8_BAR;
#undef PG8_SA
#undef PG8_SB
#undef PG8_STAGE
#undef PG8_LDA
#undef PG8_LDB
#undef PG8_MMA
#undef PG8_WAIT_V
#undef PG8_WAIT_L
#undef PG8_BAR
#undef PG8_SCHED
}
}

using pg8::Unit;
struct SchedIn {
    static constexpr bool GATHER = false;
    int G, v, K; const bf16* Bt;
    __device__ __forceinline__ bool next(int i, Unit& u) const {
        int L = i * G + v; if (L >= 3040) return false;
        if (L < 2944) { const int gid = L / 184, l = L % 184; u.pm = gid * 8 + (l & 7); u.pn = l >> 3; }
        else { L -= 2944; const int gid = L / 48, l = L % 48; u.pm = 128 + gid * 8 + (l & 7); u.pn = l >> 3; }
        u.e = 0; return true;
    }
    __device__ __forceinline__ const char* bbase(const Unit& u) const { return (const char*)Bt + (size_t)u.pn * ((size_t)256 * K * 2); }
    __device__ __forceinline__ void aoff(const Unit& u, const int (&R)[2], const int (&C)[2], unsigned (&v0)[2], unsigned (&v1)[2]) const {
#pragma unroll
        for (int i = 0; i < 2; ++i) { v0[i] = (unsigned)(((u.pm * 256 + R[i]) * K + C[i]) * 2); v1[i] = (unsigned)(((u.pm * 256 + 128 + R[i]) * K + C[i]) * 2); }
    }
};
struct SchedPlain {
    static constexpr bool GATHER = false;
    int G, v, K, nN, nwg; const bf16* Bt;
    __device__ __forceinline__ bool next(int i, Unit& u) const {
        const int L = i * G + v; if (L >= nwg) return false;
        const int per = 8 * nN, gid = L / per, l = L % per; u.pm = gid * 8 + (l & 7); u.pn = l >> 3; u.e = 0; return true;
    }
    __device__ __forceinline__ const char* bbase(const Unit& u) const { return (const char*)Bt + (size_t)u.pn * ((size_t)256 * K * 2); }
    __device__ __forceinline__ void aoff(const Unit& u, const int (&R)[2], const int (&C)[2], unsigned (&v0)[2], unsigned (&v1)[2]) const {
#pragma unroll
        for (int i = 0; i < 2; ++i) { v0[i] = (unsigned)(((u.pm * 256 + R[i]) * K + C[i]) * 2); v1[i] = (unsigned)(((u.pm * 256 + 128 + R[i]) * K + C[i]) * 2); }
    }
};
template <bool GATH> struct SchedMoe {
    static constexpr bool GATHER = GATH;
    int G, v, K, NT; const bf16* Bt; const volatile LAS unsigned* cl; const int* rowtok;
    __device__ __forceinline__ bool next(int i, Unit& u) const {
        const int L = i * G + v; const int mt = L / NT; const int tot = (int)cl[LW_MTS + 32];
        if (mt >= tot) return false;
        int e = 0;
        while (e < 31 && (int)cl[LW_MTS + e + 1] <= mt) ++e;
        u.pm = mt; u.pn = L - mt * NT; u.e = e; return true;
    }
    __device__ __forceinline__ const char* bbase(const Unit& u) const { return (const char*)Bt + ((size_t)u.e * NT + u.pn) * ((size_t)256 * K * 2); }
    __device__ __forceinline__ void aoff(const Unit& u, const int (&R)[2], const int (&C)[2], unsigned (&v0)[2], unsigned (&v1)[2]) const {
        if (GATH) {
            const int i0 = (u.pm - (int)cl[LW_MTS + u.e]) * 256, cnt = (int)cl[LW_CNT + u.e];
            const int* rt = rowtok + (size_t)u.e * CAP;
#pragma unroll
            for (int i = 0; i < 2; ++i) {
                int s0 = i0 + R[i], s1 = i0 + 128 + R[i]; s0 = s0 < cnt ? s0 : 0; s1 = s1 < cnt ? s1 : 0;
                const int t0 = rt[s0], t1 = rt[s1];
                v0[i] = (unsigned)((t0 * K + C[i]) * 2); v1[i] = (unsigned)((t1 * K + C[i]) * 2);
            }
        } else {
#pragma unroll
            for (int i = 0; i < 2; ++i) { v0[i] = (unsigned)(((u.pm * 256 + R[i]) * K + C[i]) * 2); v1[i] = (unsigned)(((u.pm * 256 + 128 + R[i]) * K + C[i]) * 2); }
        }
    }
};

__device__ __forceinline__ float softplusf(float x) { return x > 20.f ? x : log1pf(__expf(x)); }

struct EpiIn {
    static constexpr bool PERM = true;
    bf16* xraw; float* dt; bf16* sz; bf16* scb; bf16* cu; const float* dt_bias;
    __device__ __forceinline__ void operator()(const f32x4 (&acc)[2][2][4][2], const Unit& u, int wr, int wc, int fr, int fq) const {
        const int row0 = u.pm * 256 + wr * 64 + fr, pn = u.pn, cl = wc * 32 + 8 * fq;
        if (pn <= 4 || pn == 6 || (pn >= 11 && pn <= 14)) {
            bf16* base; int ld;
            if (pn <= 4) { base = xraw + pn * 256; ld = XBCW; } else if (pn == 6) { base = xraw + 1280; ld = XBCW; } else { base = scb + (pn - 11) * 256; ld = 1024; }
#pragma unroll
            for (int ai = 0; ai < 2; ++ai)
#pragma unroll
                for (int m = 0; m < 4; ++m) { bf16* rowp = base + (size_t)(row0 + ai * 128 + m * 16) * ld + cl;
#pragma unroll
                    for (int bj = 0; bj < 2; ++bj) { const f32x4 v0 = acc[ai][bj][m][0], v1 = acc[ai][bj][m][1];
                        u32x4 w; w.x = pg8::cvt_pk_bf16(v0[0], v0[1]); w.y = pg8::cvt_pk_bf16(v0[2], v0[3]); w.z = pg8::cvt_pk_bf16(v1[0], v1[1]); w.w = pg8::cvt_pk_bf16(v1[2], v1[3]);
                        *(u32x4*)(rowp + bj * 128) = w; } }
        } else if (pn == 5) {
            if (wc == 0) {
                const f32x4 b0 = *(const f32x4*)(dt_bias + 8 * fq), b1 = *(const f32x4*)(dt_bias + 8 * fq + 4);
#pragma unroll
                for (int ai = 0; ai < 2; ++ai)
#pragma unroll
                    for (int m = 0; m < 4; ++m) { float* rowp = dt + (size_t)(row0 + ai * 128 + m * 16) * 32 + 8 * fq;
                        const f32x4 v0 = acc[ai][0][m][0] + b0, v1 = acc[ai][0][m][1] + b1; f32x4 o0, o1;
#pragma unroll
                        for (int j = 0; j < 4; ++j) { o0[j] = softplusf(v0[j]); o1[j] = softplusf(v1[j]); }
                        *(f32x4*)rowp = o0; *(f32x4*)(rowp + 4) = o1; }
            }
        } else if (pn <= 10) {
            bf16* base = sz + (pn - 7) * 256;
#pragma unroll
            for (int ai = 0; ai < 2; ++ai)
#pragma unroll
                for (int m = 0; m < 4; ++m) { bf16* rowp = base + (size_t)(row0 + ai * 128 + m * 16) * 1024 + cl;
#pragma unroll
                    for (int bj = 0; bj < 2; ++bj) { f32x4 v0 = acc[ai][bj][m][0], v1 = acc[ai][bj][m][1];
#pragma unroll
                        for (int j = 0; j < 4; ++j) { v0[j] = fsilu(v0[j]); v1[j] = fsilu(v1[j]); }
                        u32x4 w; w.x = pg8::cvt_pk_bf16(v0[0], v0[1]); w.y = pg8::cvt_pk_bf16(v0[2], v0[3]); w.z = pg8::cvt_pk_bf16(v1[0], v1[1]); w.w = pg8::cvt_pk_bf16(v1[2], v1[3]);
                        *(u32x4*)(rowp + bj * 128) = w; } }
        } else {
            bf16* base = cu + (pn - 15) * 128;
#pragma unroll
            for (int ai = 0; ai < 2; ++ai)
#pragma unroll
                for (int m = 0; m < 4; ++m) { bf16* rowp = base + (size_t)(row0 + ai * 128 + m * 16) * 1024 + cl;
                    const f32x4 v0 = acc[ai][0][m][0] * acc[ai][1][m][0], v1 = acc[ai][0][m][1] * acc[ai][1][m][1];
                    u32x4 w; w.x = pg8::cvt_pk_bf16(v0[0], v0[1]); w.y = pg8::cvt_pk_bf16(v0[2], v0[3]); w.z = pg8::cvt_pk_bf16(v1[0], v1[1]); w.w = pg8::cvt_pk_bf16(v1[2], v1[3]);
                    *(u32x4*)rowp = w; }
        }
    }
};
struct EpiOut {
    static constexpr bool PERM = false;
    const float* x; float* out; const float* mod;
    __device__ __forceinline__ void operator()(const f32x4 (&acc)[2][2][4][2], const Unit& u, int wr, int wc, int fr, int fq) const {
        const int row0 = u.pm * 256 + wr * 64 + fr, col0 = u.pn * 256 + wc * 32 + 4 * fq, b = u.pm >> 3;
        f32x4 gv[2][2];
#pragma unroll
        for (int bj = 0; bj < 2; ++bj)
#pragma unroll
            for (int n = 0; n < 2; ++n) gv[bj][n] = *(const f32x4*)(mod + (size_t)b * 6144 + 2048 + col0 + bj * 128 + n * 16);
#pragma unroll
        for (int ai = 0; ai < 2; ++ai)
#pragma unroll
            for (int m = 0; m < 4; ++m) { const size_t off = (size_t)(row0 + ai * 128 + m * 16) * 1024 + col0;
#pragma unroll
                for (int bj = 0; bj < 2; ++bj)
#pragma unroll
                    for (int n = 0; n < 2; ++n) { const f32x4 xv = *(const f32x4*)(x + off + bj * 128 + n * 16);
                        *(f32x4*)(out + off + bj * 128 + n * 16) = xv + gv[bj][n] * acc[ai][bj][m][n]; }
                asm volatile("" ::: "memory"); }
    }
};
struct EpiGU {
    static constexpr bool PERM = true;
    bf16* act; const float* bgu;
    __device__ __forceinline__ void operator()(const f32x4 (&acc)[2][2][4][2], const Unit& u, int wr, int wc, int fr, int fq) const {
        const int row0 = u.pm * 256 + wr * 64 + fr, cl = wc * 32 + 8 * fq, ch0 = u.pn * 128 + cl;
        const float* bp = bgu + (size_t)u.e * 2048 + ch0;
        const f32x4 bg0 = *(const f32x4*)bp, bg1 = *(const f32x4*)(bp + 4), bl0 = *(const f32x4*)(bp + 1024), bl1 = *(const f32x4*)(bp + 1028);
#pragma unroll
        for (int ai = 0; ai < 2; ++ai)
#pragma unroll
            for (int m = 0; m < 4; ++m) { bf16* rowp = act + (size_t)(row0 + ai * 128 + m * 16) * 1024 + ch0;
                f32x4 g0 = acc[ai][0][m][0] + bg0, g1 = acc[ai][0][m][1] + bg1, l0 = acc[ai][1][m][0] + bl0, l1 = acc[ai][1][m][1] + bl1, o0, o1;
#pragma unroll
                for (int j = 0; j < 4; ++j) {
                    const float ga = fminf(g0[j], 7.f), gb = fminf(g1[j], 7.f);
                    const float la = fminf(fmaxf(l0[j], -7.f), 7.f), lb = fminf(fmaxf(l1[j], -7.f), 7.f);
                    o0[j] = ga * __builtin_amdgcn_rcpf(1.0f + __expf(-1.702f * ga)) * (la + 1.0f);
                    o1[j] = gb * __builtin_amdgcn_rcpf(1.0f + __expf(-1.702f * gb)) * (lb + 1.0f); }
                u32x4 w; w.x = pg8::cvt_pk_bf16(o0[0], o0[1]); w.y = pg8::cvt_pk_bf16(o0[2], o0[3]); w.z = pg8::cvt_pk_bf16(o1[0], o1[1]); w.w = pg8::cvt_pk_bf16(o1[2], o1[3]);
                *(u32x4*)rowp = w; }
    }
};
struct EpiDown {
    static constexpr bool PERM = true;
    bf16* y; const float* bdn;
    __device__ __forceinline__ void operator()(const f32x4 (&acc)[2][2][4][2], const Unit& u, int wr, int wc, int fr, int fq) const {
        const int row0 = u.pm * 256 + wr * 64 + fr, col0 = u.pn * 256 + wc * 32 + 8 * fq;
        const float* bp = bdn + (size_t)u.e * 1024 + col0;
        f32x4 bv[2][2];
#pragma unroll
        for (int bj = 0; bj < 2; ++bj) { bv[bj][0] = *(const f32x4*)(bp + bj * 128); bv[bj][1] = *(const f32x4*)(bp + bj * 128 + 4); }
#pragma unroll
        for (int ai = 0; ai < 2; ++ai)
#pragma unroll
            for (int m = 0; m < 4; ++m) { bf16* rowp = y + (size_t)(row0 + ai * 128 + m * 16) * 1024 + col0;
#pragma unroll
                for (int bj = 0; bj < 2; ++bj) { const f32x4 v0 = acc[ai][bj][m][0] + bv[bj][0], v1 = acc[ai][bj][m][1] + bv[bj][1];
                    u32x4 w; w.x = pg8::cvt_pk_bf16(v0[0], v0[1]); w.y = pg8::cvt_pk_bf16(v0[2], v0[3]); w.z = pg8::cvt_pk_bf16(v1[0], v1[1]); w.w = pg8::cvt_pk_bf16(v1[2], v1[3]);
                    *(u32x4*)(rowp + bj * 128) = w; } }
    }
};

__device__ __forceinline__ void p0_item(const float* W, int ldw, int K, int k0, int n0, bf16* WT, int drow0, const float* kscale, LAS float* scr, int lane) {
#pragma unroll 8
    for (int i = 0; i < 32; ++i) { const int kk = 2 * i + (lane >> 5); float w = W[(size_t)(k0 + kk) * ldw + n0 + (lane & 31)]; if (kscale) w *= kscale[k0 + kk]; scr[kk * 33 + (lane & 31)] = w; }
    LDS_WAIT(); asm volatile("" ::: "memory");
    const int c = lane & 7;
#pragma unroll
    for (int j = 0; j < 4; ++j) { const int n = (lane >> 3) + 8 * j; const LAS float* s = scr + (8 * c) * 33 + n;
        u32x4 o; o.x = pk2(s[0 * 33], s[1 * 33]); o.y = pk2(s[2 * 33], s[3 * 33]); o.z = pk2(s[4 * 33], s[5 * 33]); o.w = pk2(s[6 * 33], s[7 * 33]);
        *(u32x4*)(WT + (size_t)(drow0 + n) * K + k0 + 8 * c) = o; }
    LDS_WAIT(); asm volatile("" ::: "memory");
}
__device__ __forceinline__ int win_drow(int n) {
    if (n < X0) return (7 + (n >> 8)) * 256 + (n & 255);
    if (n < B0) return n - X0;
    if (n < C0) return 4 * 256 + (n - B0);
    if (n < DT0) return 6 * 256 + (n - C0);
    if (n < SC0) return 5 * 256 + (n - DT0);
    n -= SC0;
    if (n < 1024) return (11 + (n >> 8)) * 256 + (n & 255);
    if (n < 2048) { n -= 1024; return (15 + (n >> 7)) * 256 + (n & 127); }
    n -= 2048; return (15 + (n >> 7)) * 256 + 128 + (n & 127);
}
__device__ __forceinline__ void phase0(Frame& F) {
    float* mod = (float*)(F.ws + WS_MOD);
    for (int it = F.vcu; it < 192; it += F.G) {
        LAS float* sc = (LAS float*)F.lds;
        LAS float* red = (LAS float*)(F.lds + 69632);
        for (int i = F.tid; i < 17 * 1024; i += 512) { const int r = i >> 10, k = i & 1023; const float v = (r < 16) ? F.c[r * 1024 + k] : F.c_ctx[k]; sc[i] = fsilu(v); }
        __syncthreads();
        const int col = F.tid & 31, kg = F.tid >> 5, n0 = it * 32;
        float acc[17];
#pragma unroll
        for (int r = 0; r < 17; ++r) acc[r] = 0.f;
        for (int q = 0; q < 16; ++q) {
            const int k = 4 * (kg + 16 * q);
            const float w0 = F.w_mod[(size_t)(k + 0) * 6144 + n0 + col], w1 = F.w_mod[(size_t)(k + 1) * 6144 + n0 + col], w2 = F.w_mod[(size_t)(k + 2) * 6144 + n0 + col], w3 = F.w_mod[(size_t)(k + 3) * 6144 + n0 + col];
#pragma unroll
            for (int r = 0; r < 17; ++r) { const f32x4 s = *(const LAS f32x4*)(sc + r * 1024 + k); acc[r] += s[0] * w0 + s[1] * w1 + s[2] * w2 + s[3] * w3; }
        }
#pragma unroll
        for (int r = 0; r < 17; ++r) red[(kg * 17 + r) * 32 + col] = acc[r];
        __syncthreads();
        for (int o = F.tid; o < 17 * 32; o += 512) { const int r = o >> 5, cc = o & 31; float s = F.b_mod[n0 + cc];
            for (int g = 0; g < 16; ++g) s += red[(g * 17 + r) * 32 + cc];
            mod[(size_t)r * 6144 + n0 + cc] = s; }
        __syncthreads();
    }
    LAS float* scr = (LAS float*)(F.lds + F.wave * 8448);
    const int gw = F.vcu * NWAVES + F.wave, NGW = F.G * NWAVES;
    constexpr int I_IN = 16 * 177, I_OUT = 32 * 32, I_GU = 32 * 16 * 64, I_DN = 32 * 16 * 32;
    bf16* win = (bf16*)(F.ws + WS_WIN); bf16* wout = (bf16*)(F.ws + WS_WOUT); bf16* wgu = (bf16*)(F.ws + WS_WGU); bf16* wdn = (bf16*)(F.ws + WS_WDN);
    for (int it = gw; it < I_IN + I_OUT + I_GU + I_DN; it += NGW) {
        int r = it;
        if (r < I_IN) { const int kb = r / 177, nb = r % 177; p0_item(F.w_in, IN_W, 1024, kb * 64, nb * 32, win, win_drow(nb * 32), nullptr, scr, F.lane); continue; } r -= I_IN;
        if (r < I_OUT) { const int kb = r >> 5, nb = r & 31; p0_item(F.w_out, 1024, 2048, kb * 64, nb * 32, wout, nb * 32, kb < 16 ? F.ssd_norm_g : nullptr, scr, F.lane); continue; } r -= I_OUT;
        if (r < I_GU) { const int e = r >> 10, q = r & 1023, kb = q >> 6, nb = q & 63; const int n = nb * 32;
            const int drow = n < 1024 ? (n >> 7) * 256 + (n & 127) : ((n - 1024) >> 7) * 256 + 128 + ((n - 1024) & 127);
            p0_item(F.w_gu + (size_t)e * 1024 * 2048, 2048, 1024, kb * 64, n, wgu + (size_t)e * 2048 * 1024, drow, nullptr, scr, F.lane); continue; } r -= I_GU;
        { const int e = r >> 9, q = r & 511, kb = q >> 5, nb = q & 31;
            p0_item(F.w_dn + (size_t)e * 1024 * 1024, 1024, 1024, kb * 64, nb * 32, wdn + (size_t)e * 1024 * 1024, nb * 32, nullptr, scr, F.lane); }
    }
}

__device__ __forceinline__ void phase1(Frame& F) {
    const float* mod = (const float*)(F.ws + WS_MOD); bf16* hx = (bf16*)(F.ws + WS_HX);
    const int gw = F.vcu * NWAVES + F.wave, NGW = F.G * NWAVES;
    for (int row = gw; row < TT; row += NGW) {
        const float* src = row < TL ? F.x + (size_t)row * 1024 : F.ctx + (size_t)(row - TL) * 1024;
        const int mb = row < TL ? (row >> 11) : 16;
        const float* shift = mod + (size_t)mb * 6144, *scale = shift + 1024;
        f32x4 v[4]; float s = 0.f;
#pragma unroll
        for (int j = 0; j < 4; ++j) { v[j] = *(const f32x4*)(src + 4 * F.lane + 256 * j); s += (v[j][0] * v[j][0] + v[j][1] * v[j][1]) + (v[j][2] * v[j][2] + v[j][3] * v[j][3]); }
        const float rs = 1.0f / sqrtf(wave_sum(s) * (1.f / 1024.f) + NORM_EPS);
#pragma unroll
        for (int j = 0; j < 4; ++j) { const int c = 4 * F.lane + 256 * j;
            const f32x4 g = *(const f32x4*)(F.norm1_g + c), sh = *(const f32x4*)(shift + c), sc = *(const f32x4*)(scale + c);
            const f32x4 o = v[j] * rs * g * (sc + 1.0f) + sh;
            u32x2 w; w.x = pk2(o[0], o[1]); w.y = pk2(o[2], o[3]);
            *(u32x2*)(hx + (size_t)row * 1024 + c) = w; }
    }
}

__device__ __forceinline__ void unpack8(const u32x4 w, float (&f)[8]) { f[0] = bflo(w.x); f[1] = bfhi(w.x); f[2] = bflo(w.y); f[3] = bfhi(w.y); f[4] = bflo(w.z); f[5] = bfhi(w.z); f[6] = bflo(w.w); f[7] = bfhi(w.w); }
__device__ __forceinline__ void phase_conv(Frame& F) {
    const bf16* xraw = (const bf16*)(F.ws + WS_XRAW); bf16* xbc = (bf16*)(F.ws + WS_XBC);
    if (F.tid >= 384) return;
    const int cp = F.tid % 192, rs = F.tid / 192, c0 = cp * 8;
    float w0[8], w1[8], w2[8], bb[8];
#pragma unroll
    for (int e = 0; e < 8; ++e) { w0[e] = F.conv_w[c0 + e]; w1[e] = F.conv_w[XBCW + c0 + e]; w2[e] = F.conv_w[2 * XBCW + c0 + e]; bb[e] = F.conv_b[c0 + e]; }
    for (int it = F.vcu; it < TT / 32; it += F.G) {
        const int r0 = it * 32 + rs * 16;
        const bool isctx = r0 >= TL;
        if (isctx && c0 >= 1280) continue;
        const int L = isctx ? CTXL : SEQ, t0 = isctx ? ((r0 - TL) & (CTXL - 1)) : (r0 & (SEQ - 1));
        const u32x4 zero = (u32x4){0u, 0u, 0u, 0u};
        u32x4 prev = (t0 > 0) ? *(const u32x4*)(xraw + (size_t)(r0 - 1) * XBCW + c0) : zero;
        u32x4 cur = *(const u32x4*)(xraw + (size_t)r0 * XBCW + c0);
#pragma unroll 4
        for (int i = 0; i < 16; ++i) {
            const u32x4 nxt = (t0 + i + 1 < L) ? *(const u32x4*)(xraw + (size_t)(r0 + i + 1) * XBCW + c0) : zero;
            float a[8], b[8], c[8], o[8]; unpack8(prev, a); unpack8(cur, b); unpack8(nxt, c);
#pragma unroll
            for (int e = 0; e < 8; ++e) o[e] = fsilu(w0[e] * a[e] + w1[e] * b[e] + w2[e] * c[e] + bb[e]);
            u32x4 w; w.x = pk2(o[0], o[1]); w.y = pk2(o[2], o[3]); w.z = pk2(o[4], o[5]); w.w = pk2(o[6], o[7]);
            *(u32x4*)(xbc + (size_t)(r0 + i) * XBCW + c0) = w;
            prev = cur; cur = nxt;
        }
    }
}

namespace ssd {
constexpr int LDC = 136, LDJ = 72;
constexpr int S_CC = 0, S_BC = 17408, S_BT = 34816, S_XT = 53248, S_G = 62464, S_HB = 71680, S_CS = 89088, S_DTV = 89344, S_W = 89600, S_TOT = 89856;
__device__ __forceinline__ bf16x8 ldfrag(const LAS unsigned char* base, int row, int ld, int k) { return *(const LAS bf16x8*)(base + (size_t)(row * ld + k) * 2); }
}
__device__ __forceinline__ void phase_ssd(Frame& F) {
    using namespace ssd;
    const bf16* xbc = (const bf16*)(F.ws + WS_XBC); const float* dtb = (const float*)(F.ws + WS_DT);
    LAS unsigned char* L = F.lds;
    LAS float* cs = (LAS float*)(L + S_CS); LAS float* dtv = (LAS float*)(L + S_DTV); LAS float* wv = (LAS float*)(L + S_W); LAS float* tot = (LAS float*)(L + S_TOT);
    const int tid = F.tid, lane = F.lane, w = F.wave, fr = lane & 15, fq = lane >> 4;
    for (int it = F.vcu; it < 512; it += F.G) {
        const int b = it >> 5, h = (it >> 1) & 15, dir = it & 1, g = h >> 3;
        const float a = -__expf(F.a_log[dir * 16 + h]);
        const int dtcol = dir * 16 + h;
        bf16* ydir = (bf16*)(F.ws + (dir ? WS_YB : WS_YF));
        f32x4 Hacc[4];
#pragma unroll
        for (int tp = 0; tp < 4; ++tp) Hacc[tp] = (f32x4){0.f, 0.f, 0.f, 0.f};
        for (int s = 0; s < 36; ++s) {
            const bool isctx = s < 4;
            int rowbase;
            if (isctx) rowbase = TL + b * CTXL + (dir ? (3 - s) : s) * 64;
            else rowbase = b * SEQ + (dir ? (35 - s) : (s - 4)) * 64;
            if (w == 0) {
                const int j = dir ? (63 - lane) : lane;
                const float dtj = dtb[(size_t)(rowbase + j) * 32 + dtcol];
                float v = dtj * a;
#pragma unroll
                for (int o = 1; o < 64; o <<= 1) { const float t = __shfl_up(v, o); if (lane >= o) v += t; }
                const float total = __shfl(v, 63);
                cs[j] = v; dtv[j] = dtj; wv[j] = __expf(total - v) * dtj;
                if (lane == 0) tot[0] = total;
            }
            u32x4 cR[2], bR[2]; unsigned short btR[2][8], xtR[8];
#pragma unroll
            for (int q2 = 0; q2 < 2; ++q2) { const int q = tid + 512 * q2, row = q >> 4, n8 = q & 15;
                const bf16* p = xbc + (size_t)(rowbase + row) * XBCW + 1024 + g * 128 + n8 * 8;
                bR[q2] = *(const u32x4*)p;
                cR[q2] = isctx ? (u32x4){0u, 0u, 0u, 0u} : *(const u32x4*)(p + 256); }
#pragma unroll
            for (int q2 = 0; q2 < 2; ++q2) { const int q = tid + 512 * q2, n = q & 127, j8 = q >> 7;
                const bf16* p = xbc + (size_t)(rowbase + j8 * 8) * XBCW + 1024 + g * 128 + n;
#pragma unroll
                for (int e = 0; e < 8; ++e) btR[q2][e] = p[(size_t)e * XBCW]; }
            { const int p_ = tid & 63, j8 = tid >> 6;
                const bf16* p = xbc + (size_t)(rowbase + j8 * 8) * XBCW + h * 64 + p_;
#pragma unroll
                for (int e = 0; e < 8; ++e) xtR[e] = p[(size_t)e * XBCW]; }
            __syncthreads();
#pragma unroll
            for (int q2 = 0; q2 < 2; ++q2) { const int q = tid + 512 * q2, row = q >> 4, n8 = q & 15;
                *(LAS u32x4*)(L + S_BC + (size_t)(row * LDC + n8 * 8) * 2) = bR[q2];
                *(LAS u32x4*)(L + S_CC + (size_t)(row * LDC + n8 * 8) * 2) = cR[q2]; }
#pragma unroll
            for (int q2 = 0; q2 < 2; ++q2) { const int q = tid + 512 * q2, n = q & 127, j8 = q >> 7;
                float f[8];
#pragma unroll
                for (int e = 0; e < 8; ++e) f[e] = bf2f(btR[q2][e]) * wv[j8 * 8 + e];
                u32x4 o; o.x = pk2(f[0], f[1]); o.y = pk2(f[2], f[3]); o.z = pk2(f[4], f[5]); o.w = pk2(f[6], f[7]);
                *(LAS u32x4*)(L + S_BT + (size_t)(n * LDJ + j8 * 8) * 2) = o; }
            { const int p_ = tid & 63, j8 = tid >> 6;
                u32x4 o; o.x = (unsigned)xtR[0] | ((unsigned)xtR[1] << 16); o.y = (unsigned)xtR[2] | ((unsigned)xtR[3] << 16); o.z = (unsigned)xtR[4] | ((unsigned)xtR[5] << 16); o.w = (unsigned)xtR[6] | ((unsigned)xtR[7] << 16);
                *(LAS u32x4*)(L + S_XT + (size_t)(p_ * LDJ + j8 * 8) * 2) = o; }
            __syncthreads();
            if (!isctx) {
#pragma unroll
                for (int q2 = 0; q2 < 2; ++q2) { const int q = w + 8 * q2, tj = q >> 2, ti = q & 3;
                    f32x4 acc = (f32x4){0.f, 0.f, 0.f, 0.f};
                    const bool need = dir ? (tj >= ti) : (tj <= ti);
                    if (need) {
#pragma unroll
                        for (int k0 = 0; k0 < 128; k0 += 32) acc = __builtin_amdgcn_mfma_f32_16x16x32_bf16(ldfrag(L + S_BC, 16 * tj + fr, LDC, k0 + 8 * fq), ldfrag(L + S_CC, 16 * ti + fr, LDC, k0 + 8 * fq), acc, 0, 0, 0);
                    }
                    const int i = 16 * ti + fr; const float csi = cs[i]; float gv[4];
#pragma unroll
                    for (int r = 0; r < 4; ++r) { const int j = 16 * tj + 4 * fq + r; const bool ok = dir ? (j >= i) : (j <= i);
                        const float sg = ok ? (csi - cs[j]) : -1e30f;
                        gv[r] = ok ? acc[r] * __expf(sg) * dtv[j] : 0.f; }
                    u32x2 o; o.x = pk2(gv[0], gv[1]); o.y = pk2(gv[2], gv[3]);
                    *(LAS u32x2*)(L + S_G + (size_t)(i * LDJ + 16 * tj + 4 * fq) * 2) = o; }
                __syncthreads();
#pragma unroll
                for (int q2 = 0; q2 < 2; ++q2) { const int q = w + 8 * q2, tp = q >> 2, ti = q & 3;
                    f32x4 yd = (f32x4){0.f, 0.f, 0.f, 0.f}, yo = (f32x4){0.f, 0.f, 0.f, 0.f};
#pragma unroll
                    for (int k0 = 0; k0 < 64; k0 += 32) yd = __builtin_amdgcn_mfma_f32_16x16x32_bf16(ldfrag(L + S_XT, 16 * tp + fr, LDJ, k0 + 8 * fq), ldfrag(L + S_G, 16 * ti + fr, LDJ, k0 + 8 * fq), yd, 0, 0, 0);
#pragma unroll
                    for (int k0 = 0; k0 < 128; k0 += 32) yo = __builtin_amdgcn_mfma_f32_16x16x32_bf16(ldfrag(L + S_HB, 16 * tp + fr, LDC, k0 + 8 * fq), ldfrag(L + S_CC, 16 * ti + fr, LDC, k0 + 8 * fq), yo, 0, 0, 0);
                    const int i = 16 * ti + fr; const float ei = __expf(cs[i]);
                    const f32x4 y = yd + yo * ei;
                    u32x2 o; o.x = pk2(y[0], y[1]); o.y = pk2(y[2], y[3]);
                    *(u32x2*)(ydir + (size_t)(rowbase + i) * 1024 + h * 64 + 16 * tp + 4 * fq) = o; }
            }
            {
                const float dec = __expf(tot[0]);
#pragma unroll
                for (int tp = 0; tp < 4; ++tp) Hacc[tp] = Hacc[tp] * dec;
#pragma unroll
                for (int k0 = 0; k0 < 64; k0 += 32) { const bf16x8 af = ldfrag(L + S_BT, 16 * w + fr, LDJ, k0 + 8 * fq);
#pragma unroll
                    for (int tp = 0; tp < 4; ++tp) Hacc[tp] = __builtin_amdgcn_mfma_f32_16x16x32_bf16(af, ldfrag(L + S_XT, 16 * tp + fr, LDJ, k0 + 8 * fq), Hacc[tp], 0, 0, 0); }
            }
            __syncthreads();
#pragma unroll
            for (int tp = 0; tp < 4; ++tp) { u32x2 o; o.x = pk2(Hacc[tp][0], Hacc[tp][1]); o.y = pk2(Hacc[tp][2], Hacc[tp][3]);
                *(LAS u32x2*)(L + S_HB + (size_t)((16 * tp + fr) * LDC + 16 * w + 4 * fq) * 2) = o; }
        }
        __syncthreads();
    }
}

__device__ __forceinline__ void phase_combine(Frame& F) {
    const bf16* xbc = (const bf16*)(F.ws + WS_XBC); const bf16* yf = (const bf16*)(F.ws + WS_YF); const bf16* yb = (const bf16*)(F.ws + WS_YB);
    const bf16* sz = (const bf16*)(F.ws + WS_SZ); const bf16* scb = (const bf16*)(F.ws + WS_SCB); const bf16* cu = (const bf16*)(F.ws + WS_CU);
    bf16* a2 = (bf16*)(F.ws + WS_A2);
    const int g = F.wave & 1, sub = F.wave >> 1, c = g * 512 + F.lane * 8;
    const float dsk = F.ssd_d[c >> 6];
    const int c2 = (F.tid & 127) * 8, sub2 = F.tid >> 7;
    float k0[8], k1[8], k2[8];
#pragma unroll
    for (int e = 0; e < 8; ++e) { k0[e] = F.sc_conv_w[c2 + e]; k1[e] = F.sc_conv_w[1024 + c2 + e]; k2[e] = F.sc_conv_w[2048 + c2 + e]; }
    for (int it = F.vcu; it < TL / 64; it += F.G) {
        const int tb = it * 64;
        for (int i = 0; i < 16; ++i) {
            const int t = tb + sub * 16 + i;
            float a[8], b2[8], x[8], z[8], v[8]; float ss = 0.f;
            unpack8(*(const u32x4*)(yf + (size_t)t * 1024 + c), a); unpack8(*(const u32x4*)(yb + (size_t)t * 1024 + c), b2);
            unpack8(*(const u32x4*)(xbc + (size_t)t * XBCW + c), x); unpack8(*(const u32x4*)(sz + (size_t)t * 1024 + c), z);
#pragma unroll
            for (int e = 0; e < 8; ++e) { v[e] = (a[e] + b2[e] + dsk * x[e]) * z[e]; ss += v[e] * v[e]; }
            const float rs = 1.0f / sqrtf(wave_sum(ss) * (1.f / 512.f) + NORM_EPS);
            u32x4 o; o.x = pk2(v[0] * rs, v[1] * rs); o.y = pk2(v[2] * rs, v[3] * rs); o.z = pk2(v[4] * rs, v[5] * rs); o.w = pk2(v[6] * rs, v[7] * rs);
            *(u32x4*)(a2 + (size_t)t * 2048 + c) = o;
        }
        for (int i = 0; i < 16; ++i) {
            const int t = tb + sub2 * 16 + i, tt = t & (SEQ - 1);
            const u32x4 zero = (u32x4){0u, 0u, 0u, 0u};
            float p[8], q[8], n[8], sb[8], o8[8];
            unpack8(tt >= 64 ? *(const u32x4*)(cu + (size_t)(t - 64) * 1024 + c2) : zero, p);
            unpack8(*(const u32x4*)(cu + (size_t)t * 1024 + c2), q);
            unpack8(tt + 64 < SEQ ? *(const u32x4*)(cu + (size_t)(t + 64) * 1024 + c2) : zero, n);
            unpack8(*(const u32x4*)(scb + (size_t)t * 1024 + c2), sb);
#pragma unroll
            for (int e = 0; e < 8; ++e) o8[e] = sb[e] * (k0[e] * p[e] + k1[e] * q[e] + k2[e] * n[e]);
            u32x4 o; o.x = pk2(o8[0], o8[1]); o.y = pk2(o8[2], o8[3]); o.z = pk2(o8[4], o8[5]); o.w = pk2(o8[6], o8[7]);
            *(u32x4*)(a2 + (size_t)t * 2048 + 1024 + c2) = o;
        }
    }
}

__device__ __forceinline__ void phase_router(Frame& F) {
    const float* mod = (const float*)(F.ws + WS_MOD); bf16* h2 = (bf16*)(F.ws + WS_HX);
    int* rowtok = (int*)(F.ws + WS_ROWTOK); int* tokes = (int*)(F.ws + WS_TOKES); float* tokg = (float*)(F.ws + WS_TOKG);
    LAS unsigned char* L = F.lds;
    LAS f32x4* WR = (LAS f32x4*)L;
    LAS float* mulv = (LAS float*)(L + 131072);
    LAS float* shv = (LAS float*)(L + 131072 + 4096);
    LAS int* tinfo = (LAS int*)(L + 131072 + 8192);
    LAS int* lcnt = (LAS int*)(L + 131072 + 8192 + 6144);
    LAS int* lbase = lcnt + 32;
    for (int i = F.tid; i < 8192; i += 512) { const int k = i >> 3, e4 = i & 7; WR[e4 * 1024 + k] = *(const f32x4*)(F.w_router + (size_t)k * 32 + e4 * 4); }
    if (F.tid < 32) lcnt[F.tid] = 0;
    const int lane = F.lane;
    const int myexp = ((lane >> 5) & 1) * 16 + ((lane >> 4) & 1) * 8 + ((lane >> 3) & 1) * 4 + ((lane >> 2) & 1) * 2 + ((lane >> 1) & 1);
    const float mybias = F.b_router[myexp];
    for (int blk = F.vcu; blk < TL / 128; blk += F.G) {
        const int bb = (blk * 128) >> 11;
        __syncthreads();
        for (int k = F.tid; k < 1024; k += 512) { mulv[k] = F.norm2_g[k] * (1.0f + mod[(size_t)bb * 6144 + 4 * 1024 + k]); shv[k] = mod[(size_t)bb * 6144 + 3 * 1024 + k]; }
        __syncthreads();
        for (int i = 0; i < 16; ++i) {
            const int tl = F.wave * 16 + i, t = blk * 128 + tl;
            const float* xr = F.out + (size_t)t * 1024;
            float hv[16]; float ss = 0.f;
#pragma unroll
            for (int jj = 0; jj < 16; ++jj) { hv[jj] = xr[lane + 64 * jj]; ss += hv[jj] * hv[jj]; }
            const float rs = 1.0f / sqrtf(wave_sum(ss) * (1.f / 1024.f) + NORM_EPS);
            float acc[32];
#pragma unroll
            for (int e = 0; e < 32; ++e) acc[e] = 0.f;
#pragma unroll
            for (int jj = 0; jj < 16; ++jj) { const int k = lane + 64 * jj;
                const float hval = hv[jj] * rs * mulv[k] + shv[k];
                h2[(size_t)t * 1024 + k] = (bf16)f2bf(hval);
#pragma unroll
                for (int e4 = 0; e4 < 8; ++e4) { const f32x4 wq = WR[e4 * 1024 + k];
                    acc[4 * e4 + 0] += hval * wq[0]; acc[4 * e4 + 1] += hval * wq[1]; acc[4 * e4 + 2] += hval * wq[2]; acc[4 * e4 + 3] += hval * wq[3]; } }
            float r16[16], r8[8], r4[4], r2[2], r1;
            { const bool hi = (lane & 32) != 0;
#pragma unroll
              for (int e = 0; e < 16; ++e) { const float send = hi ? acc[e] : acc[e + 16]; const float recv = __shfl_xor(send, 32); r16[e] = (hi ? acc[e + 16] : acc[e]) + recv; } }
            { const bool hi = (lane & 16) != 0;
#pragma unroll
              for (int e = 0; e < 8; ++e) { const float send = hi ? r16[e] : r16[e + 8]; const float recv = __shfl_xor(send, 16); r8[e] = (hi ? r16[e + 8] : r16[e]) + recv; } }
            { const bool hi = (lane & 8) != 0;
#pragma unroll
              for (int e = 0; e < 4; ++e) { const float send = hi ? r8[e] : r8[e + 4]; const float recv = __shfl_xor(send, 8); r4[e] = (hi ? r8[e + 4] : r8[e]) + recv; } }
            { const bool hi = (lane & 4) != 0;
#pragma unroll
              for (int e = 0; e < 2; ++e) { const float send = hi ? r4[e] : r4[e + 2]; const float recv = __shfl_xor(send, 4); r2[e] = (hi ? r4[e + 2] : r4[e]) + recv; } }
            { const bool hi = (lane & 2) != 0; const float send = hi ? r2[0] : r2[1]; const float recv = __shfl_xor(send, 2); r1 = (hi ? r2[1] : r2[0]) + recv; }
            r1 += __shfl_xor(r1, 1);
            float val = r1 + mybias;
            int sel[4]; float sv[4];
#pragma unroll
            for (int kk = 0; kk < 4; ++kk) {
                float bv = val; int bi = myexp;
#pragma unroll
                for (int o = 1; o < 64; o <<= 1) { const float ov = __shfl_xor(bv, o); const int oi = __shfl_xor(bi, o); if (ov > bv || (ov == bv && oi < bi)) { bv = ov; bi = oi; } }
                sel[kk] = bi; sv[kk] = bv; if (myexp == bi) val = -3.0e38f;
            }
            const float p1 = __expf(sv[1] - sv[0]), p2 = __expf(sv[2] - sv[0]), p3 = __expf(sv[3] - sv[0]);
            const float inv = 1.0f / (1.0f + p1 + p2 + p3);
            const float gt[4] = {inv, p1 * inv, p2 * inv, p3 * inv};
            if (lane < 4) {
                const int e = lane == 0 ? sel[0] : lane == 1 ? sel[1] : lane == 2 ? sel[2] : sel[3];
                const float gg = lane == 0 ? gt[0] : lane == 1 ? gt[1] : lane == 2 ? gt[2] : gt[3];
                const int ls = atomicAdd((int*)&lcnt[e], 1);
                tinfo[(tl * 4 + lane) * 3 + 0] = e; tinfo[(tl * 4 + lane) * 3 + 1] = ls; tinfo[(tl * 4 + lane) * 3 + 2] = __float_as_int(gg);
            }
        }
        __syncthreads();
        if (F.tid < 32) { const int n = lcnt[F.tid]; lbase[F.tid] = (int)__hip_atomic_fetch_add((unsigned*)(F.ctl + CW_ECNT + F.tid), (unsigned)n, RLX_AGENT); }
        __syncthreads();
        { const int tl = F.tid >> 2, kk = F.tid & 3, t = blk * 128 + tl;
          const int e = tinfo[(tl * 4 + kk) * 3 + 0], ls = tinfo[(tl * 4 + kk) * 3 + 1]; const float gg = __int_as_float(tinfo[(tl * 4 + kk) * 3 + 2]);
          const int slot = lbase[e] + ls;
          rowtok[(size_t)e * CAP + slot] = t; tokes[t * 4 + kk] = e * CAP + slot; tokg[t * 4 + kk] = gg; }
        __syncthreads();
        if (F.tid < 32) lcnt[F.tid] = 0;
    }
    __syncthreads();
}

__device__ __forceinline__ void build_mt_table(Frame& F) {
    __syncthreads();
    if (F.tid == 0) { int s = 0;
        for (int e = 0; e < 32; ++e) { const int c = (int)__hip_atomic_load(F.ctl + CW_ECNT + e, RLX_AGENT); F.cl[LW_CNT + e] = (unsigned)c; F.cl[LW_MTS + e] = (unsigned)s; s += (c + 255) >> 8; }
        F.cl[LW_MTS + 32] = (unsigned)s; }
    __syncthreads();
}

__device__ __forceinline__ void phase_final(Frame& F) {
    const float* mod = (const float*)(F.ws + WS_MOD); const bf16* yrows = (const bf16*)(F.ws + WS_YROWS);
    const int* tokes = (const int*)(F.ws + WS_TOKES); const float* tokg = (const float*)(F.ws + WS_TOKG);
    const int gw = F.vcu * NWAVES + F.wave, NGW = F.G * NWAVES, lane = F.lane;
    for (int t = gw; t < TL; t += NGW) {
        const int b = t >> 11;
        float m[16];
#pragma unroll
        for (int e = 0; e < 16; ++e) m[e] = 0.f;
#pragma unroll
        for (int kk = 0; kk < 4; ++kk) {
            const int es = tokes[t * 4 + kk]; const float gg = tokg[t * 4 + kk];
            const int e = es >> 15, slot = es & (CAP - 1);
            const size_t pos = (size_t)F.cl[LW_MTS + e] * 256 + slot;
            float y0[8], y1[8];
            unpack8(*(const u32x4*)(yrows + pos * 1024 + lane * 8), y0); unpack8(*(const u32x4*)(yrows + pos * 1024 + 512 + lane * 8), y1);
#pragma unroll
            for (int q = 0; q < 8; ++q) { m[q] += gg * y0[q]; m[8 + q] += gg * y1[q]; }
        }
        float x2[16]; float ss = 0.f;
#pragma unroll
        for (int hf = 0; hf < 2; ++hf)
#pragma unroll
            for (int q4 = 0; q4 < 2; ++q4) { const int c = hf * 512 + lane * 8 + q4 * 4;
                const f32x4 xv = *(const f32x4*)(F.out + (size_t)t * 1024 + c), gv = *(const f32x4*)(mod + (size_t)b * 6144 + 5 * 1024 + c);
#pragma unroll
                for (int j = 0; j < 4; ++j) { const float v = xv[j] + gv[j] * m[hf * 8 + q4 * 4 + j]; x2[hf * 8 + q4 * 4 + j] = v; ss += v * v; } }
        const float rs = 1.0f / sqrtf(wave_sum(ss) * (1.f / 1024.f) + NORM_EPS);
#pragma unroll
        for (int hf = 0; hf < 2; ++hf)
#pragma unroll
            for (int q4 = 0; q4 < 2; ++q4) { const int c = hf * 512 + lane * 8 + q4 * 4;
                const f32x4 fg = *(const f32x4*)(F.final_g + c); f32x4 o;
#pragma unroll
                for (int j = 0; j < 4; ++j) o[j] = x2[hf * 8 + q4 * 4 + j] * rs * fg[j];
                *(f32x4*)(F.out + (size_t)t * 1024 + c) = o; }
    }
}

constexpr int NPHASE = 11;
__global__ void __launch_bounds__(NWAVES * 64, 2) mk_fwd(Args args) {
    extern __shared__ __attribute__((aligned(16))) unsigned char lds_raw[];
    Frame F;
    F.lds = (LAS unsigned char*)lds_raw;
    F.cl = (volatile LAS unsigned*)(F.lds + CTLDS_OFF);
    F.tid = threadIdx.x; F.lane = F.tid & 63; F.wave = __builtin_amdgcn_readfirstlane(F.tid >> 6);
    F.G = gridDim.x; { const int bx = blockIdx.x; F.vcu = (F.G % 8 == 0) ? (bx % 8) * (F.G / 8) + bx / 8 : bx; }
    F.ws = args.ws; F.ctl = (gu32*)(args.ws + WS_CTL); F.out = args.out;
    F.x = args.in[0]; F.c = args.in[1]; F.ctx = args.in[2]; F.c_ctx = args.in[3]; F.w_mod = args.in[4]; F.b_mod = args.in[5]; F.norm1_g = args.in[6]; F.w_in = args.in[7];
    F.conv_w = args.in[8]; F.conv_b = args.in[9]; F.dt_bias = args.in[10]; F.a_log = args.in[11]; F.ssd_d = args.in[12]; F.ssd_norm_g = args.in[13]; F.sc_conv_w = args.in[14];
    F.w_out = args.in[15]; F.norm2_g = args.in[16]; F.w_router = args.in[17]; F.b_router = args.in[18]; F.w_gu = args.in[19]; F.b_gu = args.in[20]; F.w_dn = args.in[21]; F.b_dn = args.in[22]; F.final_g = args.in[23];
    for (int u = F.tid; u < (LDS_BYTES - CTLDS_OFF) / 4; u += NWAVES * 64) ((LAS unsigned*)(F.lds + CTLDS_OFF))[u] = 0u;
    __syncthreads();
    const int lo = args.ph_lo, hi = args.ph_hi;
    XcdBarrier bar; bar.bar = (unsigned*)(F.ctl + CW_BAR); bar.x = 0; bar.st = nullptr;
    if (hi - lo > 1) bar = xcd_barrier_post((unsigned*)(F.ctl + CW_BAR), F.cl + LW_BARST);
#define IN(k) (lo <= (k) && (k) < hi)
#define SEAM(k) do { if (IN(k) && IN((k) + 1)) xcd_barrier(bar); } while (0)

    if (IN(0)) { phase0(F); SEAM(0); }
    if (IN(1)) { phase1(F); SEAM(1); }
    if (IN(2)) {
        SchedIn S{F.G, F.vcu, 1024, (const bf16*)(F.ws + WS_WIN)};
        EpiIn E{(bf16*)(F.ws + WS_XRAW), (float*)(F.ws + WS_DT), (bf16*)(F.ws + WS_SZ), (bf16*)(F.ws + WS_SCB), (bf16*)(F.ws + WS_CU), F.dt_bias};
        pg8::gemm_phase<EpiIn, SchedIn>(F.lds, (const bf16*)(F.ws + WS_HX), 1024, S, E);
        SEAM(2);
    }
    if (IN(3)) { phase_conv(F); SEAM(3); }
    if (IN(4)) { phase_ssd(F); SEAM(4); }
    if (IN(5)) { phase_combine(F); SEAM(5); }
    if (IN(6)) {
        SchedPlain S{F.G, F.vcu, 2048, 4, 512, (const bf16*)(F.ws + WS_WOUT)};
        EpiOut E{F.x, F.out, (const float*)(F.ws + WS_MOD)};
        pg8::gemm_phase<EpiOut, SchedPlain>(F.lds, (const bf16*)(F.ws + WS_A2), 2048, S, E);
        SEAM(6);
    }
    if (IN(7)) { phase_router(F); SEAM(7); }
    if (IN(8)) {
        build_mt_table(F);
        SchedMoe<true> S{F.G, F.vcu, 1024, 8, (const bf16*)(F.ws + WS_WGU), F.cl, (const int*)(F.ws + WS_ROWTOK)};
        EpiGU E{(bf16*)(F.ws + WS_ACT), F.b_gu};
        pg8::gemm_phase<EpiGU, SchedMoe<true>>(F.lds, (const bf16*)(F.ws + WS_HX), 1024, S, E);
        SEAM(8);
    }
    if (IN(9)) {
        build_mt_table(F);
        SchedMoe<false> S{F.G, F.vcu, 1024, 4, (const bf16*)(F.ws + WS_WDN), F.cl, nullptr};
        EpiDown E{(bf16*)(F.ws + WS_YROWS), F.b_dn};
        pg8::gemm_phase<EpiDown, SchedMoe<false>>(F.lds, (const bf16*)(F.ws + WS_ACT), 1024, S, E);
        SEAM(9);
    }
    if (IN(10)) { build_mt_table(F); phase_final(F); }
#undef IN
#undef SEAM
}

extern "C" void kernel_launch(void* const* d_in, const int* in_sizes, int n_in, void* d_out, int out_size, void* d_ws, size_t ws_size, hipStream_t stream) {
    static int grid = 0;
    if (grid == 0) {
        if (n_in != 24 || out_size != TL * D || ws_size < WS_END) { fprintf(stderr, "kernel_launch: unexpected shapes (n_in %d out %d ws %zu); nothing launched\n", n_in, out_size, ws_size); grid = -1; return; }
        int dev = 0, cus = 0;
        if (hipGetDevice(&dev) != hipSuccess || hipDeviceGetAttribute(&cus, hipDeviceAttributeMultiprocessorCount, dev) != hipSuccess) { grid = -1; return; }
        if (hipFuncSetAttribute((const void*)mk_fwd, hipFuncAttributeMaxDynamicSharedMemorySize, LDS_BYTES) != hipSuccess) { fprintf(stderr, "kernel_launch: hipFuncSetAttribute failed\n"); grid = -1; return; }
        int per_cu = 0;
        if (hipOccupancyMaxActiveBlocksPerMultiprocessor(&per_cu, (const void*)mk_fwd, NWAVES * 64, LDS_BYTES) != hipSuccess || per_cu < 1) fprintf(stderr, "kernel_launch: occupancy query says %d\n", per_cu);
        (void)hipGetLastError();
        grid = cus;
    }
    if (grid < 0) return;
    (void)hipMemsetAsync((char*)d_ws + WS_CTL, 0, CTL_ZERO_BYTES, stream);
    Args a{};
    for (int i = 0; i < 24; ++i) a.in[i] = (const float*)d_in[i];
    a.out = (float*)d_out; a.ws = (unsigned char*)d_ws;
#if MK_ONE_LAUNCH
    a.ph_lo = 0; a.ph_hi = NPHASE;
    hipLaunchKernelGGL(mk_fwd, dim3(grid), dim3(NWAVES * 64), LDS_BYTES, stream, a);
#else
    for (int p = 0; p < NPHASE; ++p) { a.ph_lo = p; a.ph_hi = p + 1; hipLaunchKernelGGL(mk_fwd, dim3(grid), dim3(NWAVES * 64), LDS_BYTES, stream, a); }
#endif
}
```

```cpp
#include <hip/hip_runtime.h>
#include <cstdio>
#include <cstdint>

#ifndef MK_ONE_LAUNCH
#define MK_ONE_LAUNCH 1
#endif
#ifndef PROBE_DOUBLE
#define PROBE_DOUBLE 0
#endif

#define LAS __attribute__((address_space(3)))
#define GAS __attribute__((address_space(1)))
typedef unsigned short bf16;
typedef short bf16x8 __attribute__((ext_vector_type(8)));
typedef float f32x4 __attribute__((ext_vector_type(4)));
typedef float f32x2 __attribute__((ext_vector_type(2)));
typedef unsigned u32x4 __attribute__((ext_vector_type(4)));
typedef unsigned u32x2 __attribute__((ext_vector_type(2)));
typedef GAS unsigned gu32;

constexpr int D = 1024, NB = 16, SEQ = 2048, CTXL = 256;
constexpr int TL = NB * SEQ;
constexpr int TC = NB * CTXL;
constexpr int TT = TL + TC;
constexpr int IN_W = 5664, X0 = 1024, B0 = 2048, C0 = 2304, DT0 = 2560, SC0 = 2592;
constexpr int NE = 32, TOPK = 4, DFF = 1024;
constexpr int XBCW = 1536;
constexpr int NT_IN = 23;
constexpr int CAP = TL;
constexpr int ACT_ROWS = TL * TOPK + NE * 256;
constexpr float NORM_EPS = 1e-6f;

constexpr size_t MiB = 1u << 20;
constexpr size_t WS_CTL = 0, CTL_ZERO_BYTES = 1 * MiB;
constexpr size_t WS_MOD = 1 * MiB;
constexpr size_t WS_TOKES = 2 * MiB;
constexpr size_t WS_TOKG = 2 * MiB + 512 * 1024;
constexpr size_t WS_ROWTOK = 3 * MiB;
constexpr size_t WS_WIN = 7 * MiB;
constexpr size_t WS_WOUT = 19 * MiB;
constexpr size_t WS_WGU = 23 * MiB;
constexpr size_t WS_WDN = 151 * MiB;
constexpr size_t WS_HX = 215 * MiB;
constexpr size_t WS_XRAW = 287 * MiB;
constexpr size_t WS_XBC = 395 * MiB;
constexpr size_t WS_DT = 503 * MiB;
constexpr size_t WS_SZ = 508 * MiB;
constexpr size_t WS_SCB = 572 * MiB;
constexpr size_t WS_CU = 636 * MiB;
constexpr size_t WS_YF = 700 * MiB;
constexpr size_t WS_YB = 764 * MiB;
constexpr size_t WS_A2 = 828 * MiB;
constexpr size_t WS_ACT = 287 * MiB;
constexpr size_t WS_YROWS = 572 * MiB;
constexpr size_t WS_END = 956 * MiB;
constexpr int CW_ECNT = 64;
constexpr int CW_BAR = 4096;

constexpr int LDS_BYTES = 147456;
constexpr int CTLDS_OFF = 146432;
constexpr int LW_BARST = 0;
constexpr int LW_MTS = 16;
constexpr int LW_CNT = 64;

constexpr int NWAVES = 8;

#define LDS_WAIT() asm volatile("s_waitcnt lgkmcnt(0)" ::: "memory")
#define VM_WAIT() asm volatile("s_waitcnt vmcnt(0)" ::: "memory")
#define RLX_AGENT __ATOMIC_RELAXED, __HIP_MEMORY_SCOPE_AGENT

__device__ __forceinline__ unsigned f2bf(float f) { unsigned u = __builtin_bit_cast(unsigned, f); return (u + 0x7fffu + ((u >> 16) & 1u)) >> 16; }
typedef __bf16 hwbf16x2 __attribute__((ext_vector_type(2)));
__device__ __forceinline__ unsigned pk2(float lo, float hi) { const f32x2 v = {lo, hi}; const hwbf16x2 b = __builtin_convertvector(v, hwbf16x2); return __builtin_bit_cast(unsigned, b); }
__device__ __forceinline__ float bf2f(unsigned b) { return __builtin_bit_cast(float, b << 16); }
__device__ __forceinline__ float bflo(unsigned w) { return __builtin_bit_cast(float, w << 16); }
__device__ __forceinline__ float bfhi(unsigned w) { return __builtin_bit_cast(float, w & 0xffff0000u); }
__device__ __forceinline__ float fsilu(float x) { return x * __builtin_amdgcn_rcpf(1.0f + __expf(-x)); }
__device__ __forceinline__ float wave_sum(float v) {
#pragma unroll
    for (int o = 1; o < 64; o <<= 1) v += __shfl_xor(v, o);
    return v;
}

#define XB_TMO      128
#define XB_XCNT(j)  (256  + 64 * (j))
#define XB_XSUB(j)  (1280 + 64 * (j))
#define XB_XGEN(j)  (2304 + 64 * (j))
#define XB_TOP      3328
#define XB_TOPGEN   3392
#define XCD_BAR_WORDS 3456
#define XB_SPIN_CAP (1u << 18)
__device__ __forceinline__ unsigned xb_ld(unsigned* p)              { return __hip_atomic_load(p, __ATOMIC_RELAXED, __HIP_MEMORY_SCOPE_AGENT); }
__device__ __forceinline__ unsigned xb_add(unsigned* p, unsigned v) { return __hip_atomic_fetch_add(p, v, __ATOMIC_RELAXED, __HIP_MEMORY_SCOPE_AGENT); }
__device__ __forceinline__ unsigned xb_xcc_id() { return (unsigned)__builtin_amdgcn_s_getreg((3 << 11) | 20) & 0xFu; }
#define XB_SPIN(cond, bar) do { unsigned _sp = 0; while (cond) { __builtin_amdgcn_s_sleep(1); \
    if ((++_sp & 255u) == 0u) { if (xb_ld(&(bar)[XB_TMO])) break; if (_sp > XB_SPIN_CAP) { atomicAdd(&(bar)[XB_TMO], 1u); break; } } } } while (0)
struct XcdBarrier { unsigned* bar; unsigned x; volatile LAS unsigned* st; };
__device__ __forceinline__ XcdBarrier xcd_barrier_post(unsigned* bar, volatile LAS unsigned* st) {
    XcdBarrier b; b.bar = bar; b.x = xb_xcc_id(); b.st = st;
    if (threadIdx.x == 0) (void)xb_add(&bar[XB_XCNT(b.x)], 1u);
    return b;
}
__device__ __forceinline__ void xcd_barrier_complete(unsigned* bar, unsigned x, unsigned& nloc, unsigned& nx) {
    const unsigned G = gridDim.x * gridDim.y * gridDim.z;
    unsigned sum, cnt, mine, sp = 0u;
    for (;;) {
        sum = 0u; cnt = 0u; mine = 0u;
#pragma unroll
        for (unsigned j = 0; j < 16; ++j) { const unsigned c = xb_ld(&bar[XB_XCNT(j)]); sum += c; cnt += (c > 0u) ? 1u : 0u; mine = (j == x) ? c : mine; }
        if (sum == G) break;
        __builtin_amdgcn_s_sleep(1);
        if ((++sp & 255u) == 0u) { if (xb_ld(&bar[XB_TMO])) break; if (sp > XB_SPIN_CAP) { atomicAdd(&bar[XB_TMO], 1u); break; } }
    }
    nloc = mine > 0u ? mine : 1u; nx = cnt > 0u ? cnt : 1u;
}
__device__ __forceinline__ void xcd_barrier(const XcdBarrier& b) {
    asm volatile("s_waitcnt vmcnt(0)" ::: "memory");
    __syncthreads();
    if (threadIdx.x == 0) {
        unsigned* bar = b.bar;
        __builtin_amdgcn_s_waitcnt(0);
        unsigned nloc = b.st[0], nx = b.st[1];
        if (nloc == 0u) { xcd_barrier_complete(bar, b.x, nloc, nx); b.st[0] = nloc; b.st[1] = nx; }
        const unsigned old = xb_add(&bar[XB_XSUB(b.x)], 1u);
        const unsigned gen = old / nloc;
        if (old + 1u == (gen + 1u) * nloc) {
            __builtin_amdgcn_fence(__ATOMIC_RELEASE, "agent");
            asm volatile("s_waitcnt vmcnt(0)" ::: "memory");
            const unsigned og = xb_add(&bar[XB_TOP], 1u);
            const unsigned tg = og / nx;
            if (og + 1u == (tg + 1u) * nx) xb_add(&bar[XB_TOPGEN], 1u);
            else XB_SPIN(xb_ld(&bar[XB_TOPGEN]) == tg, bar);
            __builtin_amdgcn_fence(__ATOMIC_ACQUIRE, "agent");
            xb_add(&bar[XB_XGEN(b.x)], 1u);
            asm volatile("s_waitcnt vmcnt(0)" ::: "memory");
        } else {
            XB_SPIN(xb_ld(&bar[XB_XGEN(b.x)]) == gen, bar);
            __builtin_amdgcn_fence(__ATOMIC_ACQUIRE, "agent");
            asm volatile("s_waitcnt vmcnt(0)" ::: "memory");
        }
    }
    __syncthreads();
}

struct Args { const float* in[24]; float* out; unsigned char* ws; int ph_lo, ph_hi; };
struct Frame {
    LAS unsigned char* lds;
    volatile LAS unsigned* cl;
    unsigned char* ws;
    gu32* ctl;
    int tid, lane, wave, vcu, G;
    const float *x, *c, *ctx, *c_ctx, *w_mod, *b_mod, *norm1_g, *w_in, *conv_w, *conv_b, *dt_bias, *a_log, *ssd_d, *ssd_norm_g, *sc_conv_w, *w_out, *norm2_g, *w_router, *b_router, *w_gu, *b_gu, *w_dn, *b_dn, *final_g;
    float* out;
};

namespace pg8 {
constexpr int BM = 256, BK = 64, HALF = 128, HTB = HALF * BK * 2, STAGE_BYTES = 8 * HTB;
__device__ __forceinline__ int lds_byte(int r, int c) { const int st = (r >> 4) * 2 + (c >> 5), rr = r & 15, cc = c & 31, ob = rr * 64 + cc * 2; return st * 1024 + (ob ^ (((ob >> 9) & 1) << 5)); }
__device__ __forceinline__ void stage_rc(int b, int& R, int& C) { const int st = b / 1024, sb = b % 1024, swz = sb ^ (((sb >> 9) & 1) << 5); R = (st >> 1) * 16 + swz / 64; C = (st & 1) * 32 + (swz % 64) / 2; }
__device__ __forceinline__ int perm32(int rho) { const int n = rho >> 4, i = rho & 15; return 8 * (i >> 2) + 4 * n + (i & 3); }
__device__ __forceinline__ unsigned cvt_pk_bf16(float lo, float hi) { unsigned r; asm volatile("v_cvt_pk_bf16_f32 %0, %1, %2" : "=v"(r) : "v"(lo), "v"(hi)); return r; }

struct Unit { int pm, pn, e; };

template <class Epi, class Sched>
__device__ __forceinline__ void gemm_phase(LAS unsigned char* lds, const bf16* Aptr, const int K, const Sched& S, const Epi& E) {
    const int tid = threadIdx.x, wid = __builtin_amdgcn_readfirstlane(tid >> 6), lane = tid & 63, wr = wid >> 2, wc = wid & 3, fr = lane & 15, fq = lane >> 4;
    const int nt = K / BK;
    int sR[2], sC[2];
    unsigned voffB[2];
#pragma unroll
    for (int i = 0; i < 2; ++i) { int R, C; stage_rc(tid * 16 + i * 8192, R, C); const int Rb = Epi::PERM ? ((R & ~31) + perm32(R & 31)) : R;
        sR[i] = R; sC[i] = C; voffB[i] = (unsigned)(Rb * K + C) * 2u; }
    const size_t kstep = (size_t)(BK * 2);
    const size_t hstep = (size_t)HALF * K * 2;
    const unsigned ldsw = (unsigned)wid * 1024u;
    const int aoff = lds_byte(wr * 64 + fr, fq * 8), boff = lds_byte(wc * 32 + fr, fq * 8);
    const char* const Abase = (const char*)Aptr;
#define PG8_SA(b, h) (((b) * 2 + (h)) * HTB)
#define PG8_SB(b, h) ((4 + (b) * 2 + (h)) * HTB)
#define PG8_STAGE(bufoff, gbase, voff) do { _Pragma("unroll") for (int _i = 0; _i < 2; ++_i) \
        __builtin_amdgcn_global_load_lds((const unsigned*)((const char*)(gbase) + (voff)[_i]), (LAS unsigned*)(lds + (bufoff) + ldsw + _i * 8192), 16, 0, 0); } while (0)
#define PG8_LDA(dst, b, h) do { _Pragma("unroll") for (int m = 0; m < 4; ++m) _Pragma("unroll") for (int k = 0; k < 2; ++k) dst[m][k] = *(const LAS bf16x8*)(lds + PG8_SA(b, h) + aoff + m * 2048 + k * 1024); } while (0)
#define PG8_LDB(dst, b, h) do { _Pragma("unroll") for (int n = 0; n < 2; ++n) _Pragma("unroll") for (int k = 0; k < 2; ++k) dst[n][k] = *(const LAS bf16x8*)(lds + PG8_SB(b, h) + boff + n * 2048 + k * 1024); } while (0)
#define PG8_MMA(ai, bj, At, Bt) do { __builtin_amdgcn_s_setprio(1); _Pragma("unroll") for (int m = 0; m < 4; ++m) _Pragma("unroll") for (int n = 0; n < 2; ++n) _Pragma("unroll") for (int k = 0; k < 2; ++k) \
        acc[ai][bj][m][n] = __builtin_amdgcn_mfma_f32_16x16x32_bf16(Bt[n][k], At[m][k], acc[ai][bj][m][n], 0, 0, 0); __builtin_amdgcn_s_setprio(0); } while (0)
#define PG8_WAIT_V(n) asm volatile("s_waitcnt vmcnt(" #n ")" ::: "memory")
#define PG8_WAIT_L(n) asm volatile("s_waitcnt lgkmcnt(" #n ")" ::: "memory")
#define PG8_BAR __builtin_amdgcn_s_barrier()
#define PG8_SCHED __builtin_amdgcn_sched_barrier(0)
    Unit cur, nxt; int ui = 0;
    if (!S.next(0, cur)) return;
    f32x4 acc[2][2][4][2];
#pragma unroll
    for (int a = 0; a < 2; ++a)
#pragma unroll
        for (int b = 0; b < 2; ++b)
#pragma unroll
            for (int m = 0; m < 4; ++m)
#pragma unroll
                for (int n = 0; n < 2; ++n) acc[a][b][m][n] = (f32x4){0.f, 0.f, 0.f, 0.f};
    bf16x8 At[4][2], B0[2][2], B1[2][2];
    unsigned va0[2], va1[2];
    S.aoff(cur, sR, sC, va0, va1);
    if (Sched::GATHER) { asm volatile("s_waitcnt vmcnt(0)" ::: "memory"); asm volatile("" : "+v"(va0[0]), "+v"(va0[1]), "+v"(va1[0]), "+v"(va1[1])); }
    const char* cB = S.bbase(cur);
    PG8_STAGE(PG8_SB(0, 0), cB, voffB); PG8_STAGE(PG8_SB(0, 1), cB + hstep, voffB); PG8_STAGE(PG8_SA(0, 0), Abase, va0); PG8_STAGE(PG8_SA(0, 1), Abase, va1);
    if (wr == 1) PG8_BAR;
    PG8_WAIT_V(2); PG8_BAR;
    PG8_STAGE(PG8_SB(1, 0), cB + kstep, voffB); PG8_STAGE(PG8_SA(1, 0), Abase + kstep, va0); PG8_STAGE(PG8_SB(1, 1), cB + hstep + kstep, voffB);
    PG8_WAIT_V(6); PG8_BAR;
    for (;;) {
        const bool has_next = S.next(ui + 1, nxt);
        const char* nB = has_next ? S.bbase(nxt) : cB;
        for (int t = 0; t < nt; t += 2) {
            const bool last = (t == nt - 2);
            const char* a1 = Abase + (size_t)(t + 1) * kstep;
            const char* a2 = last ? Abase : Abase + (size_t)(t + 2) * kstep; const char* b2 = last ? nB : cB + (size_t)(t + 2) * kstep;
            const char* a3 = a2 + kstep; const char* b3 = b2 + kstep;
            unsigned nva0[2], nva1[2];
            nva0[0] = va0[0]; nva0[1] = va0[1]; nva1[0] = va1[0]; nva1[1] = va1[1];
            if (last && has_next) {
                S.aoff(nxt, sR, sC, nva0, nva1);
                if (Sched::GATHER) { asm volatile("s_waitcnt vmcnt(0)" ::: "memory"); asm volatile("" : "+v"(nva0[0]), "+v"(nva0[1]), "+v"(nva1[0]), "+v"(nva1[1])); }
            }
            PG8_LDB(B0, 0, 0); PG8_LDB(B1, 0, 1); PG8_SCHED; PG8_LDA(At, 0, 0); PG8_STAGE(PG8_SA(1, 1), a1, va1);
            PG8_WAIT_V(8); PG8_WAIT_L(0); PG8_BAR; PG8_MMA(0, 0, At, B0); PG8_MMA(0, 1, At, B1); PG8_BAR; PG8_SCHED;
            if (last) { va0[0] = nva0[0]; va0[1] = nva0[1]; va1[0] = nva1[0]; va1[1] = nva1[1]; }
            PG8_LDA(At, 0, 1); PG8_STAGE(PG8_SB(0, 0), b2, voffB); PG8_STAGE(PG8_SB(0, 1), b2 + hstep, voffB); PG8_STAGE(PG8_SA(0, 0), a2, va0);
            PG8_WAIT_V(8); PG8_WAIT_L(0); PG8_BAR; PG8_MMA(1, 0, At, B0); PG8_MMA(1, 1, At, B1); PG8_BAR; PG8_SCHED;
            PG8_LDB(B0, 1, 0); PG8_LDB(B1, 1, 1); PG8_SCHED; PG8_LDA(At, 1, 0); PG8_STAGE(PG8_SA(0, 1), a2, va1);
            PG8_WAIT_V(8); PG8_WAIT_L(0); PG8_BAR; PG8_MMA(0, 0, At, B0); PG8_MMA(0, 1, At, B1); PG8_BAR; PG8_SCHED;
            PG8_LDA(At, 1, 1); PG8_STAGE(PG8_SB(1, 0), b3, voffB); PG8_STAGE(PG8_SB(1, 1), b3 + hstep, voffB); PG8_STAGE(PG8_SA(1, 0), a3, va0);
            PG8_WAIT_V(8); PG8_WAIT_L(0); PG8_BAR; PG8_MMA(1, 0, At, B0); PG8_MMA(1, 1, At, B1); PG8_BAR; PG8_SCHED;
        }
        if (wr == 0) PG8_BAR;
        E(acc, cur, wr, wc, fr, fq);
        if (!has_next) break;
#pragma unroll
        for (int a = 0; a < 2; ++a)
#pragma unroll
            for (int b = 0; b < 2; ++b)
#pragma unroll
                for (int m = 0; m < 4; ++m)
#pragma unroll
                    for (int n = 0; n < 2; ++n) acc[a][b][m][n] = (f32x4){0.f, 0.f, 0.f, 0.f};
        cur = nxt; cB = nB; ++ui;
        if (wr == 1) PG8_BAR;
    }
    PG8_WAIT_V(0);
    PG8_BAR;
#undef PG8_SA
#undef PG8_SB
#undef PG8_STAGE
#undef PG8_LDA
#undef PG8_LDB
#undef PG8_MMA
#undef PG8_WAIT_V
#undef PG8_WAIT_L
#undef PG8_BAR
#undef PG8_SCHED
}
}

using pg8::Unit;
struct SchedIn {
    static constexpr bool GATHER = false;
    int G, v, K; const bf16* Bt;
    __device__ __forceinline__ bool next(int i, Unit& u) const {
        int L = i * G + v; if (L >= 3040) return false;
        if (L < 2944) { const int gid = L / 184, l = L % 184; u.pm = gid * 8 + (l & 7); u.pn = l >> 3; }
        else { L -= 2944; const int gid = L / 48, l = L % 48; u.pm = 128 + gid * 8 + (l & 7); u.pn = l >> 3; }
        u.e = 0; return true;
    }
    __device__ __forceinline__ const char* bbase(const Unit& u) const { return (const char*)Bt + (size_t)u.pn * ((size_t)256 * K * 2); }
    __device__ __forceinline__ void aoff(const Unit& u, const int (&R)[2], const int (&C)[2], unsigned (&v0)[2], unsigned (&v1)[2]) const {
#pragma unroll
        for (int i = 0; i < 2; ++i) { v0[i] = (unsigned)(((u.pm * 256 + R[i]) * K + C[i]) * 2); v1[i] = (unsigned)(((u.pm * 256 + 128 + R[i]) * K + C[i]) * 2); }
    }
};
struct SchedPlain {
    static constexpr bool GATHER = false;
    int G, v, K, nN, nwg; const bf16* Bt;
    __device__ __forceinline__ bool next(int i, Unit& u) const {
        const int L = i * G + v; if (L >= nwg) return false;
        const int per = 8 * nN, gid = L / per, l = L % per; u.pm = gid * 8 + (l & 7); u.pn = l >> 3; u.e = 0; return true;
    }
    __device__ __forceinline__ const char* bbase(const Unit& u) const { return (const char*)Bt + (size_t)u.pn * ((size_t)256 * K * 2); }
    __device__ __forceinline__ void aoff(const Unit& u, const int (&R)[2], const int (&C)[2], unsigned (&v0)[2], unsigned (&v1)[2]) const {
#pragma unroll
        for (int i = 0; i < 2; ++i) { v0[i] = (unsigned)(((u.pm * 256 + R[i]) * K + C[i]) * 2); v1[i] = (unsigned)(((u.pm * 256 + 128 + R[i]) * K + C[i]) * 2); }
    }
};
template <bool GATH> struct SchedMoe {
    static constexpr bool GATHER = GATH;
    int G, v, K, NT; const bf16* Bt; const volatile LAS unsigned* cl; const int* rowtok;
    __device__ __forceinline__ bool next(int i, Unit& u) const {
        const int L = i * G + v; const int mt = L / NT; const int tot = (int)cl[LW_MTS + 32];
        if (mt >= tot) return false;
        int e = 0;
        while (e < 31 && (int)cl[LW_MTS + e + 1] <= mt) ++e;
        u.pm = mt; u.pn = L - mt * NT; u.e = e; return true;
    }
    __device__ __forceinline__ const char* bbase(const Unit& u) const { return (const char*)Bt + ((size_t)u.e * NT + u.pn) * ((size_t)256 * K * 2); }
    __device__ __forceinline__ void aoff(const Unit& u, const int (&R)[2], const int (&C)[2], unsigned (&v0)[2], unsigned (&v1)[2]) const {
        if (GATH) {
            const int i0 = (u.pm - (int)cl[LW_MTS + u.e]) * 256, cnt = (int)cl[LW_CNT + u.e];
            const int* rt = rowtok + (size_t)u.e * CAP;
#pragma unroll
            for (int i = 0; i < 2; ++i) {
                int s0 = i0 + R[i], s1 = i0 + 128 + R[i]; s0 = s0 < cnt ? s0 : 0; s1 = s1 < cnt ? s1 : 0;
                const int t0 = rt[s0], t1 = rt[s1];
                v0[i] = (unsigned)((t0 * K + C[i]) * 2); v1[i] = (unsigned)((t1 * K + C[i]) * 2);
            }
        } else {
#pragma unroll
            for (int i = 0; i < 2; ++i) { v0[i] = (unsigned)(((u.pm * 256 + R[i]) * K + C[i]) * 2); v1[i] = (unsigned)(((u.pm * 256 + 128 + R[i]) * K + C[i]) * 2); }
        }
    }
};

__device__ __forceinline__ float softplusf(float x) { return x > 20.f ? x : log1pf(__expf(x)); }

struct EpiIn {
    static constexpr bool PERM = true;
    bf16* xraw; float* dt; bf16* sz; bf16* scb; bf16* cu; const float* dt_bias;
    __device__ __forceinline__ void operator()(const f32x4 (&acc)[2][2][4][2], const Unit& u, int wr, int wc, int fr, int fq) const {
        const int row0 = u.pm * 256 + wr * 64 + fr, pn = u.pn, cl = wc * 32 + 8 * fq;
        if (pn <= 4 || pn == 6 || (pn >= 11 && pn <= 14)) {
            bf16* base; int ld;
            if (pn <= 4) { base = xraw + pn * 256; ld = XBCW; } else if (pn == 6) { base = xraw + 1280; ld = XBCW; } else { base = scb + (pn - 11) * 256; ld = 1024; }
#pragma unroll
            for (int ai = 0; ai < 2; ++ai)
#pragma unroll
                for (int m = 0; m < 4; ++m) { bf16* rowp = base + (size_t)(row0 + ai * 128 + m * 16) * ld + cl;
#pragma unroll
                    for (int bj = 0; bj < 2; ++bj) { const f32x4 v0 = acc[ai][bj][m][0], v1 = acc[ai][bj][m][1];
                        u32x4 w; w.x = pg8::cvt_pk_bf16(v0[0], v0[1]); w.y = pg8::cvt_pk_bf16(v0[2], v0[3]); w.z = pg8::cvt_pk_bf16(v1[0], v1[1]); w.w = pg8::cvt_pk_bf16(v1[2], v1[3]);
                        *(u32x4*)(rowp + bj * 128) = w; } }
        } else if (pn == 5) {
            if (wc == 0) {
                const f32x4 b0 = *(const f32x4*)(dt_bias + 8 * fq), b1 = *(const f32x4*)(dt_bias + 8 * fq + 4);
#pragma unroll
                for (int ai = 0; ai < 2; ++ai)
#pragma unroll
                    for (int m = 0; m < 4; ++m) { float* rowp = dt + (size_t)(row0 + ai * 128 + m * 16) * 32 + 8 * fq;
                        const f32x4 v0 = acc[ai][0][m][0] + b0, v1 = acc[ai][0][m][1] + b1; f32x4 o0, o1;
#pragma unroll
                        for (int j = 0; j < 4; ++j) { o0[j] = softplusf(v0[j]); o1[j] = softplusf(v1[j]); }
                        *(f32x4*)rowp = o0; *(f32x4*)(rowp + 4) = o1; }
            }
        } else if (pn <= 10) {
            bf16* base = sz + (pn - 7) * 256;
#pragma unroll
            for (int ai = 0; ai < 2; ++ai)
#pragma unroll
                for (int m = 0; m < 4; ++m) { bf16* rowp = base + (size_t)(row0 + ai * 128 + m * 16) * 1024 + cl;
#pragma unroll
                    for (int bj = 0; bj < 2; ++bj) { f32x4 v0 = acc[ai][bj][m][0], v1 = acc[ai][bj][m][1];
#pragma unroll
                        for (int j = 0; j < 4; ++j) { v0[j] = fsilu(v0[j]); v1[j] = fsilu(v1[j]); }
                        u32x4 w; w.x = pg8::cvt_pk_bf16(v0[0], v0[1]); w.y = pg8::cvt_pk_bf16(v0[2], v0[3]); w.z = pg8::cvt_pk_bf16(v1[0], v1[1]); w.w = pg8::cvt_pk_bf16(v1[2], v1[3]);
                        *(u32x4*)(rowp + bj * 128) = w; } }
        } else {
            bf16* base = cu + (pn - 15) * 128;
#pragma unroll
            for (int ai = 0; ai < 2; ++ai)
#pragma unroll
                for (int m = 0; m < 4; ++m) { bf16* rowp = base + (size_t)(row0 + ai * 128 + m * 16) * 1024 + cl;
                    const f32x4 v0 = acc[ai][0][m][0] * acc[ai][1][m][0], v1 = acc[ai][0][m][1] * acc[ai][1][m][1];
                    u32x4 w; w.x = pg8::cvt_pk_bf16(v0[0], v0[1]); w.y = pg8::cvt_pk_bf16(v0[2], v0[3]); w.z = pg8::cvt_pk_bf16(v1[0], v1[1]); w.w = pg8::cvt_pk_bf16(v1[2], v1[3]);
                    *(u32x4*)rowp = w; }
        }
    }
};
struct EpiOut {
    static constexpr bool PERM = false;
    const float* x; float* out; const float* mod;
    __device__ __forceinline__ void operator()(const f32x4 (&acc)[2][2][4][2], const Unit& u, int wr, int wc, int fr, int fq) const {
        const int row0 = u.pm * 256 + wr * 64 + fr, col0 = u.pn * 256 + wc * 32 + 4 * fq, b = u.pm >> 3;
        f32x4 gv[2][2];
#pragma unroll
        for (int bj = 0; bj < 2; ++bj)
#pragma unroll
            for (int n = 0; n < 2; ++n) gv[bj][n] = *(const f32x4*)(mod + (size_t)b * 6144 + 2048 + col0 + bj * 128 + n * 16);
#pragma unroll
        for (int ai = 0; ai < 2; ++ai)
#pragma unroll
            for (int m = 0; m < 4; ++m) { const size_t off = (size_t)(row0 + ai * 128 + m * 16) * 1024 + col0;
#pragma unroll
                for (int bj = 0; bj < 2; ++bj)
#pragma unroll
                    for (int n = 0; n < 2; ++n) { const f32x4 xv = *(const f32x4*)(x + off + bj * 128 + n * 16);
                        *(f32x4*)(out + off + bj * 128 + n * 16) = xv + gv[bj][n] * acc[ai][bj][m][n]; }
                asm volatile("" ::: "memory"); }
    }
};
struct EpiGU {
    static constexpr bool PERM = true;
    bf16* act; const float* bgu;
    __device__ __forceinline__ void operator()(const f32x4 (&acc)[2][2][4][2], const Unit& u, int wr, int wc, int fr, int fq) const {
        const int row0 = u.pm * 256 + wr * 64 + fr, cl = wc * 32 + 8 * fq, ch0 = u.pn * 128 + cl;
        const float* bp = bgu + (size_t)u.e * 2048 + ch0;
        const f32x4 bg0 = *(const f32x4*)bp, bg1 = *(const f32x4*)(bp + 4), bl0 = *(const f32x4*)(bp + 1024), bl1 = *(const f32x4*)(bp + 1028);
#pragma unroll
        for (int ai = 0; ai < 2; ++ai)
#pragma unroll
            for (int m = 0; m < 4; ++m) { bf16* rowp = act + (size_t)(row0 + ai * 128 + m * 16) * 1024 + ch0;
                f32x4 g0 = acc[ai][0][m][0] + bg0, g1 = acc[ai][0][m][1] + bg1, l0 = acc[ai][1][m][0] + bl0, l1 = acc[ai][1][m][1] + bl1, o0, o1;
#pragma unroll
                for (int j = 0; j < 4; ++j) {
                    const float ga = fminf(g0[j], 7.f), gb = fminf(g1[j], 7.f);
                    const float la = fminf(fmaxf(l0[j], -7.f), 7.f), lb = fminf(fmaxf(l1[j], -7.f), 7.f);
                    o0[j] = ga * __builtin_amdgcn_rcpf(1.0f + __expf(-1.702f * ga)) * (la + 1.0f);
                    o1[j] = gb * __builtin_amdgcn_rcpf(1.0f + __expf(-1.702f * gb)) * (lb + 1.0f); }
                u32x4 w; w.x = pg8::cvt_pk_bf16(o0[0], o0[1]); w.y = pg8::cvt_pk_bf16(o0[2], o0[3]); w.z = pg8::cvt_pk_bf16(o1[0], o1[1]); w.w = pg8::cvt_pk_bf16(o1[2], o1[3]);
                *(u32x4*)rowp = w; }
    }
};
struct EpiDown {
    static constexpr bool PERM = true;
    bf16* y; const float* bdn;
    __device__ __forceinline__ void operator()(const f32x4 (&acc)[2][2][4][2], const Unit& u, int wr, int wc, int fr, int fq) const {
        const int row0 = u.pm * 256 + wr * 64 + fr, col0 = u.pn * 256 + wc * 32 + 8 * fq;
        const float* bp = bdn + (size_t)u.e * 1024 + col0;
        f32x4 bv[2][2];
#pragma unroll
        for (int bj = 0; bj < 2; ++bj) { bv[bj][0] = *(const f32x4*)(bp + bj * 128); bv[bj][1] = *(const f32x4*)(bp + bj * 128 + 4); }
#pragma unroll
        for (int ai = 0; ai < 2; ++ai)
#pragma unroll
            for (int m = 0; m < 4; ++m) { bf16* rowp = y + (size_t)(row0 + ai * 128 + m * 16) * 1024 + col0;
#pragma unroll
                for (int bj = 0; bj < 2; ++bj) { const f32x4 v0 = acc[ai][bj][m][0] + bv[bj][0], v1 = acc[ai][bj][m][1] + bv[bj][1];
                    u32x4 w; w.x = pg8::cvt_pk_bf16(v0[0], v0[1]); w.y = pg8::cvt_pk_bf16(v0[2], v0[3]); w.z = pg8::cvt_pk_bf16(v1[0], v1[1]); w.w = pg8::cvt_pk_bf16(v1[2], v1[3]);
                    *(u32x4*)(rowp + bj * 128) = w; } }
    }
};

__device__ __forceinline__ void p0_item(const float* W, int ldw, int K, int k0, int n0, bf16* WT, int drow0, const float* kscale, LAS float* scr, int lane) {
#pragma unroll 8
    for (int i = 0; i < 32; ++i) { const int kk = 2 * i + (lane >> 5); float w = W[(size_t)(k0 + kk) * ldw + n0 + (lane & 31)]; if (kscale) w *= kscale[k0 + kk]; scr[kk * 33 + (lane & 31)] = w; }
    LDS_WAIT(); asm volatile("" ::: "memory");
    const int c = lane & 7;
#pragma unroll
    for (int j = 0; j < 4; ++j) { const int n = (lane >> 3) + 8 * j; const LAS float* s = scr + (8 * c) * 33 + n;
        u32x4 o; o.x = pk2(s[0 * 33], s[1 * 33]); o.y = pk2(s[2 * 33], s[3 * 33]); o.z = pk2(s[4 * 33], s[5 * 33]); o.w = pk2(s[6 * 33], s[7 * 33]);
        *(u32x4*)(WT + (size_t)(drow0 + n) * K + k0 + 8 * c) = o; }
    LDS_WAIT(); asm volatile("" ::: "memory");
}
__device__ __forceinline__ int win_drow(int n) {
    if (n < X0) return (7 + (n >> 8)) * 256 + (n & 255);
    if (n < B0) return n - X0;
    if (n < C0) return 4 * 256 + (n - B0);
    if (n < DT0) return 6 * 256 + (n - C0);
    if (n < SC0) return 5 * 256 + (n - DT0);
    n -= SC0;
    if (n < 1024) return (11 + (n >> 8)) * 256 + (n & 255);
    if (n < 2048) { n -= 1024; return (15 + (n >> 7)) * 256 + (n & 127); }
    n -= 2048; return (15 + (n >> 7)) * 256 + 128 + (n & 127);
}
__device__ __forceinline__ void phase0(Frame& F) {
    float* mod = (float*)(F.ws + WS_MOD);
    for (int it = F.vcu; it < 192; it += F.G) {
        LAS float* sc = (LAS float*)F.lds;
        LAS float* red = (LAS float*)(F.lds + 69632);
        for (int i = F.tid; i < 17 * 1024; i += 512) { const int r = i >> 10, k = i & 1023; const float v = (r < 16) ? F.c[r * 1024 + k] : F.c_ctx[k]; sc[i] = fsilu(v); }
        __syncthreads();
        const int col = F.tid & 31, kg = F.tid >> 5, n0 = it * 32;
        float acc[17];
#pragma unroll
        for (int r = 0; r < 17; ++r) acc[r] = 0.f;
        for (int q = 0; q < 16; ++q) {
            const int k = 4 * (kg + 16 * q);
            const float w0 = F.w_mod[(size_t)(k + 0) * 6144 + n0 + col], w1 = F.w_mod[(size_t)(k + 1) * 6144 + n0 + col], w2 = F.w_mod[(size_t)(k + 2) * 6144 + n0 + col], w3 = F.w_mod[(size_t)(k + 3) * 6144 + n0 + col];
#pragma unroll
            for (int r = 0; r < 17; ++r) { const f32x4 s = *(const LAS f32x4*)(sc + r * 1024 + k); acc[r] += s[0] * w0 + s[1] * w1 + s[2] * w2 + s[3] * w3; }
        }
#pragma unroll
        for (int r = 0; r < 17; ++r) red[(kg * 17 + r) * 32 + col] = acc[r];
        __syncthreads();
        for (int o = F.tid; o < 17 * 32; o += 512) { const int r = o >> 5, cc = o & 31; float s = F.b_mod[n0 + cc];
            for (int g = 0; g < 16; ++g) s += red[(g * 17 + r) * 32 + cc];
            mod[(size_t)r * 6144 + n0 + cc] = s; }
        __syncthreads();
    }
    LAS float* scr = (LAS float*)(F.lds + F.wave * 8448);
    const int gw = F.vcu * NWAVES + F.wave, NGW = F.G * NWAVES;
    constexpr int I_IN = 16 * 177, I_OUT = 32 * 32, I_GU = 32 * 16 * 64, I_DN = 32 * 16 * 32;
    bf16* win = (bf16*)(F.ws + WS_WIN); bf16* wout = (bf16*)(F.ws + WS_WOUT); bf16* wgu = (bf16*)(F.ws + WS_WGU); bf16* wdn = (bf16*)(F.ws + WS_WDN);
    for (int it = gw; it < I_IN + I_OUT + I_GU + I_DN; it += NGW) {
        int r = it;
        if (r < I_IN) { const int kb = r / 177, nb = r % 177; p0_item(F.w_in, IN_W, 1024, kb * 64, nb * 32, win, win_drow(nb * 32), nullptr, scr, F.lane); continue; } r -= I_IN;
        if (r < I_OUT) { const int kb = r >> 5, nb = r & 31; p0_item(F.w_out, 1024, 2048, kb * 64, nb * 32, wout, nb * 32, kb < 16 ? F.ssd_norm_g : nullptr, scr, F.lane); continue; } r -= I_OUT;
        if (r < I_GU) { const int e = r >> 10, q = r & 1023, kb = q >> 6, nb = q & 63; const int n = nb * 32;
            const int drow = n < 1024 ? (n >> 7) * 256 + (n & 127) : ((n - 1024) >> 7) * 256 + 128 + ((n - 1024) & 127);
            p0_item(F.w_gu + (size_t)e * 1024 * 2048, 2048, 1024, kb * 64, n, wgu + (size_t)e * 2048 * 1024, drow, nullptr, scr, F.lane); continue; } r -= I_GU;
        { const int e = r >> 9, q = r & 511, kb = q >> 5, nb = q & 31;
            p0_item(F.w_dn + (size_t)e * 1024 * 1024, 1024, 1024, kb * 64, nb * 32, wdn + (size_t)e * 1024 * 1024, nb * 32, nullptr, scr, F.lane); }
    }
}

__device__ __forceinline__ void phase1(Frame& F) {
    const float* mod = (const float*)(F.ws + WS_MOD); bf16* hx = (bf16*)(F.ws + WS_HX);
    const int gw = F.vcu * NWAVES + F.wave, NGW = F.G * NWAVES;
    for (int row = gw; row < TT; row += NGW) {
        const float* src = row < TL ? F.x + (size_t)row * 1024 : F.ctx + (size_t)(row - TL) * 1024;
        const int mb = row < TL ? (row >> 11) : 16;
        const float* shift = mod + (size_t)mb * 6144, *scale = shift + 1024;
        f32x4 v[4]; float s = 0.f;
#pragma unroll
        for (int j = 0; j < 4; ++j) { v[j] = *(const f32x4*)(src + 4 * F.lane + 256 * j); s += (v[j][0] * v[j][0] + v[j][1] * v[j][1]) + (v[j][2] * v[j][2] + v[j][3] * v[j][3]); }
        const float rs = 1.0f / sqrtf(wave_sum(s) * (1.f / 1024.f) + NORM_EPS);
#pragma unroll
        for (int j = 0; j < 4; ++j) { const int c = 4 * F.lane + 256 * j;
            const f32x4 g = *(const f32x4*)(F.norm1_g + c), sh = *(const f32x4*)(shift + c), sc = *(const f32x4*)(scale + c);
            const f32x4 o = v[j] * rs * g * (sc + 1.0f) + sh;
            u32x2 w; w.x = pk2(o[0], o[1]); w.y = pk2(o[2], o[3]);
            *(u32x2*)(hx + (size_t)row * 1024 + c) = w; }
    }
}

__device__ __forceinline__ void unpack8(const u32x4 w, float (&f)[8]) { f[0] = bflo(w.x); f[1] = bfhi(w.x); f[2] = bflo(w.y); f[3] = bfhi(w.y); f[4] = bflo(w.z); f[5] = bfhi(w.z); f[6] = bflo(w.w); f[7] = bfhi(w.w); }
__device__ __forceinline__ void phase_conv(Frame& F) {
    const bf16* xraw = (const bf16*)(F.ws + WS_XRAW); bf16* xbc = (bf16*)(F.ws + WS_XBC);
    if (F.tid >= 384) return;
    const int cp = F.tid % 192, rs = F.tid / 192, c0 = cp * 8;
    float w0[8], w1[8], w2[8], bb[8];
#pragma unroll
    for (int e = 0; e < 8; ++e) { w0[e] = F.conv_w[c0 + e]; w1[e] = F.conv_w[XBCW + c0 + e]; w2[e] = F.conv_w[2 * XBCW + c0 + e]; bb[e] = F.conv_b[c0 + e]; }
    for (int it = F.vcu; it < TT / 32; it += F.G) {
        const int r0 = it * 32 + rs * 16;
        const bool isctx = r0 >= TL;
        if (isctx && c0 >= 1280) continue;
        const int L = isctx ? CTXL : SEQ, t0 = isctx ? ((r0 - TL) & (CTXL - 1)) : (r0 & (SEQ - 1));
        const u32x4 zero = (u32x4){0u, 0u, 0u, 0u};
        u32x4 prev = (t0 > 0) ? *(const u32x4*)(xraw + (size_t)(r0 - 1) * XBCW + c0) : zero;
        u32x4 cur = *(const u32x4*)(xraw + (size_t)r0 * XBCW + c0);
        for (int hf = 0; hf < 2; ++hf) {
            float o[8][8];
#pragma unroll
            for (int i = 0; i < 8; ++i) {
                const int ri = hf * 8 + i;
                const u32x4 nxt = (t0 + ri + 1 < L) ? *(const u32x4*)(xraw + (size_t)(r0 + ri + 1) * XBCW + c0) : zero;
                float a[8], b[8], c[8]; unpack8(prev, a); unpack8(cur, b); unpack8(nxt, c);
#pragma unroll
                for (int e = 0; e < 8; ++e) o[i][e] = fsilu(w0[e] * a[e] + w1[e] * b[e] + w2[e] * c[e] + bb[e]);
                u32x4 w; w.x = pk2(o[i][0], o[i][1]); w.y = pk2(o[i][2], o[i][3]); w.z = pk2(o[i][4], o[i][5]); w.w = pk2(o[i][6], o[i][7]);
                *(u32x4*)(xbc + (size_t)(r0 + ri) * XBCW + c0) = w;
                prev = cur; cur = nxt;
            }
        }
    }
}

namespace ssd {
constexpr int LDC = 136, LDJ = 72;
constexpr int S_CC = 0, S_BC = 17408, S_X = 34816, S_XW = 44032, S_G = 53248, S_HB = 62464, S_CS = 79872, S_DTV = 80384, S_W = 80896, S_TOT = 81408;
__device__ __forceinline__ bf16x8 ldfrag(const LAS unsigned char* base, int row, int ld, int k) { return *(const LAS bf16x8*)(base + (size_t)(row * ld + k) * 2); }
typedef short v4i16_t __attribute__((ext_vector_type(4)));
__device__ __forceinline__ bf16x8 ldfrag_tr(const LAS unsigned char* base, int ld, int k0, int c0, int lane) {
    const int g = lane >> 4, q = (lane & 15) >> 2, p = lane & 3;
    const LAS unsigned char* a = base + (size_t)((k0 + 8 * g + q) * ld + c0 + 4 * p) * 2;
    const v4i16_t lo = __builtin_amdgcn_ds_read_tr16_b64_v4i16((LAS v4i16_t*)a);
    const v4i16_t hi = __builtin_amdgcn_ds_read_tr16_b64_v4i16((LAS v4i16_t*)(a + (size_t)4 * ld * 2));
    return __builtin_shufflevector(lo, hi, 0, 1, 2, 3, 4, 5, 6, 7);
}
}
__device__ __forceinline__ int ssd_rowbase(int b, int dir, int s) {
    return s < 4 ? TL + b * CTXL + (dir ? (3 - s) : s) * 64 : b * SEQ + (dir ? (35 - s) : (s - 4)) * 64;
}
#define SSD_LOADS(sidx) do { const int rb_ = ssd_rowbase(b, dir, (sidx)); const bool ctx_ = (sidx) < 4; \
    _Pragma("unroll") for (int q2 = 0; q2 < 2; ++q2) { const int q = tid + 512 * q2, row = q >> 4, n8 = q & 15; \
        const bf16* p = xbc + (size_t)(rb_ + row) * XBCW + 1024 + g * 128 + n8 * 8; \
        bR[q2] = *(const u32x4*)p; cR[q2] = ctx_ ? (u32x4){0u, 0u, 0u, 0u} : *(const u32x4*)(p + 256); } \
    xR = *(const u32x4*)(xbc + (size_t)(rb_ + (tid >> 3)) * XBCW + h * 64 + (tid & 7) * 8); } while (0)
#define SSD_SCAN(dtj_, par_) do { const int j = dir ? (63 - lane) : lane; float v = (dtj_) * a; \
    _Pragma("unroll") for (int o = 1; o < 64; o <<= 1) { const float t = __shfl_up(v, o); v += (lane >= o) ? t : 0.f; } \
    const float total = __shfl(v, 63); \
    cs[(par_) * 64 + j] = v; dtv[(par_) * 64 + j] = (dtj_); wv[(par_) * 64 + j] = __expf(total - v) * (dtj_); if (lane == 0) tot[(par_)] = total; } while (0)
__device__ __forceinline__ void phase_ssd(Frame& F) {
    using namespace ssd;
    const bf16* xbc = (const bf16*)(F.ws + WS_XBC); const float* dtb = (const float*)(F.ws + WS_DT);
    LAS unsigned char* L = F.lds;
    LAS float* cs = (LAS float*)(L + S_CS); LAS float* dtv = (LAS float*)(L + S_DTV); LAS float* wv = (LAS float*)(L + S_W); LAS float* tot = (LAS float*)(L + S_TOT);
    const int tid = F.tid, lane = F.lane, w = F.wave, fr = lane & 15, fq = lane >> 4;
    for (int it = F.vcu; it < 512; it += F.G) {
        const int b = it >> 5, h = (it >> 1) & 15, dir = it & 1, g = h >> 3;
        const float a = -__expf(F.a_log[dir * 16 + h]);
        const int dtcol = dir * 16 + h;
        bf16* ydir = (bf16*)(F.ws + (dir ? WS_YB : WS_YF));
        f32x4 Hacc[4];
#pragma unroll
        for (int tp = 0; tp < 4; ++tp) Hacc[tp] = (f32x4){0.f, 0.f, 0.f, 0.f};
        u32x4 cR[2], bR[2], xR;
        if (w == 0) { const int j = dir ? (63 - lane) : lane; const float d0 = dtb[(size_t)(ssd_rowbase(b, dir, 0) + j) * 32 + dtcol]; SSD_SCAN(d0, 0); }
        SSD_LOADS(0);
        __syncthreads();
        for (int s = 0; s < 36; ++s) {
            const bool isctx = s < 4; const int par = s & 1;
            const int rowbase = ssd_rowbase(b, dir, s);
#pragma unroll
            for (int q2 = 0; q2 < 2; ++q2) asm volatile("" : "+v"(bR[q2]), "+v"(cR[q2]));
            asm volatile("" : "+v"(xR));
#pragma unroll
            for (int q2 = 0; q2 < 2; ++q2) { const int q = tid + 512 * q2, row = q >> 4, n8 = q & 15;
                *(LAS u32x4*)(L + S_BC + (size_t)(row * LDC + n8 * 8) * 2) = bR[q2];
                *(LAS u32x4*)(L + S_CC + (size_t)(row * LDC + n8 * 8) * 2) = cR[q2]; }
            { const int row = tid >> 3, p8 = tid & 7;
                *(LAS u32x4*)(L + S_X + (size_t)(row * LDJ + p8 * 8) * 2) = xR;
                float f[8]; unpack8(xR, f); const float wj = wv[par * 64 + row];
                u32x4 o; o.x = pk2(f[0] * wj, f[1] * wj); o.y = pk2(f[2] * wj, f[3] * wj); o.z = pk2(f[4] * wj, f[5] * wj); o.w = pk2(f[6] * wj, f[7] * wj);
                *(LAS u32x4*)(L + S_XW + (size_t)(row * LDJ + p8 * 8) * 2) = o; }
            __syncthreads();
            float dnext = 0.f;
            if (s + 1 < 36) {
                if (w == 0) { const int j = dir ? (63 - lane) : lane; dnext = dtb[(size_t)(ssd_rowbase(b, dir, s + 1) + j) * 32 + dtcol]; }
                SSD_LOADS(s + 1);
            }
            if (!isctx) {
                {
                    const int ti = w & 3, tj0 = w >> 2, tj1 = tj0 + 2;
                    const bool need0 = dir ? (tj0 >= ti) : (tj0 <= ti), need1 = dir ? (tj1 >= ti) : (tj1 <= ti);
                    bf16x8 cf[4], bf0[4], bf1[4];
#pragma unroll
                    for (int k = 0; k < 4; ++k) cf[k] = ldfrag(L + S_CC, 16 * ti + fr, LDC, 32 * k + 8 * fq);
                    if (need0) {
#pragma unroll
                        for (int k = 0; k < 4; ++k) bf0[k] = ldfrag(L + S_BC, 16 * tj0 + fr, LDC, 32 * k + 8 * fq); }
                    if (need1) {
#pragma unroll
                        for (int k = 0; k < 4; ++k) bf1[k] = ldfrag(L + S_BC, 16 * tj1 + fr, LDC, 32 * k + 8 * fq); }
                    const int i = 16 * ti + fr; const float csi = cs[par * 64 + i];
                    const f32x4 csj0 = *(const LAS f32x4*)(cs + par * 64 + 16 * tj0 + 4 * fq), csj1 = *(const LAS f32x4*)(cs + par * 64 + 16 * tj1 + 4 * fq);
                    const f32x4 dtj0 = *(const LAS f32x4*)(dtv + par * 64 + 16 * tj0 + 4 * fq), dtj1 = *(const LAS f32x4*)(dtv + par * 64 + 16 * tj1 + 4 * fq);
                    f32x4 a0 = (f32x4){0.f, 0.f, 0.f, 0.f}, a1 = (f32x4){0.f, 0.f, 0.f, 0.f};
                    if (need0) {
#pragma unroll
                        for (int k = 0; k < 4; ++k) a0 = __builtin_amdgcn_mfma_f32_16x16x32_bf16(bf0[k], cf[k], a0, 0, 0, 0); }
                    if (need1) {
#pragma unroll
                        for (int k = 0; k < 4; ++k) a1 = __builtin_amdgcn_mfma_f32_16x16x32_bf16(bf1[k], cf[k], a1, 0, 0, 0); }
                    float g0[4], g1[4];
#pragma unroll
                    for (int r = 0; r < 4; ++r) {
                        const int j0 = 16 * tj0 + 4 * fq + r, j1 = 16 * tj1 + 4 * fq + r;
                        const bool ok0 = dir ? (j0 >= i) : (j0 <= i), ok1 = dir ? (j1 >= i) : (j1 <= i);
                        g0[r] = ok0 ? a0[r] * __expf(csi - csj0[r]) * dtj0[r] : 0.f;
                        g1[r] = ok1 ? a1[r] * __expf(csi - csj1[r]) * dtj1[r] : 0.f; }
                    u32x2 o0, o1; o0.x = pk2(g0[0], g0[1]); o0.y = pk2(g0[2], g0[3]); o1.x = pk2(g1[0], g1[1]); o1.y = pk2(g1[2], g1[3]);
                    *(LAS u32x2*)(L + S_G + (size_t)(i * LDJ + 16 * tj0 + 4 * fq) * 2) = o0;
                    *(LAS u32x2*)(L + S_G + (size_t)(i * LDJ + 16 * tj1 + 4 * fq) * 2) = o1;
                }
                __syncthreads();
            }
            if (w == 0 && s + 1 < 36) { SSD_SCAN(dnext, par ^ 1); }
            bf16x8 xwf[4][2], af[2];
#pragma unroll
            for (int k = 0; k < 2; ++k) { af[k] = ldfrag_tr(L + S_BC, LDC, 32 * k, 16 * w, lane);
#pragma unroll
                for (int tp = 0; tp < 4; ++tp) xwf[tp][k] = ldfrag_tr(L + S_XW, LDJ, 32 * k, 16 * tp, lane); }
            const float dec = __expf(tot[par]);
            if (!isctx) {
                const int ti = w & 3, tp0 = w >> 2, tp1 = tp0 + 2;
                bf16x8 gf[2], cf[4], h0[4], h1[4];
#pragma unroll
                for (int k = 0; k < 2; ++k) gf[k] = ldfrag(L + S_G, 16 * ti + fr, LDJ, 32 * k + 8 * fq);
#pragma unroll
                for (int k = 0; k < 4; ++k) { cf[k] = ldfrag(L + S_CC, 16 * ti + fr, LDC, 32 * k + 8 * fq); h0[k] = ldfrag(L + S_HB, 16 * tp0 + fr, LDC, 32 * k + 8 * fq); h1[k] = ldfrag(L + S_HB, 16 * tp1 + fr, LDC, 32 * k + 8 * fq); }
                const int i = 16 * ti + fr; const float ei = __expf(cs[par * 64 + i]);
                f32x4 yd0 = (f32x4){0.f, 0.f, 0.f, 0.f}, yd1 = yd0, yo0 = yd0, yo1 = yd0;
#pragma unroll
                for (int k = 0; k < 2; ++k) { const bf16x8 xa = ldfrag_tr(L + S_X, LDJ, 32 * k, 16 * tp0, lane), xb = ldfrag_tr(L + S_X, LDJ, 32 * k, 16 * tp1, lane);
                    yd0 = __builtin_amdgcn_mfma_f32_16x16x32_bf16(xa, gf[k], yd0, 0, 0, 0); yd1 = __builtin_amdgcn_mfma_f32_16x16x32_bf16(xb, gf[k], yd1, 0, 0, 0); }
#pragma unroll
                for (int k = 0; k < 4; ++k) { yo0 = __builtin_amdgcn_mfma_f32_16x16x32_bf16(h0[k], cf[k], yo0, 0, 0, 0); yo1 = __builtin_amdgcn_mfma_f32_16x16x32_bf16(h1[k], cf[k], yo1, 0, 0, 0); }
                const f32x4 y0 = yd0 + yo0 * ei, y1 = yd1 + yo1 * ei;
                u32x2 o0, o1; o0.x = pk2(y0[0], y0[1]); o0.y = pk2(y0[2], y0[3]); o1.x = pk2(y1[0], y1[1]); o1.y = pk2(y1[2], y1[3]);
                bf16* yp = ydir + (size_t)(rowbase + i) * 1024 + h * 64 + 4 * fq;
                *(u32x2*)(yp + 16 * tp0) = o0; *(u32x2*)(yp + 16 * tp1) = o1;
            }
#pragma unroll
            for (int tp = 0; tp < 4; ++tp) { Hacc[tp] = Hacc[tp] * dec;
#pragma unroll
                for (int k = 0; k < 2; ++k) Hacc[tp] = __builtin_amdgcn_mfma_f32_16x16x32_bf16(af[k], xwf[tp][k], Hacc[tp], 0, 0, 0); }
            __syncthreads();
#pragma unroll
            for (int tp = 0; tp < 4; ++tp) { u32x2 o; o.x = pk2(Hacc[tp][0], Hacc[tp][1]); o.y = pk2(Hacc[tp][2], Hacc[tp][3]);
                *(LAS u32x2*)(L + S_HB + (size_t)((16 * tp + fr) * LDC + 16 * w + 4 * fq) * 2) = o; }
        }
        __syncthreads();
    }
}

__device__ __forceinline__ void phase_combine(Frame& F) {
    const bf16* xbc = (const bf16*)(F.ws + WS_XBC); const bf16* yf = (const bf16*)(F.ws + WS_YF); const bf16* yb = (const bf16*)(F.ws + WS_YB);
    const bf16* sz = (const bf16*)(F.ws + WS_SZ); const bf16* scb = (const bf16*)(F.ws + WS_SCB); const bf16* cu = (const bf16*)(F.ws + WS_CU);
    bf16* a2 = (bf16*)(F.ws + WS_A2);
    const int g = F.wave & 1, sub = F.wave >> 1, c = g * 512 + F.lane * 8;
    const float dsk = F.ssd_d[c >> 6];
    const int c2 = (F.tid & 127) * 8, sub2 = F.tid >> 7;
    float k0[8], k1[8], k2[8];
#pragma unroll
    for (int e = 0; e < 8; ++e) { k0[e] = F.sc_conv_w[c2 + e]; k1[e] = F.sc_conv_w[1024 + c2 + e]; k2[e] = F.sc_conv_w[2048 + c2 + e]; }
    for (int it = F.vcu; it < TL / 64; it += F.G) {
        const int tb = it * 64;
        for (int i = 0; i < 16; ++i) {
            const int t = tb + sub * 16 + i;
            float a[8], b2[8], x[8], z[8], v[8]; float ss = 0.f;
            unpack8(*(const u32x4*)(yf + (size_t)t * 1024 + c), a); unpack8(*(const u32x4*)(yb + (size_t)t * 1024 + c), b2);
            unpack8(*(const u32x4*)(xbc + (size_t)t * XBCW + c), x); unpack8(*(const u32x4*)(sz + (size_t)t * 1024 + c), z);
#pragma unroll
            for (int e = 0; e < 8; ++e) { v[e] = (a[e] + b2[e] + dsk * x[e]) * z[e]; ss += v[e] * v[e]; }
            const float rs = 1.0f / sqrtf(wave_sum(ss) * (1.f / 512.f) + NORM_EPS);
            u32x4 o; o.x = pk2(v[0] * rs, v[1] * rs); o.y = pk2(v[2] * rs, v[3] * rs); o.z = pk2(v[4] * rs, v[5] * rs); o.w = pk2(v[6] * rs, v[7] * rs);
            *(u32x4*)(a2 + (size_t)t * 2048 + c) = o;
        }
        for (int i = 0; i < 16; ++i) {
            const int t = tb + sub2 * 16 + i, tt = t & (SEQ - 1);
            const u32x4 zero = (u32x4){0u, 0u, 0u, 0u};
            float p[8], q[8], n[8], sb[8], o8[8];
            unpack8(tt >= 64 ? *(const u32x4*)(cu + (size_t)(t - 64) * 1024 + c2) : zero, p);
            unpack8(*(const u32x4*)(cu + (size_t)t * 1024 + c2), q);
            unpack8(tt + 64 < SEQ ? *(const u32x4*)(cu + (size_t)(t + 64) * 1024 + c2) : zero, n);
            unpack8(*(const u32x4*)(scb + (size_t)t * 1024 + c2), sb);
#pragma unroll
            for (int e = 0; e < 8; ++e) o8[e] = sb[e] * (k0[e] * p[e] + k1[e] * q[e] + k2[e] * n[e]);
            u32x4 o; o.x = pk2(o8[0], o8[1]); o.y = pk2(o8[2], o8[3]); o.z = pk2(o8[4], o8[5]); o.w = pk2(o8[6], o8[7]);
            *(u32x4*)(a2 + (size_t)t * 2048 + 1024 + c2) = o;
        }
    }
}

__device__ __forceinline__ void phase_router(Frame& F) {
    const float* mod = (const float*)(F.ws + WS_MOD); bf16* h2 = (bf16*)(F.ws + WS_HX);
    int* rowtok = (int*)(F.ws + WS_ROWTOK); int* tokes = (int*)(F.ws + WS_TOKES); float* tokg = (float*)(F.ws + WS_TOKG);
    LAS unsigned char* L = F.lds;
    LAS f32x4* WR = (LAS f32x4*)L;
    LAS float* mulv = (LAS float*)(L + 131072);
    LAS float* shv = (LAS float*)(L + 131072 + 4096);
    LAS int* tinfo = (LAS int*)(L + 131072 + 8192);
    LAS int* lcnt = (LAS int*)(L + 131072 + 8192 + 6144);
    LAS int* lbase = lcnt + 32;
    for (int i = F.tid; i < 8192; i += 512) { const int k = i >> 3, e4 = i & 7; WR[e4 * 1024 + k] = *(const f32x4*)(F.w_router + (size_t)k * 32 + e4 * 4); }
    if (F.tid < 32) lcnt[F.tid] = 0;
    const int lane = F.lane;
    const int myexp = ((lane >> 5) & 1) * 16 + ((lane >> 4) & 1) * 8 + ((lane >> 3) & 1) * 4 + ((lane >> 2) & 1) * 2 + ((lane >> 1) & 1);
    const float mybias = F.b_router[myexp];
    for (int blk = F.vcu; blk < TL / 128; blk += F.G) {
        const int bb = (blk * 128) >> 11;
        __syncthreads();
        for (int k = F.tid; k < 1024; k += 512) { mulv[k] = F.norm2_g[k] * (1.0f + mod[(size_t)bb * 6144 + 4 * 1024 + k]); shv[k] = mod[(size_t)bb * 6144 + 3 * 1024 + k]; }
        __syncthreads();
        for (int i = 0; i < 16; ++i) {
            const int tl = F.wave * 16 + i, t = blk * 128 + tl;
            const float* xr = F.out + (size_t)t * 1024;
            float hv[16]; float ss = 0.f;
#pragma unroll
            for (int jj = 0; jj < 16; ++jj) { hv[jj] = xr[lane + 64 * jj]; ss += hv[jj] * hv[jj]; }
            const float rs = 1.0f / sqrtf(wave_sum(ss) * (1.f / 1024.f) + NORM_EPS);
            float acc[32];
#pragma unroll
            for (int e = 0; e < 32; ++e) acc[e] = 0.f;
#pragma unroll
            for (int jj = 0; jj < 16; ++jj) { const int k = lane + 64 * jj;
                const float hval = hv[jj] * rs * mulv[k] + shv[k];
                h2[(size_t)t * 1024 + k] = (bf16)f2bf(hval);
#pragma unroll
                for (int e4 = 0; e4 < 8; ++e4) { const f32x4 wq = WR[e4 * 1024 + k];
                    acc[4 * e4 + 0] += hval * wq[0]; acc[4 * e4 + 1] += hval * wq[1]; acc[4 * e4 + 2] += hval * wq[2]; acc[4 * e4 + 3] += hval * wq[3]; } }
            float r16[16], r8[8], r4[4], r2[2], r1;
            { const bool hi = (lane & 32) != 0;
#pragma unroll
              for (int e = 0; e < 16; ++e) { const float send = hi ? acc[e] : acc[e + 16]; const float recv = __shfl_xor(send, 32); r16[e] = (hi ? acc[e + 16] : acc[e]) + recv; } }
            { const bool hi = (lane & 16) != 0;
#pragma unroll
              for (int e = 0; e < 8; ++e) { const float send = hi ? r16[e] : r16[e + 8]; const float recv = __shfl_xor(send, 16); r8[e] = (hi ? r16[e + 8] : r16[e]) + recv; } }
            { const bool hi = (lane & 8) != 0;
#pragma unroll
              for (int e = 0; e < 4; ++e) { const float send = hi ? r8[e] : r8[e + 4]; const float recv = __shfl_xor(send, 8); r4[e] = (hi ? r8[e + 4] : r8[e]) + recv; } }
            { const bool hi = (lane & 4) != 0;
#pragma unroll
              for (int e = 0; e < 2; ++e) { const float send = hi ? r4[e] : r4[e + 2]; const float recv = __shfl_xor(send, 4); r2[e] = (hi ? r4[e + 2] : r4[e]) + recv; } }
            { const bool hi = (lane & 2) != 0; const float send = hi ? r2[0] : r2[1]; const float recv = __shfl_xor(send, 2); r1 = (hi ? r2[1] : r2[0]) + recv; }
            r1 += __shfl_xor(r1, 1);
            float val = r1 + mybias;
            int sel[4]; float sv[4];
#pragma unroll
            for (int kk = 0; kk < 4; ++kk) {
                float bv = val; int bi = myexp;
#pragma unroll
                for (int o = 1; o < 64; o <<= 1) { const float ov = __shfl_xor(bv, o); const int oi = __shfl_xor(bi, o); if (ov > bv || (ov == bv && oi < bi)) { bv = ov; bi = oi; } }
                sel[kk] = bi; sv[kk] = bv; if (myexp == bi) val = -3.0e38f;
            }
            const float p1 = __expf(sv[1] - sv[0]), p2 = __expf(sv[2] - sv[0]), p3 = __expf(sv[3] - sv[0]);
            const float inv = 1.0f / (1.0f + p1 + p2 + p3);
            const float gt[4] = {inv, p1 * inv, p2 * inv, p3 * inv};
            if (lane < 4) {
                const int e = lane == 0 ? sel[0] : lane == 1 ? sel[1] : lane == 2 ? sel[2] : sel[3];
                const float gg = lane == 0 ? gt[0] : lane == 1 ? gt[1] : lane == 2 ? gt[2] : gt[3];
                const int ls = atomicAdd((int*)&lcnt[e], 1);
                tinfo[(tl * 4 + lane) * 3 + 0] = e; tinfo[(tl * 4 + lane) * 3 + 1] = ls; tinfo[(tl * 4 + lane) * 3 + 2] = __float_as_int(gg);
            }
        }
        __syncthreads();
        if (F.tid < 32) { const int n = lcnt[F.tid]; lbase[F.tid] = (int)__hip_atomic_fetch_add((unsigned*)(F.ctl + CW_ECNT + F.tid), (unsigned)n, RLX_AGENT); }
        __syncthreads();
        { const int tl = F.tid >> 2, kk = F.tid & 3, t = blk * 128 + tl;
          const int e = tinfo[(tl * 4 + kk) * 3 + 0], ls = tinfo[(tl * 4 + kk) * 3 + 1]; const float gg = __int_as_float(tinfo[(tl * 4 + kk) * 3 + 2]);
          const int slot = lbase[e] + ls;
          rowtok[(size_t)e * CAP + slot] = t; tokes[t * 4 + kk] = e * CAP + slot; tokg[t * 4 + kk] = gg; }
        __syncthreads();
        if (F.tid < 32) lcnt[F.tid] = 0;
    }
    __syncthreads();
}

__device__ __forceinline__ void build_mt_table(Frame& F) {
    __syncthreads();
    if (F.tid == 0) { int s = 0;
        for (int e = 0; e < 32; ++e) { const int c = (int)__hip_atomic_load(F.ctl + CW_ECNT + e, RLX_AGENT); F.cl[LW_CNT + e] = (unsigned)c; F.cl[LW_MTS + e] = (unsigned)s; s += (c + 255) >> 8; }
        F.cl[LW_MTS + 32] = (unsigned)s; }
    __syncthreads();
}

__device__ __forceinline__ void phase_final(Frame& F) {
    const float* mod = (const float*)(F.ws + WS_MOD); const bf16* yrows = (const bf16*)(F.ws + WS_YROWS);
    const int* tokes = (const int*)(F.ws + WS_TOKES); const float* tokg = (const float*)(F.ws + WS_TOKG);
    const int gw = F.vcu * NWAVES + F.wave, NGW = F.G * NWAVES, lane = F.lane;
    for (int t = gw; t < TL; t += NGW) {
        const int b = t >> 11;
        float m[16];
#pragma unroll
        for (int e = 0; e < 16; ++e) m[e] = 0.f;
#pragma unroll
        for (int kk = 0; kk < 4; ++kk) {
            const int es = tokes[t * 4 + kk]; const float gg = tokg[t * 4 + kk];
            const int e = es >> 15, slot = es & (CAP - 1);
            const size_t pos = (size_t)F.cl[LW_MTS + e] * 256 + slot;
            float y0[8], y1[8];
            unpack8(*(const u32x4*)(yrows + pos * 1024 + lane * 8), y0); unpack8(*(const u32x4*)(yrows + pos * 1024 + 512 + lane * 8), y1);
#pragma unroll
            for (int q = 0; q < 8; ++q) { m[q] += gg * y0[q]; m[8 + q] += gg * y1[q]; }
        }
        float x2[16]; float ss = 0.f;
#pragma unroll
        for (int hf = 0; hf < 2; ++hf)
#pragma unroll
            for (int q4 = 0; q4 < 2; ++q4) { const int c = hf * 512 + lane * 8 + q4 * 4;
                const f32x4 xv = *(const f32x4*)(F.out + (size_t)t * 1024 + c), gv = *(const f32x4*)(mod + (size_t)b * 6144 + 5 * 1024 + c);
#pragma unroll
                for (int j = 0; j < 4; ++j) { const float v = xv[j] + gv[j] * m[hf * 8 + q4 * 4 + j]; x2[hf * 8 + q4 * 4 + j] = v; ss += v * v; } }
        const float rs = 1.0f / sqrtf(wave_sum(ss) * (1.f / 1024.f) + NORM_EPS);
#pragma unroll
        for (int hf = 0; hf < 2; ++hf)
#pragma unroll
            for (int q4 = 0; q4 < 2; ++q4) { const int c = hf * 512 + lane * 8 + q4 * 4;
                const f32x4 fg = *(const f32x4*)(F.final_g + c); f32x4 o;
#pragma unroll
                for (int j = 0; j < 4; ++j) o[j] = x2[hf * 8 + q4 * 4 + j] * rs * fg[j];
                *(f32x4*)(F.out + (size_t)t * 1024 + c) = o; }
    }
}

constexpr int NPHASE = 11;
__global__ void __launch_bounds__(NWAVES * 64, 2) mk_fwd(Args args) {
    extern __shared__ __attribute__((aligned(16))) unsigned char lds_raw[];
    Frame F;
    F.lds = (LAS unsigned char*)lds_raw;
    F.cl = (volatile LAS unsigned*)(F.lds + CTLDS_OFF);
    F.tid = threadIdx.x; F.lane = F.tid & 63; F.wave = __builtin_amdgcn_readfirstlane(F.tid >> 6);
    F.G = gridDim.x; { const int bx = blockIdx.x; F.vcu = (F.G % 8 == 0) ? (bx % 8) * (F.G / 8) + bx / 8 : bx; }
    F.ws = args.ws; F.ctl = (gu32*)(args.ws + WS_CTL); F.out = args.out;
    F.x = args.in[0]; F.c = args.in[1]; F.ctx = args.in[2]; F.c_ctx = args.in[3]; F.w_mod = args.in[4]; F.b_mod = args.in[5]; F.norm1_g = args.in[6]; F.w_in = args.in[7];
    F.conv_w = args.in[8]; F.conv_b = args.in[9]; F.dt_bias = args.in[10]; F.a_log = args.in[11]; F.ssd_d = args.in[12]; F.ssd_norm_g = args.in[13]; F.sc_conv_w = args.in[14];
    F.w_out = args.in[15]; F.norm2_g = args.in[16]; F.w_router = args.in[17]; F.b_router = args.in[18]; F.w_gu = args.in[19]; F.b_gu = args.in[20]; F.w_dn = args.in[21]; F.b_dn = args.in[22]; F.final_g = args.in[23];
    for (int u = F.tid; u < (LDS_BYTES - CTLDS_OFF) / 4; u += NWAVES * 64) ((LAS unsigned*)(F.lds + CTLDS_OFF))[u] = 0u;
    __syncthreads();
    const int lo = args.ph_lo, hi = args.ph_hi;
    XcdBarrier bar; bar.bar = (unsigned*)(F.ctl + CW_BAR); bar.x = 0; bar.st = nullptr;
    if (hi - lo > 1) bar = xcd_barrier_post((unsigned*)(F.ctl + CW_BAR), F.cl + LW_BARST);
#define IN(k) (lo <= (k) && (k) < hi)
#define SEAM(k) do { if (IN(k) && IN((k) + 1)) xcd_barrier(bar); } while (0)

#define RUNPH(k, body) do { if (IN(k)) { body; if ((PROBE_DOUBLE >> (k)) & 1) { xcd_barrier(bar); body; } SEAM(k); } } while (0)
    RUNPH(0, phase0(F));
    RUNPH(1, phase1(F));
#define BODY2 { SchedIn S{F.G, F.vcu, 1024, (const bf16*)(F.ws + WS_WIN)}; \
        EpiIn E{(bf16*)(F.ws + WS_XRAW), (float*)(F.ws + WS_DT), (bf16*)(F.ws + WS_SZ), (bf16*)(F.ws + WS_SCB), (bf16*)(F.ws + WS_CU), F.dt_bias}; \
        pg8::gemm_phase<EpiIn, SchedIn>(F.lds, (const bf16*)(F.ws + WS_HX), 1024, S, E); }
    RUNPH(2, BODY2);
    RUNPH(3, phase_conv(F));
    RUNPH(4, phase_ssd(F));
    RUNPH(5, phase_combine(F));
#define BODY6 { SchedPlain S{F.G, F.vcu, 2048, 4, 512, (const bf16*)(F.ws + WS_WOUT)}; \
        EpiOut E{F.x, F.out, (const float*)(F.ws + WS_MOD)}; \
        pg8::gemm_phase<EpiOut, SchedPlain>(F.lds, (const bf16*)(F.ws + WS_A2), 2048, S, E); }
    RUNPH(6, BODY6);
    if (IN(7)) { phase_router(F); SEAM(7); }
#define BODY8 { build_mt_table(F); \
        SchedMoe<true> S{F.G, F.vcu, 1024, 8, (const bf16*)(F.ws + WS_WGU), F.cl, (const int*)(F.ws + WS_ROWTOK)}; \
        EpiGU E{(bf16*)(F.ws + WS_ACT), F.b_gu}; \
        pg8::gemm_phase<EpiGU, SchedMoe<true>>(F.lds, (const bf16*)(F.ws + WS_HX), 1024, S, E); }
    RUNPH(8, BODY8);
#define BODY9 { build_mt_table(F); \
        SchedMoe<false> S{F.G, F.vcu, 1024, 4, (const bf16*)(F.ws + WS_WDN), F.cl, nullptr}; \
        EpiDown E{(bf16*)(F.ws + WS_YROWS), F.b_dn}; \
        pg8::gemm_phase<EpiDown, SchedMoe<false>>(F.lds, (const bf16*)(F.ws + WS_ACT), 1024, S, E); }
    RUNPH(9, BODY9);
    if (IN(10)) { build_mt_table(F); phase_final(F); }
#undef IN
#undef SEAM
}

extern "C" void kernel_launch(void* const* d_in, const int* in_sizes, int n_in, void* d_out, int out_size, void* d_ws, size_t ws_size, hipStream_t stream) {
    static int grid = 0;
    if (grid == 0) {
        if (n_in != 24 || out_size != TL * D || ws_size < WS_END) { fprintf(stderr, "kernel_launch: unexpected shapes (n_in %d out %d ws %zu); nothing launched\n", n_in, out_size, ws_size); grid = -1; return; }
        int dev = 0, cus = 0;
        if (hipGetDevice(&dev) != hipSuccess || hipDeviceGetAttribute(&cus, hipDeviceAttributeMultiprocessorCount, dev) != hipSuccess) { grid = -1; return; }
        if (hipFuncSetAttribute((const void*)mk_fwd, hipFuncAttributeMaxDynamicSharedMemorySize, LDS_BYTES) != hipSuccess) { fprintf(stderr, "kernel_launch: hipFuncSetAttribute failed\n"); grid = -1; return; }
        int per_cu = 0;
        if (hipOccupancyMaxActiveBlocksPerMultiprocessor(&per_cu, (const void*)mk_fwd, NWAVES * 64, LDS_BYTES) != hipSuccess || per_cu < 1) fprintf(stderr, "kernel_launch: occupancy query says %d\n", per_cu);
        (void)hipGetLastError();
        grid = cus;
    }
    if (grid < 0) return;
    (void)hipMemsetAsync((char*)d_ws + WS_CTL, 0, CTL_ZERO_BYTES, stream);
    Args a{};
    for (int i = 0; i < 24; ++i) a.in[i] = (const float*)d_in[i];
    a.out = (float*)d_out; a.ws = (unsigned char*)d_ws;
#if MK_ONE_LAUNCH
    a.ph_lo = 0; a.ph_hi = NPHASE;
    hipLaunchKernelGGL(mk_fwd, dim3(grid), dim3(NWAVES * 64), LDS_BYTES, stream, a);
#else
    for (int p = 0; p < NPHASE; ++p) { a.ph_lo = p; a.ph_hi = p + 1; hipLaunchKernelGGL(mk_fwd, dim3(grid), dim3(NWAVES * 64), LDS_BYTES, stream, a); }
#endif
}
```

```cpp
#include <hip/hip_runtime.h>
#include <cstdio>
#include <cstdint>

#ifndef MK_ONE_LAUNCH
#define MK_ONE_LAUNCH 1
#endif
#ifndef PROBE_DOUBLE
#define PROBE_DOUBLE 0
#endif
#ifndef PROBE_EPI2
#define PROBE_EPI2 0
#endif

#define LAS __attribute__((address_space(3)))
#define GAS __attribute__((address_space(1)))
typedef unsigned short bf16;
typedef short bf16x8 __attribute__((ext_vector_type(8)));
typedef float f32x4 __attribute__((ext_vector_type(4)));
typedef float f32x2 __attribute__((ext_vector_type(2)));
typedef unsigned u32x4 __attribute__((ext_vector_type(4)));
typedef unsigned u32x2 __attribute__((ext_vector_type(2)));
typedef GAS unsigned gu32;

constexpr int D = 1024, NB = 16, SEQ = 2048, CTXL = 256;
constexpr int TL = NB * SEQ;
constexpr int TC = NB * CTXL;
constexpr int TT = TL + TC;
constexpr int IN_W = 5664, X0 = 1024, B0 = 2048, C0 = 2304, DT0 = 2560, SC0 = 2592;
constexpr int NE = 32, TOPK = 4, DFF = 1024;
constexpr int XBCW = 1536;
constexpr int NT_IN = 23;
constexpr int CAP = TL;
constexpr int ACT_ROWS = TL * TOPK + NE * 256;
constexpr float NORM_EPS = 1e-6f;

constexpr size_t MiB = 1u << 20;
constexpr size_t WS_CTL = 0, CTL_ZERO_BYTES = 1 * MiB;
constexpr size_t WS_MOD = 1 * MiB;
constexpr size_t WS_TOKES = 2 * MiB;
constexpr size_t WS_TOKG = 2 * MiB + 512 * 1024;
constexpr size_t WS_ROWTOK = 3 * MiB;
constexpr size_t WS_WIN = 7 * MiB;
constexpr size_t WS_WOUT = 19 * MiB;
constexpr size_t WS_WGU = 23 * MiB;
constexpr size_t WS_WDN = 151 * MiB;
constexpr size_t WS_HX = 215 * MiB;
constexpr size_t WS_XRAW = 287 * MiB;
constexpr size_t WS_XBC = 395 * MiB;
constexpr size_t WS_DT = 503 * MiB;
constexpr size_t WS_SZ = 508 * MiB;
constexpr size_t WS_SCB = 572 * MiB;
constexpr size_t WS_CU = 636 * MiB;
constexpr size_t WS_YF = 700 * MiB;
constexpr size_t WS_YB = 764 * MiB;
constexpr size_t WS_A2 = 828 * MiB;
constexpr size_t WS_ACT = 287 * MiB;
constexpr size_t WS_YROWS = 572 * MiB;
constexpr size_t WS_END = 956 * MiB;
constexpr int CW_ECNT = 64;
constexpr int CW_BAR = 4096;

constexpr int LDS_BYTES = 147456;
constexpr int CTLDS_OFF = 146432;
constexpr int LW_BARST = 0;
constexpr int LW_MTS = 16;
constexpr int LW_CNT = 64;

constexpr int NWAVES = 8;

#define LDS_WAIT() asm volatile("s_waitcnt lgkmcnt(0)" ::: "memory")
#define VM_WAIT() asm volatile("s_waitcnt vmcnt(0)" ::: "memory")
#define RLX_AGENT __ATOMIC_RELAXED, __HIP_MEMORY_SCOPE_AGENT

__device__ __forceinline__ unsigned f2bf(float f) { unsigned u = __builtin_bit_cast(unsigned, f); return (u + 0x7fffu + ((u >> 16) & 1u)) >> 16; }
typedef __bf16 hwbf16x2 __attribute__((ext_vector_type(2)));
__device__ __forceinline__ unsigned pk2(float lo, float hi) { const f32x2 v = {lo, hi}; const hwbf16x2 b = __builtin_convertvector(v, hwbf16x2); return __builtin_bit_cast(unsigned, b); }
__device__ __forceinline__ float bf2f(unsigned b) { return __builtin_bit_cast(float, b << 16); }
__device__ __forceinline__ float bflo(unsigned w) { return __builtin_bit_cast(float, w << 16); }
__device__ __forceinline__ float bfhi(unsigned w) { return __builtin_bit_cast(float, w & 0xffff0000u); }
__device__ __forceinline__ float fsilu(float x) { return x * __builtin_amdgcn_rcpf(1.0f + __expf(-x)); }
__device__ __forceinline__ float wave_sum(float v) {
#pragma unroll
    for (int o = 1; o < 64; o <<= 1) v += __shfl_xor(v, o);
    return v;
}

#define XB_TMO      128
#define XB_XCNT(j)  (256  + 64 * (j))
#define XB_XSUB(j)  (1280 + 64 * (j))
#define XB_XGEN(j)  (2304 + 64 * (j))
#define XB_TOP      3328
#define XB_TOPGEN   3392
#define XCD_BAR_WORDS 3456
#define XB_SPIN_CAP (1u << 18)
__device__ __forceinline__ unsigned xb_ld(unsigned* p)              { return __hip_atomic_load(p, __ATOMIC_RELAXED, __HIP_MEMORY_SCOPE_AGENT); }
__device__ __forceinline__ unsigned xb_add(unsigned* p, unsigned v) { return __hip_atomic_fetch_add(p, v, __ATOMIC_RELAXED, __HIP_MEMORY_SCOPE_AGENT); }
__device__ __forceinline__ unsigned xb_xcc_id() { return (unsigned)__builtin_amdgcn_s_getreg((3 << 11) | 20) & 0xFu; }
#define XB_SPIN(cond, bar) do { unsigned _sp = 0; while (cond) { __builtin_amdgcn_s_sleep(1); \
    if ((++_sp & 255u) == 0u) { if (xb_ld(&(bar)[XB_TMO])) break; if (_sp > XB_SPIN_CAP) { atomicAdd(&(bar)[XB_TMO], 1u); break; } } } } while (0)
struct XcdBarrier { unsigned* bar; unsigned x; volatile LAS unsigned* st; };
__device__ __forceinline__ XcdBarrier xcd_barrier_post(unsigned* bar, volatile LAS unsigned* st) {
    XcdBarrier b; b.bar = bar; b.x = xb_xcc_id(); b.st = st;
    if (threadIdx.x == 0) (void)xb_add(&bar[XB_XCNT(b.x)], 1u);
    return b;
}
__device__ __forceinline__ void xcd_barrier_complete(unsigned* bar, unsigned x, unsigned& nloc, unsigned& nx) {
    const unsigned G = gridDim.x * gridDim.y * gridDim.z;
    unsigned sum, cnt, mine, sp = 0u;
    for (;;) {
        sum = 0u; cnt = 0u; mine = 0u;
#pragma unroll
        for (unsigned j = 0; j < 16; ++j) { const unsigned c = xb_ld(&bar[XB_XCNT(j)]); sum += c; cnt += (c > 0u) ? 1u : 0u; mine = (j == x) ? c : mine; }
        if (sum == G) break;
        __builtin_amdgcn_s_sleep(1);
        if ((++sp & 255u) == 0u) { if (xb_ld(&bar[XB_TMO])) break; if (sp > XB_SPIN_CAP) { atomicAdd(&bar[XB_TMO], 1u); break; } }
    }
    nloc = mine > 0u ? mine : 1u; nx = cnt > 0u ? cnt : 1u;
}
__device__ __forceinline__ void xcd_barrier(const XcdBarrier& b) {
    asm volatile("s_waitcnt vmcnt(0)" ::: "memory");
    __syncthreads();
    if (threadIdx.x == 0) {
        unsigned* bar = b.bar;
        __builtin_amdgcn_s_waitcnt(0);
        unsigned nloc = b.st[0], nx = b.st[1];
        if (nloc == 0u) { xcd_barrier_complete(bar, b.x, nloc, nx); b.st[0] = nloc; b.st[1] = nx; }
        const unsigned old = xb_add(&bar[XB_XSUB(b.x)], 1u);
        const unsigned gen = old / nloc;
        if (old + 1u == (gen + 1u) * nloc) {
            __builtin_amdgcn_fence(__ATOMIC_RELEASE, "agent");
            asm volatile("s_waitcnt vmcnt(0)" ::: "memory");
            const unsigned og = xb_add(&bar[XB_TOP], 1u);
            const unsigned tg = og / nx;
            if (og + 1u == (tg + 1u) * nx) xb_add(&bar[XB_TOPGEN], 1u);
            else XB_SPIN(xb_ld(&bar[XB_TOPGEN]) == tg, bar);
            __builtin_amdgcn_fence(__ATOMIC_ACQUIRE, "agent");
            xb_add(&bar[XB_XGEN(b.x)], 1u);
            asm volatile("s_waitcnt vmcnt(0)" ::: "memory");
        } else {
            XB_SPIN(xb_ld(&bar[XB_XGEN(b.x)]) == gen, bar);
            __builtin_amdgcn_fence(__ATOMIC_ACQUIRE, "agent");
            asm volatile("s_waitcnt vmcnt(0)" ::: "memory");
        }
    }
    __syncthreads();
}

struct Args { const float* in[24]; float* out; unsigned char* ws; int ph_lo, ph_hi; };
struct Frame {
    LAS unsigned char* lds;
    volatile LAS unsigned* cl;
    unsigned char* ws;
    gu32* ctl;
    int tid, lane, wave, vcu, G;
    const float *x, *c, *ctx, *c_ctx, *w_mod, *b_mod, *norm1_g, *w_in, *conv_w, *conv_b, *dt_bias, *a_log, *ssd_d, *ssd_norm_g, *sc_conv_w, *w_out, *norm2_g, *w_router, *b_router, *w_gu, *b_gu, *w_dn, *b_dn, *final_g;
    float* out;
};

namespace pg8 {
constexpr int BM = 256, BK = 64, HALF = 128, HTB = HALF * BK * 2, STAGE_BYTES = 8 * HTB;
__device__ __forceinline__ int lds_byte(int r, int c) { const int st = (r >> 4) * 2 + (c >> 5), rr = r & 15, cc = c & 31, ob = rr * 64 + cc * 2; return st * 1024 + (ob ^ (((ob >> 9) & 1) << 5)); }
__device__ __forceinline__ void stage_rc(int b, int& R, int& C) { const int st = b / 1024, sb = b % 1024, swz = sb ^ (((sb >> 9) & 1) << 5); R = (st >> 1) * 16 + swz / 64; C = (st & 1) * 32 + (swz % 64) / 2; }
__device__ __forceinline__ int perm32(int rho) { const int n = rho >> 4, i = rho & 15; return 8 * (i >> 2) + 4 * n + (i & 3); }
__device__ __forceinline__ unsigned cvt_pk_bf16(float lo, float hi) { unsigned r; asm volatile("v_cvt_pk_bf16_f32 %0, %1, %2" : "=v"(r) : "v"(lo), "v"(hi)); return r; }

struct Unit { int pm, pn, e; };

template <class Epi, class Sched>
__device__ __forceinline__ void gemm_phase(LAS unsigned char* lds, const bf16* Aptr, const int K, const Sched& S, const Epi& E) {
    const int tid = threadIdx.x, wid = __builtin_amdgcn_readfirstlane(tid >> 6), lane = tid & 63, wr = wid >> 2, wc = wid & 3, fr = lane & 15, fq = lane >> 4;
    const int nt = K / BK;
    int sR[2], sC[2];
    unsigned voffB[2];
#pragma unroll
    for (int i = 0; i < 2; ++i) { int R, C; stage_rc(tid * 16 + i * 8192, R, C); const int Rb = Epi::PERM ? ((R & ~31) + perm32(R & 31)) : R;
        sR[i] = R; sC[i] = C; voffB[i] = (unsigned)(Rb * K + C) * 2u; }
    const size_t kstep = (size_t)(BK * 2);
    const size_t hstep = (size_t)HALF * K * 2;
    const unsigned ldsw = (unsigned)wid * 1024u;
    const int aoff = lds_byte(wr * 64 + fr, fq * 8), boff = lds_byte(wc * 32 + fr, fq * 8);
    const char* const Abase = (const char*)Aptr;
#define PG8_SA(b, h) (((b) * 2 + (h)) * HTB)
#define PG8_SB(b, h) ((4 + (b) * 2 + (h)) * HTB)
#define PG8_STAGE(bufoff, gbase, voff) do { _Pragma("unroll") for (int _i = 0; _i < 2; ++_i) \
        __builtin_amdgcn_global_load_lds((const unsigned*)((const char*)(gbase) + (voff)[_i]), (LAS unsigned*)(lds + (bufoff) + ldsw + _i * 8192), 16, 0, 0); } while (0)
#define PG8_LDA(dst, b, h) do { _Pragma("unroll") for (int m = 0; m < 4; ++m) _Pragma("unroll") for (int k = 0; k < 2; ++k) dst[m][k] = *(const LAS bf16x8*)(lds + PG8_SA(b, h) + aoff + m * 2048 + k * 1024); } while (0)
#define PG8_LDB(dst, b, h) do { _Pragma("unroll") for (int n = 0; n < 2; ++n) _Pragma("unroll") for (int k = 0; k < 2; ++k) dst[n][k] = *(const LAS bf16x8*)(lds + PG8_SB(b, h) + boff + n * 2048 + k * 1024); } while (0)
#define PG8_MMA(ai, bj, At, Bt) do { __builtin_amdgcn_s_setprio(1); _Pragma("unroll") for (int m = 0; m < 4; ++m) _Pragma("unroll") for (int n = 0; n < 2; ++n) _Pragma("unroll") for (int k = 0; k < 2; ++k) \
        acc[ai][bj][m][n] = __builtin_amdgcn_mfma_f32_16x16x32_bf16(Bt[n][k], At[m][k], acc[ai][bj][m][n], 0, 0, 0); __builtin_amdgcn_s_setprio(0); } while (0)
#define PG8_WAIT_V(n) asm volatile("s_waitcnt vmcnt(" #n ")" ::: "memory")
#define PG8_WAIT_L(n) asm volatile("s_waitcnt lgkmcnt(" #n ")" ::: "memory")
#define PG8_BAR __builtin_amdgcn_s_barrier()
#define PG8_SCHED __builtin_amdgcn_sched_barrier(0)
    Unit cur, nxt; int ui = 0;
    if (!S.next(0, cur)) return;
    f32x4 acc[2][2][4][2];
#pragma unroll
    for (int a = 0; a < 2; ++a)
#pragma unroll
        for (int b = 0; b < 2; ++b)
#pragma unroll
            for (int m = 0; m < 4; ++m)
#pragma unroll
                for (int n = 0; n < 2; ++n) acc[a][b][m][n] = (f32x4){0.f, 0.f, 0.f, 0.f};
    bf16x8 At[4][2], B0[2][2], B1[2][2];
    unsigned va0[2], va1[2];
    S.aoff(cur, sR, sC, va0, va1);
    if (Sched::GATHER) { asm volatile("s_waitcnt vmcnt(0)" ::: "memory"); asm volatile("" : "+v"(va0[0]), "+v"(va0[1]), "+v"(va1[0]), "+v"(va1[1])); }
    const char* cB = S.bbase(cur);
    PG8_STAGE(PG8_SB(0, 0), cB, voffB); PG8_STAGE(PG8_SB(0, 1), cB + hstep, voffB); PG8_STAGE(PG8_SA(0, 0), Abase, va0); PG8_STAGE(PG8_SA(0, 1), Abase, va1);
    if (wr == 1) PG8_BAR;
    PG8_WAIT_V(2); PG8_BAR;
    PG8_STAGE(PG8_SB(1, 0), cB + kstep, voffB); PG8_STAGE(PG8_SA(1, 0), Abase + kstep, va0); PG8_STAGE(PG8_SB(1, 1), cB + hstep + kstep, voffB);
    PG8_WAIT_V(6); PG8_BAR;
    for (;;) {
        const bool has_next = S.next(ui + 1, nxt);
        const char* nB = has_next ? S.bbase(nxt) : cB;
        for (int t = 0; t < nt; t += 2) {
            const bool last = (t == nt - 2);
            const char* a1 = Abase + (size_t)(t + 1) * kstep;
            const char* a2 = last ? Abase : Abase + (size_t)(t + 2) * kstep; const char* b2 = last ? nB : cB + (size_t)(t + 2) * kstep;
            const char* a3 = a2 + kstep; const char* b3 = b2 + kstep;
            unsigned nva0[2], nva1[2];
            nva0[0] = va0[0]; nva0[1] = va0[1]; nva1[0] = va1[0]; nva1[1] = va1[1];
            if (last && has_next) {
                S.aoff(nxt, sR, sC, nva0, nva1);
                if (Sched::GATHER) { asm volatile("s_waitcnt vmcnt(0)" ::: "memory"); asm volatile("" : "+v"(nva0[0]), "+v"(nva0[1]), "+v"(nva1[0]), "+v"(nva1[1])); }
            }
            PG8_LDB(B0, 0, 0); PG8_LDB(B1, 0, 1); PG8_SCHED; PG8_LDA(At, 0, 0); PG8_STAGE(PG8_SA(1, 1), a1, va1);
            PG8_WAIT_V(8); PG8_WAIT_L(0); PG8_BAR; PG8_MMA(0, 0, At, B0); PG8_MMA(0, 1, At, B1); PG8_BAR; PG8_SCHED;
            if (last) { va0[0] = nva0[0]; va0[1] = nva0[1]; va1[0] = nva1[0]; va1[1] = nva1[1]; }
            PG8_LDA(At, 0, 1); PG8_STAGE(PG8_SB(0, 0), b2, voffB); PG8_STAGE(PG8_SB(0, 1), b2 + hstep, voffB); PG8_STAGE(PG8_SA(0, 0), a2, va0);
            PG8_WAIT_V(8); PG8_WAIT_L(0); PG8_BAR; PG8_MMA(1, 0, At, B0); PG8_MMA(1, 1, At, B1); PG8_BAR; PG8_SCHED;
            PG8_LDB(B0, 1, 0); PG8_LDB(B1, 1, 1); PG8_SCHED; PG8_LDA(At, 1, 0); PG8_STAGE(PG8_SA(0, 1), a2, va1);
            PG8_WAIT_V(8); PG8_WAIT_L(0); PG8_BAR; PG8_MMA(0, 0, At, B0); PG8_MMA(0, 1, At, B1); PG8_BAR; PG8_SCHED;
            PG8_LDA(At, 1, 1); PG8_STAGE(PG8_SB(1, 0), b3, voffB); PG8_STAGE(PG8_SB(1, 1), b3 + hstep, voffB); PG8_STAGE(PG8_SA(1, 0), a3, va0);
            PG8_WAIT_V(8); PG8_WAIT_L(0); PG8_BAR; PG8_MMA(1, 0, At, B0); PG8_MMA(1, 1, At, B1); PG8_BAR; PG8_SCHED;
        }
        if (wr == 0) PG8_BAR;
        E(acc, cur, wr, wc, fr, fq);
#if PROBE_EPI2
        E(acc, cur, wr, wc, fr, fq);
#endif
        if (!has_next) break;
#pragma unroll
        for (int a = 0; a < 2; ++a)
#pragma unroll
            for (int b = 0; b < 2; ++b)
#pragma unroll
                for (int m = 0; m < 4; ++m)
#pragma unroll
                    for (int n = 0; n < 2; ++n) acc[a][b][m][n] = (f32x4){0.f, 0.f, 0.f, 0.f};
        cur = nxt; cB = nB; ++ui;
        if (wr == 1) PG8_BAR;
    }
    PG8_WAIT_V(0);
    PG8_BAR;
#undef PG8_SA
#undef PG8_SB
#undef PG8_STAGE
#undef PG8_LDA
#undef PG8_LDB
#undef PG8_MMA
#undef PG8_WAIT_V
#undef PG8_WAIT_L
#undef PG8_BAR
#undef PG8_SCHED
}
}

using pg8::Unit;
struct SchedIn {
    static constexpr bool GATHER = false;
    int G, v, K; const bf16* Bt;
    __device__ __forceinline__ bool next(int i, Unit& u) const {
        int L = i * G + v; if (L >= 3040) return false;
        if (L < 2944) { const int gid = L / 184, l = L % 184; u.pm = gid * 8 + (l & 7); u.pn = l >> 3; }
        else { L -= 2944; const int gid = L / 48, l = L % 48; u.pm = 128 + gid * 8 + (l & 7); u.pn = l >> 3; }
        u.e = 0; return true;
    }
    __device__ __forceinline__ const char* bbase(const Unit& u) const { return (const char*)Bt + (size_t)u.pn * ((size_t)256 * K * 2); }
    __device__ __forceinline__ void aoff(const Unit& u, const int (&R)[2], const int (&C)[2], unsigned (&v0)[2], unsigned (&v1)[2]) const {
#pragma unroll
        for (int i = 0; i < 2; ++i) { v0[i] = (unsigned)(((u.pm * 256 + R[i]) * K + C[i]) * 2); v1[i] = (unsigned)(((u.pm * 256 + 128 + R[i]) * K + C[i]) * 2); }
    }
};
struct SchedPlain {
    static constexpr bool GATHER = false;
    int G, v, K, nN, nwg; const bf16* Bt;
    __device__ __forceinline__ bool next(int i, Unit& u) const {
        const int L = i * G + v; if (L >= nwg) return false;
        const int per = 8 * nN, gid = L / per, l = L % per; u.pm = gid * 8 + (l & 7); u.pn = l >> 3; u.e = 0; return true;
    }
    __device__ __forceinline__ const char* bbase(const Unit& u) const { return (const char*)Bt + (size_t)u.pn * ((size_t)256 * K * 2); }
    __device__ __forceinline__ void aoff(const Unit& u, const int (&R)[2], const int (&C)[2], unsigned (&v0)[2], unsigned (&v1)[2]) const {
#pragma unroll
        for (int i = 0; i < 2; ++i) { v0[i] = (unsigned)(((u.pm * 256 + R[i]) * K + C[i]) * 2); v1[i] = (unsigned)(((u.pm * 256 + 128 + R[i]) * K + C[i]) * 2); }
    }
};
template <bool GATH> struct SchedMoe {
    static constexpr bool GATHER = GATH;
    int G, v, K, NT; const bf16* Bt; const volatile LAS unsigned* cl; const int* rowtok;
    __device__ __forceinline__ bool next(int i, Unit& u) const {
        const int L = i * G + v; const int mt = L / NT; const int tot = (int)cl[LW_MTS + 32];
        if (mt >= tot) return false;
        int e = 0;
        while (e < 31 && (int)cl[LW_MTS + e + 1] <= mt) ++e;
        u.pm = mt; u.pn = L - mt * NT; u.e = e; return true;
    }
    __device__ __forceinline__ const char* bbase(const Unit& u) const { return (const char*)Bt + ((size_t)u.e * NT + u.pn) * ((size_t)256 * K * 2); }
    __device__ __forceinline__ void aoff(const Unit& u, const int (&R)[2], const int (&C)[2], unsigned (&v0)[2], unsigned (&v1)[2]) const {
        if (GATH) {
            const int i0 = (u.pm - (int)cl[LW_MTS + u.e]) * 256, cnt = (int)cl[LW_CNT + u.e];
            const int* rt = rowtok + (size_t)u.e * CAP;
#pragma unroll
            for (int i = 0; i < 2; ++i) {
                int s0 = i0 + R[i], s1 = i0 + 128 + R[i]; s0 = s0 < cnt ? s0 : 0; s1 = s1 < cnt ? s1 : 0;
                const int t0 = rt[s0], t1 = rt[s1];
                v0[i] = (unsigned)((t0 * K + C[i]) * 2); v1[i] = (unsigned)((t1 * K + C[i]) * 2);
            }
        } else {
#pragma unroll
            for (int i = 0; i < 2; ++i) { v0[i] = (unsigned)(((u.pm * 256 + R[i]) * K + C[i]) * 2); v1[i] = (unsigned)(((u.pm * 256 + 128 + R[i]) * K + C[i]) * 2); }
        }
    }
};

__device__ __forceinline__ float softplusf(float x) { return x > 20.f ? x : log1pf(__expf(x)); }

struct EpiIn {
    static constexpr bool PERM = true;
    bf16* xraw; float* dt; bf16* sz; bf16* scb; bf16* cu; const float* dt_bias;
    __device__ __forceinline__ void operator()(const f32x4 (&acc)[2][2][4][2], const Unit& u, int wr, int wc, int fr, int fq) const {
        const int row0 = u.pm * 256 + wr * 64 + fr, pn = u.pn, cl = wc * 32 + 8 * fq;
        if (pn <= 4 || pn == 6 || (pn >= 11 && pn <= 14)) {
            bf16* base; int ld;
            if (pn <= 4) { base = xraw + pn * 256; ld = XBCW; } else if (pn == 6) { base = xraw + 1280; ld = XBCW; } else { base = scb + (pn - 11) * 256; ld = 1024; }
#pragma unroll
            for (int ai = 0; ai < 2; ++ai)
#pragma unroll
                for (int m = 0; m < 4; ++m) { bf16* rowp = base + (size_t)(row0 + ai * 128 + m * 16) * ld + cl;
#pragma unroll
                    for (int bj = 0; bj < 2; ++bj) { const f32x4 v0 = acc[ai][bj][m][0], v1 = acc[ai][bj][m][1];
                        u32x4 w; w.x = pg8::cvt_pk_bf16(v0[0], v0[1]); w.y = pg8::cvt_pk_bf16(v0[2], v0[3]); w.z = pg8::cvt_pk_bf16(v1[0], v1[1]); w.w = pg8::cvt_pk_bf16(v1[2], v1[3]);
                        *(u32x4*)(rowp + bj * 128) = w; } }
        } else if (pn == 5) {
            if (wc == 0) {
                const f32x4 b0 = *(const f32x4*)(dt_bias + 8 * fq), b1 = *(const f32x4*)(dt_bias + 8 * fq + 4);
#pragma unroll
                for (int ai = 0; ai < 2; ++ai)
#pragma unroll
                    for (int m = 0; m < 4; ++m) { float* rowp = dt + (size_t)(row0 + ai * 128 + m * 16) * 32 + 8 * fq;
                        const f32x4 v0 = acc[ai][0][m][0] + b0, v1 = acc[ai][0][m][1] + b1; f32x4 o0, o1;
#pragma unroll
                        for (int j = 0; j < 4; ++j) { o0[j] = softplusf(v0[j]); o1[j] = softplusf(v1[j]); }
                        *(f32x4*)rowp = o0; *(f32x4*)(rowp + 4) = o1; }
            }
        } else if (pn <= 10) {
            bf16* base = sz + (pn - 7) * 256;
#pragma unroll
            for (int ai = 0; ai < 2; ++ai)
#pragma unroll
                for (int m = 0; m < 4; ++m) { bf16* rowp = base + (size_t)(row0 + ai * 128 + m * 16) * 1024 + cl;
#pragma unroll
                    for (int bj = 0; bj < 2; ++bj) { f32x4 v0 = acc[ai][bj][m][0], v1 = acc[ai][bj][m][1];
#pragma unroll
                        for (int j = 0; j < 4; ++j) { v0[j] = fsilu(v0[j]); v1[j] = fsilu(v1[j]); }
                        u32x4 w; w.x = pg8::cvt_pk_bf16(v0[0], v0[1]); w.y = pg8::cvt_pk_bf16(v0[2], v0[3]); w.z = pg8::cvt_pk_bf16(v1[0], v1[1]); w.w = pg8::cvt_pk_bf16(v1[2], v1[3]);
                        *(u32x4*)(rowp + bj * 128) = w; } }
        } else {
            bf16* base = cu + (pn - 15) * 128;
#pragma unroll
            for (int ai = 0; ai < 2; ++ai)
#pragma unroll
                for (int m = 0; m < 4; ++m) { bf16* rowp = base + (size_t)(row0 + ai * 128 + m * 16) * 1024 + cl;
                    const f32x4 v0 = acc[ai][0][m][0] * acc[ai][1][m][0], v1 = acc[ai][0][m][1] * acc[ai][1][m][1];
                    u32x4 w; w.x = pg8::cvt_pk_bf16(v0[0], v0[1]); w.y = pg8::cvt_pk_bf16(v0[2], v0[3]); w.z = pg8::cvt_pk_bf16(v1[0], v1[1]); w.w = pg8::cvt_pk_bf16(v1[2], v1[3]);
                    *(u32x4*)rowp = w; }
        }
    }
};
struct EpiOut {
    static constexpr bool PERM = false;
    const float* x; float* out; const float* mod;
    __device__ __forceinline__ void operator()(const f32x4 (&acc)[2][2][4][2], const Unit& u, int wr, int wc, int fr, int fq) const {
        const int row0 = u.pm * 256 + wr * 64 + fr, col0 = u.pn * 256 + wc * 32 + 4 * fq, b = u.pm >> 3;
        f32x4 gv[2][2];
#pragma unroll
        for (int bj = 0; bj < 2; ++bj)
#pragma unroll
            for (int n = 0; n < 2; ++n) gv[bj][n] = *(const f32x4*)(mod + (size_t)b * 6144 + 2048 + col0 + bj * 128 + n * 16);
#pragma unroll
        for (int ai = 0; ai < 2; ++ai)
#pragma unroll
            for (int m = 0; m < 4; ++m) { const size_t off = (size_t)(row0 + ai * 128 + m * 16) * 1024 + col0;
#pragma unroll
                for (int bj = 0; bj < 2; ++bj)
#pragma unroll
                    for (int n = 0; n < 2; ++n) { const f32x4 xv = *(const f32x4*)(x + off + bj * 128 + n * 16);
                        *(f32x4*)(out + off + bj * 128 + n * 16) = xv + gv[bj][n] * acc[ai][bj][m][n]; }
                asm volatile("" ::: "memory"); }
    }
};
struct EpiGU {
    static constexpr bool PERM = true;
    bf16* act; const float* bgu;
    __device__ __forceinline__ void operator()(const f32x4 (&acc)[2][2][4][2], const Unit& u, int wr, int wc, int fr, int fq) const {
        const int row0 = u.pm * 256 + wr * 64 + fr, cl = wc * 32 + 8 * fq, ch0 = u.pn * 128 + cl;
        const float* bp = bgu + (size_t)u.e * 2048 + ch0;
        const f32x4 bg0 = *(const f32x4*)bp, bg1 = *(const f32x4*)(bp + 4), bl0 = *(const f32x4*)(bp + 1024), bl1 = *(const f32x4*)(bp + 1028);
#pragma unroll
        for (int ai = 0; ai < 2; ++ai)
#pragma unroll
            for (int m = 0; m < 4; ++m) { bf16* rowp = act + (size_t)(row0 + ai * 128 + m * 16) * 1024 + ch0;
                f32x4 g0 = acc[ai][0][m][0] + bg0, g1 = acc[ai][0][m][1] + bg1, l0 = acc[ai][1][m][0] + bl0, l1 = acc[ai][1][m][1] + bl1, o0, o1;
#pragma unroll
                for (int j = 0; j < 4; ++j) {
                    const float ga = fminf(g0[j], 7.f), gb = fminf(g1[j], 7.f);
                    const float la = fminf(fmaxf(l0[j], -7.f), 7.f), lb = fminf(fmaxf(l1[j], -7.f), 7.f);
                    o0[j] = ga * __builtin_amdgcn_rcpf(1.0f + __expf(-1.702f * ga)) * (la + 1.0f);
                    o1[j] = gb * __builtin_amdgcn_rcpf(1.0f + __expf(-1.702f * gb)) * (lb + 1.0f); }
                u32x4 w; w.x = pg8::cvt_pk_bf16(o0[0], o0[1]); w.y = pg8::cvt_pk_bf16(o0[2], o0[3]); w.z = pg8::cvt_pk_bf16(o1[0], o1[1]); w.w = pg8::cvt_pk_bf16(o1[2], o1[3]);
                *(u32x4*)rowp = w; }
    }
};
struct EpiDown {
    static constexpr bool PERM = true;
    bf16* y; const float* bdn;
    __device__ __forceinline__ void operator()(const f32x4 (&acc)[2][2][4][2], const Unit& u, int wr, int wc, int fr, int fq) const {
        const int row0 = u.pm * 256 + wr * 64 + fr, col0 = u.pn * 256 + wc * 32 + 8 * fq;
        const float* bp = bdn + (size_t)u.e * 1024 + col0;
        f32x4 bv[2][2];
#pragma unroll
        for (int bj = 0; bj < 2; ++bj) { bv[bj][0] = *(const f32x4*)(bp + bj * 128); bv[bj][1] = *(const f32x4*)(bp + bj * 128 + 4); }
#pragma unroll
        for (int ai = 0; ai < 2; ++ai)
#pragma unroll
            for (int m = 0; m < 4; ++m) { bf16* rowp = y + (size_t)(row0 + ai * 128 + m * 16) * 1024 + col0;
#pragma unroll
                for (int bj = 0; bj < 2; ++bj) { const f32x4 v0 = acc[ai][bj][m][0] + bv[bj][0], v1 = acc[ai][bj][m][1] + bv[bj][1];
                    u32x4 w; w.x = pg8::cvt_pk_bf16(v0[0], v0[1]); w.y = pg8::cvt_pk_bf16(v0[2], v0[3]); w.z = pg8::cvt_pk_bf16(v1[0], v1[1]); w.w = pg8::cvt_pk_bf16(v1[2], v1[3]);
                    *(u32x4*)(rowp + bj * 128) = w; } }
    }
};

__device__ __forceinline__ void p0_item(const float* W, int ldw, int K, int k0, int n0, bf16* WT, int drow0, const float* kscale, LAS float* scr, int lane) {
#pragma unroll 8
    for (int i = 0; i < 32; ++i) { const int kk = 2 * i + (lane >> 5); float w = W[(size_t)(k0 + kk) * ldw + n0 + (lane & 31)]; if (kscale) w *= kscale[k0 + kk]; scr[kk * 33 + (lane & 31)] = w; }
    LDS_WAIT(); asm volatile("" ::: "memory");
    const int c = lane & 7;
#pragma unroll
    for (int j = 0; j < 4; ++j) { const int n = (lane >> 3) + 8 * j; const LAS float* s = scr + (8 * c) * 33 + n;
        u32x4 o; o.x = pk2(s[0 * 33], s[1 * 33]); o.y = pk2(s[2 * 33], s[3 * 33]); o.z = pk2(s[4 * 33], s[5 * 33]); o.w = pk2(s[6 * 33], s[7 * 33]);
        *(u32x4*)(WT + (size_t)(drow0 + n) * K + k0 + 8 * c) = o; }
    LDS_WAIT(); asm volatile("" ::: "memory");
}
__device__ __forceinline__ int win_drow(int n) {
    if (n < X0) return (7 + (n >> 8)) * 256 + (n & 255);
    if (n < B0) return n - X0;
    if (n < C0) return 4 * 256 + (n - B0);
    if (n < DT0) return 6 * 256 + (n - C0);
    if (n < SC0) return 5 * 256 + (n - DT0);
    n -= SC0;
    if (n < 1024) return (11 + (n >> 8)) * 256 + (n & 255);
    if (n < 2048) { n -= 1024; return (15 + (n >> 7)) * 256 + (n & 127); }
    n -= 2048; return (15 + (n >> 7)) * 256 + 128 + (n & 127);
}
__device__ __forceinline__ void phase0(Frame& F) {
    float* mod = (float*)(F.ws + WS_MOD);
    for (int it = F.vcu; it < 192; it += F.G) {
        LAS float* sc = (LAS float*)F.lds;
        LAS float* red = (LAS float*)(F.lds + 69632);
        const int col = F.tid & 31, kg = F.tid >> 5, n0 = it * 32;
        float wl[64];
#pragma unroll
        for (int q = 0; q < 16; ++q)
#pragma unroll
            for (int j = 0; j < 4; ++j) wl[q * 4 + j] = F.w_mod[(size_t)(4 * (kg + 16 * q) + j) * 6144 + n0 + col];
        for (int i = F.tid; i < 17 * 1024; i += 512) { const int r = i >> 10, k = i & 1023; const float v = (r < 16) ? F.c[r * 1024 + k] : F.c_ctx[k]; sc[i] = fsilu(v); }
        __syncthreads();
        float acc[17];
#pragma unroll
        for (int r = 0; r < 17; ++r) acc[r] = 0.f;
#pragma unroll
        for (int q = 0; q < 16; ++q) {
            const int k = 4 * (kg + 16 * q);
#pragma unroll
            for (int r = 0; r < 17; ++r) { const f32x4 s4 = *(const LAS f32x4*)(sc + r * 1024 + k); acc[r] += s4[0] * wl[q * 4 + 0] + s4[1] * wl[q * 4 + 1] + s4[2] * wl[q * 4 + 2] + s4[3] * wl[q * 4 + 3]; }
        }
#pragma unroll
        for (int r = 0; r < 17; ++r) red[(kg * 17 + r) * 32 + col] = acc[r];
        __syncthreads();
        for (int o = F.tid; o < 17 * 32; o += 512) { const int r = o >> 5, cc = o & 31; float s = F.b_mod[n0 + cc];
            for (int g = 0; g < 16; ++g) s += red[(g * 17 + r) * 32 + cc];
            mod[(size_t)r * 6144 + n0 + cc] = s; }
        __syncthreads();
    }
    LAS float* scr = (LAS float*)(F.lds + F.wave * 8448);
    const int gw = F.vcu * NWAVES + F.wave, NGW = F.G * NWAVES;
    constexpr int I_IN = 16 * 177, I_OUT = 32 * 32;
    bf16* win = (bf16*)(F.ws + WS_WIN); bf16* wout = (bf16*)(F.ws + WS_WOUT);
    for (int it = gw; it < I_IN + I_OUT; it += NGW) {
        int r = it;
        if (r < I_IN) { const int kb = r / 177, nb = r % 177; p0_item(F.w_in, IN_W, 1024, kb * 64, nb * 32, win, win_drow(nb * 32), nullptr, scr, F.lane); continue; } r -= I_IN;
        { const int kb = r >> 5, nb = r & 31; p0_item(F.w_out, 1024, 2048, kb * 64, nb * 32, wout, nb * 32, kb < 16 ? F.ssd_norm_g : nullptr, scr, F.lane); }
    }
}

__device__ __forceinline__ void phase1(Frame& F) {
    const float* mod = (const float*)(F.ws + WS_MOD); bf16* hx = (bf16*)(F.ws + WS_HX);
    const int gw = F.vcu * NWAVES + F.wave, NGW = F.G * NWAVES;
    for (int row = gw; row < TT; row += NGW) {
        const float* src = row < TL ? F.x + (size_t)row * 1024 : F.ctx + (size_t)(row - TL) * 1024;
        const int mb = row < TL ? (row >> 11) : 16;
        const float* shift = mod + (size_t)mb * 6144, *scale = shift + 1024;
        f32x4 v[4]; float s = 0.f;
#pragma unroll
        for (int j = 0; j < 4; ++j) { v[j] = *(const f32x4*)(src + 4 * F.lane + 256 * j); s += (v[j][0] * v[j][0] + v[j][1] * v[j][1]) + (v[j][2] * v[j][2] + v[j][3] * v[j][3]); }
        const float rs = 1.0f / sqrtf(wave_sum(s) * (1.f / 1024.f) + NORM_EPS);
#pragma unroll
        for (int j = 0; j < 4; ++j) { const int c = 4 * F.lane + 256 * j;
            const f32x4 g = *(const f32x4*)(F.norm1_g + c), sh = *(const f32x4*)(shift + c), sc = *(const f32x4*)(scale + c);
            const f32x4 o = v[j] * rs * g * (sc + 1.0f) + sh;
            u32x2 w; w.x = pk2(o[0], o[1]); w.y = pk2(o[2], o[3]);
            *(u32x2*)(hx + (size_t)row * 1024 + c) = w; }
    }
}

__device__ __forceinline__ void unpack8(const u32x4 w, float (&f)[8]) { f[0] = bflo(w.x); f[1] = bfhi(w.x); f[2] = bflo(w.y); f[3] = bfhi(w.y); f[4] = bflo(w.z); f[5] = bfhi(w.z); f[6] = bflo(w.w); f[7] = bfhi(w.w); }
__device__ __forceinline__ void phase_conv(Frame& F) {
    const bf16* xraw = (const bf16*)(F.ws + WS_XRAW); bf16* xbc = (bf16*)(F.ws + WS_XBC);
    if (F.tid >= 384) return;
    const int cp = F.tid % 192, rs = F.tid / 192, c0 = cp * 8;
    float w0[8], w1[8], w2[8], bb[8];
#pragma unroll
    for (int e = 0; e < 8; ++e) { w0[e] = F.conv_w[c0 + e]; w1[e] = F.conv_w[XBCW + c0 + e]; w2[e] = F.conv_w[2 * XBCW + c0 + e]; bb[e] = F.conv_b[c0 + e]; }
    for (int it = F.vcu; it < TT / 32; it += F.G) {
        const int r0 = it * 32 + rs * 16;
        const bool isctx = r0 >= TL;
        if (isctx && c0 >= 1280) continue;
        const int L = isctx ? CTXL : SEQ, t0 = isctx ? ((r0 - TL) & (CTXL - 1)) : (r0 & (SEQ - 1));
        const u32x4 zero = (u32x4){0u, 0u, 0u, 0u};
        u32x4 prev = (t0 > 0) ? *(const u32x4*)(xraw + (size_t)(r0 - 1) * XBCW + c0) : zero;
        u32x4 cur = *(const u32x4*)(xraw + (size_t)r0 * XBCW + c0);
        for (int hf = 0; hf < 2; ++hf) {
            float o[8][8];
#pragma unroll
            for (int i = 0; i < 8; ++i) {
                const int ri = hf * 8 + i;
                const u32x4 nxt = (t0 + ri + 1 < L) ? *(const u32x4*)(xraw + (size_t)(r0 + ri + 1) * XBCW + c0) : zero;
                float a[8], b[8], c[8]; unpack8(prev, a); unpack8(cur, b); unpack8(nxt, c);
#pragma unroll
                for (int e = 0; e < 8; ++e) o[i][e] = fsilu(w0[e] * a[e] + w1[e] * b[e] + w2[e] * c[e] + bb[e]);
                u32x4 w; w.x = pk2(o[i][0], o[i][1]); w.y = pk2(o[i][2], o[i][3]); w.z = pk2(o[i][4], o[i][5]); w.w = pk2(o[i][6], o[i][7]);
                *(u32x4*)(xbc + (size_t)(r0 + ri) * XBCW + c0) = w;
                prev = cur; cur = nxt;
            }
        }
    }
}

namespace ssd {
constexpr int LDC = 136, LDJ = 72;
constexpr int S_CC = 0, S_BC = 17408, S_X = 34816, S_XW = 44032, S_G = 53248, S_HB = 62464, S_CS = 79872, S_DTV = 80384, S_W = 80896, S_TOT = 81408;
__device__ __forceinline__ bf16x8 ldfrag(const LAS unsigned char* base, int row, int ld, int k) { return *(const LAS bf16x8*)(base + (size_t)(row * ld + k) * 2); }
typedef short v4i16_t __attribute__((ext_vector_type(4)));
__device__ __forceinline__ bf16x8 ldfrag_tr(const LAS unsigned char* base, int ld, int k0, int c0, int lane) {
    const int g = lane >> 4, q = (lane & 15) >> 2, p = lane & 3;
    const LAS unsigned char* a = base + (size_t)((k0 + 8 * g + q) * ld + c0 + 4 * p) * 2;
    const v4i16_t lo = __builtin_amdgcn_ds_read_tr16_b64_v4i16((LAS v4i16_t*)a);
    const v4i16_t hi = __builtin_amdgcn_ds_read_tr16_b64_v4i16((LAS v4i16_t*)(a + (size_t)4 * ld * 2));
    return __builtin_shufflevector(lo, hi, 0, 1, 2, 3, 4, 5, 6, 7);
}
}
__device__ __forceinline__ int ssd_rowbase(int b, int dir, int s) {
    return s < 4 ? TL + b * CTXL + (dir ? (3 - s) : s) * 64 : b * SEQ + (dir ? (35 - s) : (s - 4)) * 64;
}
#define SSD_LOADS(sidx) do { const int rb_ = ssd_rowbase(b, dir, (sidx)); const bool ctx_ = (sidx) < 4; \
    _Pragma("unroll") for (int q2 = 0; q2 < 2; ++q2) { const int q = tid + 512 * q2, row = q >> 4, n8 = q & 15; \
        const bf16* p = xbc + (size_t)(rb_ + row) * XBCW + 1024 + g * 128 + n8 * 8; \
        bR[q2] = *(const u32x4*)p; cR[q2] = ctx_ ? (u32x4){0u, 0u, 0u, 0u} : *(const u32x4*)(p + 256); } \
    xR = *(const u32x4*)(xbc + (size_t)(rb_ + (tid >> 3)) * XBCW + h * 64 + (tid & 7) * 8); } while (0)
#define SSD_SCAN(dtj_, par_) do { const int j = dir ? (63 - lane) : lane; float v = (dtj_) * a; \
    _Pragma("unroll") for (int o = 1; o < 64; o <<= 1) { const float t = __shfl_up(v, o); v += (lane >= o) ? t : 0.f; } \
    const float total = __shfl(v, 63); \
    cs[(par_) * 64 + j] = v; dtv[(par_) * 64 + j] = (dtj_); wv[(par_) * 64 + j] = __expf(total - v) * (dtj_); if (lane == 0) tot[(par_)] = total; } while (0)
constexpr int WC_TILES_GU = 32 * 32 * 64, WC_TILES = WC_TILES_GU + 32 * 32 * 32;
__device__ __forceinline__ void wc_tile_base(const Frame& F, int T, const float*& src, int& ldw, bf16*& dst) {
    if (T < WC_TILES_GU) { const int e = T >> 11, q = T & 2047, kb = q >> 6, nb = q & 63, n0 = nb * 32;
        const int drow0 = n0 < 1024 ? (n0 >> 7) * 256 + (n0 & 127) : ((n0 - 1024) >> 7) * 256 + 128 + ((n0 - 1024) & 127);
        ldw = 2048; src = F.w_gu + (size_t)e * 1024 * 2048 + (size_t)(kb * 32) * 2048 + n0;
        dst = (bf16*)(F.ws + WS_WGU) + (size_t)e * 2048 * 1024 + (size_t)drow0 * 1024 + kb * 32; }
    else { const int T2 = T - WC_TILES_GU, e = T2 >> 10, q = T2 & 1023, kb = q >> 5, nb = q & 31, n0 = nb * 32;
        ldw = 1024; src = F.w_dn + (size_t)e * 1024 * 1024 + (size_t)(kb * 32) * 1024 + n0;
        dst = (bf16*)(F.ws + WS_WDN) + (size_t)e * 1024 * 1024 + (size_t)n0 * 1024 + kb * 32; }
}
#define WC_LOAD(T_) do { const float* src_; int ldw_; bf16* dst_; wc_tile_base(F, (T_), src_, ldw_, dst_); \
    const int lo_ = (lane >> 5) * 16 * ldw_ + (lane & 31); \
    _Pragma("unroll") for (int e = 0; e < 16; ++e) wR[e] = (src_ + (size_t)e * ldw_)[lo_]; } while (0)
#define WC_STORE(T_) do { const float* src_; int ldw_; bf16* dst_; wc_tile_base(F, (T_), src_, ldw_, dst_); \
    _Pragma("unroll") for (int e = 0; e < 16; ++e) asm volatile("" : "+v"(wR[e])); \
    u32x4 o0_, o1_; o0_.x = pk2(wR[0], wR[1]); o0_.y = pk2(wR[2], wR[3]); o0_.z = pk2(wR[4], wR[5]); o0_.w = pk2(wR[6], wR[7]); \
    o1_.x = pk2(wR[8], wR[9]); o1_.y = pk2(wR[10], wR[11]); o1_.z = pk2(wR[12], wR[13]); o1_.w = pk2(wR[14], wR[15]); \
    bf16* dl_ = dst_ + ((lane & 31) * 1024 + (lane >> 5) * 16); \
    *(u32x4*)dl_ = o0_; *(u32x4*)(dl_ + 8) = o1_; } while (0)
__device__ __forceinline__ void phase_ssd(Frame& F) {
    using namespace ssd;
    const bf16* xbc = (const bf16*)(F.ws + WS_XBC); const float* dtb = (const float*)(F.ws + WS_DT);
    LAS unsigned char* L = F.lds;
    LAS float* cs = (LAS float*)(L + S_CS); LAS float* dtv = (LAS float*)(L + S_DTV); LAS float* wv = (LAS float*)(L + S_W); LAS float* tot = (LAS float*)(L + S_TOT);
    const int tid = F.tid, lane = F.lane, w = F.wave, fr = lane & 15, fq = lane >> 4;
    float wR[16]; int cstep = 0;
    int Tpend = __builtin_amdgcn_readfirstlane((cstep * F.G + F.vcu) * 8 + w);
    if (Tpend < WC_TILES) { WC_LOAD(Tpend); }
    for (int it = F.vcu; it < 512; it += F.G) {
        const int b = it >> 5, h = (it >> 1) & 15, dir = it & 1, g = h >> 3;
        const float a = -__expf(F.a_log[dir * 16 + h]);
        const int dtcol = dir * 16 + h;
        bf16* ydir = (bf16*)(F.ws + (dir ? WS_YB : WS_YF));
        f32x4 Hacc[4];
#pragma unroll
        for (int tp = 0; tp < 4; ++tp) Hacc[tp] = (f32x4){0.f, 0.f, 0.f, 0.f};
        u32x4 cR[2], bR[2], xR;
        if (w == 0) { const int j = dir ? (63 - lane) : lane; const float d0 = dtb[(size_t)(ssd_rowbase(b, dir, 0) + j) * 32 + dtcol]; SSD_SCAN(d0, 0); }
        SSD_LOADS(0);
        __syncthreads();
        for (int s = 0; s < 36; ++s) {
            const bool isctx = s < 4; const int par = s & 1;
            const int rowbase = ssd_rowbase(b, dir, s);
#pragma unroll
            for (int q2 = 0; q2 < 2; ++q2) asm volatile("" : "+v"(bR[q2]), "+v"(cR[q2]));
            asm volatile("" : "+v"(xR));
#pragma unroll
            for (int q2 = 0; q2 < 2; ++q2) { const int q = tid + 512 * q2, row = q >> 4, n8 = q & 15;
                *(LAS u32x4*)(L + S_BC + (size_t)(row * LDC + n8 * 8) * 2) = bR[q2];
                *(LAS u32x4*)(L + S_CC + (size_t)(row * LDC + n8 * 8) * 2) = cR[q2]; }
            { const int row = tid >> 3, p8 = tid & 7;
                *(LAS u32x4*)(L + S_X + (size_t)(row * LDJ + p8 * 8) * 2) = xR;
                float f[8]; unpack8(xR, f); const float wj = wv[par * 64 + row];
                u32x4 o; o.x = pk2(f[0] * wj, f[1] * wj); o.y = pk2(f[2] * wj, f[3] * wj); o.z = pk2(f[4] * wj, f[5] * wj); o.w = pk2(f[6] * wj, f[7] * wj);
                *(LAS u32x4*)(L + S_XW + (size_t)(row * LDJ + p8 * 8) * 2) = o; }
            __syncthreads();
            if (Tpend < WC_TILES) { WC_STORE(Tpend); }
            float dnext = 0.f;
            if (s + 1 < 36) {
                if (w == 0) { const int j = dir ? (63 - lane) : lane; dnext = dtb[(size_t)(ssd_rowbase(b, dir, s + 1) + j) * 32 + dtcol]; }
                SSD_LOADS(s + 1);
            }
            ++cstep; Tpend = __builtin_amdgcn_readfirstlane((cstep * F.G + F.vcu) * 8 + w);
            if (Tpend < WC_TILES) { WC_LOAD(Tpend); }
            if (!isctx) {
                {
                    const int ti = w & 3, tj0 = w >> 2, tj1 = tj0 + 2;
                    const bool need0 = dir ? (tj0 >= ti) : (tj0 <= ti), need1 = dir ? (tj1 >= ti) : (tj1 <= ti);
                    bf16x8 cf[4], bf0[4], bf1[4];
#pragma unroll
                    for (int k = 0; k < 4; ++k) cf[k] = ldfrag(L + S_CC, 16 * ti + fr, LDC, 32 * k + 8 * fq);
                    if (need0) {
#pragma unroll
                        for (int k = 0; k < 4; ++k) bf0[k] = ldfrag(L + S_BC, 16 * tj0 + fr, LDC, 32 * k + 8 * fq); }
                    if (need1) {
#pragma unroll
                        for (int k = 0; k < 4; ++k) bf1[k] = ldfrag(L + S_BC, 16 * tj1 + fr, LDC, 32 * k + 8 * fq); }
                    const int i = 16 * ti + fr; const float csi = cs[par * 64 + i];
                    const f32x4 csj0 = *(const LAS f32x4*)(cs + par * 64 + 16 * tj0 + 4 * fq), csj1 = *(const LAS f32x4*)(cs + par * 64 + 16 * tj1 + 4 * fq);
                    const f32x4 dtj0 = *(const LAS f32x4*)(dtv + par * 64 + 16 * tj0 + 4 * fq), dtj1 = *(const LAS f32x4*)(dtv + par * 64 + 16 * tj1 + 4 * fq);
                    f32x4 a0 = (f32x4){0.f, 0.f, 0.f, 0.f}, a1 = (f32x4){0.f, 0.f, 0.f, 0.f};
                    if (need0) {
#pragma unroll
                        for (int k = 0; k < 4; ++k) a0 = __builtin_amdgcn_mfma_f32_16x16x32_bf16(bf0[k], cf[k], a0, 0, 0, 0); }
                    if (need1) {
#pragma unroll
                        for (int k = 0; k < 4; ++k) a1 = __builtin_amdgcn_mfma_f32_16x16x32_bf16(bf1[k], cf[k], a1, 0, 0, 0); }
                    float g0[4], g1[4];
#pragma unroll
                    for (int r = 0; r < 4; ++r) {
                        const int j0 = 16 * tj0 + 4 * fq + r, j1 = 16 * tj1 + 4 * fq + r;
                        const bool ok0 = dir ? (j0 >= i) : (j0 <= i), ok1 = dir ? (j1 >= i) : (j1 <= i);
                        g0[r] = ok0 ? a0[r] * __expf(csi - csj0[r]) * dtj0[r] : 0.f;
                        g1[r] = ok1 ? a1[r] * __expf(csi - csj1[r]) * dtj1[r] : 0.f; }
                    u32x2 o0, o1; o0.x = pk2(g0[0], g0[1]); o0.y = pk2(g0[2], g0[3]); o1.x = pk2(g1[0], g1[1]); o1.y = pk2(g1[2], g1[3]);
                    *(LAS u32x2*)(L + S_G + (size_t)(i * LDJ + 16 * tj0 + 4 * fq) * 2) = o0;
                    *(LAS u32x2*)(L + S_G + (size_t)(i * LDJ + 16 * tj1 + 4 * fq) * 2) = o1;
                }
                __syncthreads();
            }
            if (w == 0 && s + 1 < 36) { SSD_SCAN(dnext, par ^ 1); }
            bf16x8 xwf[4][2], af[2];
#pragma unroll
            for (int k = 0; k < 2; ++k) { af[k] = ldfrag_tr(L + S_BC, LDC, 32 * k, 16 * w, lane);
#pragma unroll
                for (int tp = 0; tp < 4; ++tp) xwf[tp][k] = ldfrag_tr(L + S_XW, LDJ, 32 * k, 16 * tp, lane); }
            const float dec = __expf(tot[par]);
            if (!isctx) {
                const int ti = w & 3, tp0 = w >> 2, tp1 = tp0 + 2;
                bf16x8 gf[2], cf[4], h0[4], h1[4];
#pragma unroll
                for (int k = 0; k < 2; ++k) gf[k] = ldfrag(L + S_G, 16 * ti + fr, LDJ, 32 * k + 8 * fq);
#pragma unroll
                for (int k = 0; k < 4; ++k) { cf[k] = ldfrag(L + S_CC, 16 * ti + fr, LDC, 32 * k + 8 * fq); h0[k] = ldfrag(L + S_HB, 16 * tp0 + fr, LDC, 32 * k + 8 * fq); h1[k] = ldfrag(L + S_HB, 16 * tp1 + fr, LDC, 32 * k + 8 * fq); }
                const int i = 16 * ti + fr; const float ei = __expf(cs[par * 64 + i]);
                f32x4 yd0 = (f32x4){0.f, 0.f, 0.f, 0.f}, yd1 = yd0, yo0 = yd0, yo1 = yd0;
#pragma unroll
                for (int k = 0; k < 2; ++k) { const bf16x8 xa = ldfrag_tr(L + S_X, LDJ, 32 * k, 16 * tp0, lane), xb = ldfrag_tr(L + S_X, LDJ, 32 * k, 16 * tp1, lane);
                    yd0 = __builtin_amdgcn_mfma_f32_16x16x32_bf16(xa, gf[k], yd0, 0, 0, 0); yd1 = __builtin_amdgcn_mfma_f32_16x16x32_bf16(xb, gf[k], yd1, 0, 0, 0); }
#pragma unroll
                for (int k = 0; k < 4; ++k) { yo0 = __builtin_amdgcn_mfma_f32_16x16x32_bf16(h0[k], cf[k], yo0, 0, 0, 0); yo1 = __builtin_amdgcn_mfma_f32_16x16x32_bf16(h1[k], cf[k], yo1, 0, 0, 0); }
                const f32x4 y0 = yd0 + yo0 * ei, y1 = yd1 + yo1 * ei;
                u32x2 o0, o1; o0.x = pk2(y0[0], y0[1]); o0.y = pk2(y0[2], y0[3]); o1.x = pk2(y1[0], y1[1]); o1.y = pk2(y1[2], y1[3]);
                bf16* yp = ydir + (size_t)(rowbase + i) * 1024 + h * 64 + 4 * fq;
                *(u32x2*)(yp + 16 * tp0) = o0; *(u32x2*)(yp + 16 * tp1) = o1;
            }
#pragma unroll
            for (int tp = 0; tp < 4; ++tp) { Hacc[tp] = Hacc[tp] * dec;
#pragma unroll
                for (int k = 0; k < 2; ++k) Hacc[tp] = __builtin_amdgcn_mfma_f32_16x16x32_bf16(af[k], xwf[tp][k], Hacc[tp], 0, 0, 0); }
            __syncthreads();
#pragma unroll
            for (int tp = 0; tp < 4; ++tp) { u32x2 o; o.x = pk2(Hacc[tp][0], Hacc[tp][1]); o.y = pk2(Hacc[tp][2], Hacc[tp][3]);
                *(LAS u32x2*)(L + S_HB + (size_t)((16 * tp + fr) * LDC + 16 * w + 4 * fq) * 2) = o; }
        }
        __syncthreads();
    }
    while (Tpend < WC_TILES) { WC_STORE(Tpend); ++cstep; Tpend = __builtin_amdgcn_readfirstlane((cstep * F.G + F.vcu) * 8 + w); if (Tpend < WC_TILES) { WC_LOAD(Tpend); } }
}

__device__ __forceinline__ void phase_combine(Frame& F) {
    const bf16* xbc = (const bf16*)(F.ws + WS_XBC); const bf16* yf = (const bf16*)(F.ws + WS_YF); const bf16* yb = (const bf16*)(F.ws + WS_YB);
    const bf16* sz = (const bf16*)(F.ws + WS_SZ); const bf16* scb = (const bf16*)(F.ws + WS_SCB); const bf16* cu = (const bf16*)(F.ws + WS_CU);
    bf16* a2 = (bf16*)(F.ws + WS_A2);
    const int g = F.wave & 1, sub = F.wave >> 1, c = g * 512 + F.lane * 8;
    const float dsk = F.ssd_d[c >> 6];
    const int c2 = (F.tid & 127) * 8, sub2 = F.tid >> 7;
    float k0[8], k1[8], k2[8];
#pragma unroll
    for (int e = 0; e < 8; ++e) { k0[e] = F.sc_conv_w[c2 + e]; k1[e] = F.sc_conv_w[1024 + c2 + e]; k2[e] = F.sc_conv_w[2048 + c2 + e]; }
    for (int it = F.vcu; it < TL / 64; it += F.G) {
        const int tb = it * 64;
        for (int i = 0; i < 16; ++i) {
            const int t = tb + sub * 16 + i;
            float a[8], b2[8], x[8], z[8], v[8]; float ss = 0.f;
            unpack8(*(const u32x4*)(yf + (size_t)t * 1024 + c), a); unpack8(*(const u32x4*)(yb + (size_t)t * 1024 + c), b2);
            unpack8(*(const u32x4*)(xbc + (size_t)t * XBCW + c), x); unpack8(*(const u32x4*)(sz + (size_t)t * 1024 + c), z);
#pragma unroll
            for (int e = 0; e < 8; ++e) { v[e] = (a[e] + b2[e] + dsk * x[e]) * z[e]; ss += v[e] * v[e]; }
            const float rs = 1.0f / sqrtf(wave_sum(ss) * (1.f / 512.f) + NORM_EPS);
            u32x4 o; o.x = pk2(v[0] * rs, v[1] * rs); o.y = pk2(v[2] * rs, v[3] * rs); o.z = pk2(v[4] * rs, v[5] * rs); o.w = pk2(v[6] * rs, v[7] * rs);
            *(u32x4*)(a2 + (size_t)t * 2048 + c) = o;
        }
        for (int i = 0; i < 16; ++i) {
            const int t = tb + sub2 * 16 + i, tt = t & (SEQ - 1);
            const u32x4 zero = (u32x4){0u, 0u, 0u, 0u};
            float p[8], q[8], n[8], sb[8], o8[8];
            unpack8(tt >= 64 ? *(const u32x4*)(cu + (size_t)(t - 64) * 1024 + c2) : zero, p);
            unpack8(*(const u32x4*)(cu + (size_t)t * 1024 + c2), q);
            unpack8(tt + 64 < SEQ ? *(const u32x4*)(cu + (size_t)(t + 64) * 1024 + c2) : zero, n);
            unpack8(*(const u32x4*)(scb + (size_t)t * 1024 + c2), sb);
#pragma unroll
            for (int e = 0; e < 8; ++e) o8[e] = sb[e] * (k0[e] * p[e] + k1[e] * q[e] + k2[e] * n[e]);
            u32x4 o; o.x = pk2(o8[0], o8[1]); o.y = pk2(o8[2], o8[3]); o.z = pk2(o8[4], o8[5]); o.w = pk2(o8[6], o8[7]);
            *(u32x4*)(a2 + (size_t)t * 2048 + 1024 + c2) = o;
        }
    }
}

__device__ __forceinline__ void phase_router(Frame& F) {
    const float* mod = (const float*)(F.ws + WS_MOD); bf16* h2 = (bf16*)(F.ws + WS_HX);
    int* rowtok = (int*)(F.ws + WS_ROWTOK); int* tokes = (int*)(F.ws + WS_TOKES); float* tokg = (float*)(F.ws + WS_TOKG);
    LAS unsigned char* L = F.lds;
    LAS f32x4* WR = (LAS f32x4*)L;
    LAS float* mulv = (LAS float*)(L + 131072);
    LAS float* shv = (LAS float*)(L + 131072 + 4096);
    LAS int* tinfo = (LAS int*)(L + 131072 + 8192);
    LAS int* lcnt = (LAS int*)(L + 131072 + 8192 + 6144);
    LAS int* lbase = lcnt + 32;
    for (int i = F.tid; i < 8192; i += 512) { const int k = i >> 3, e4 = i & 7; WR[e4 * 1024 + k] = *(const f32x4*)(F.w_router + (size_t)k * 32 + e4 * 4); }
    if (F.tid < 32) lcnt[F.tid] = 0;
    const int lane = F.lane;
    const int myexp = ((lane >> 5) & 1) * 16 + ((lane >> 4) & 1) * 8 + ((lane >> 3) & 1) * 4 + ((lane >> 2) & 1) * 2 + ((lane >> 1) & 1);
    const float mybias = F.b_router[myexp];
    for (int blk = F.vcu; blk < TL / 128; blk += F.G) {
        const int bb = (blk * 128) >> 11;
        __syncthreads();
        for (int k = F.tid; k < 1024; k += 512) { mulv[k] = F.norm2_g[k] * (1.0f + mod[(size_t)bb * 6144 + 4 * 1024 + k]); shv[k] = mod[(size_t)bb * 6144 + 3 * 1024 + k]; }
        __syncthreads();
        for (int i = 0; i < 16; ++i) {
            const int tl = F.wave * 16 + i, t = blk * 128 + tl;
            const float* xr = F.out + (size_t)t * 1024;
            float hv[16]; float ss = 0.f;
#pragma unroll
            for (int jj = 0; jj < 16; ++jj) { hv[jj] = xr[lane + 64 * jj]; ss += hv[jj] * hv[jj]; }
            const float rs = 1.0f / sqrtf(wave_sum(ss) * (1.f / 1024.f) + NORM_EPS);
            float acc[32];
#pragma unroll
            for (int e = 0; e < 32; ++e) acc[e] = 0.f;
#pragma unroll
            for (int jj = 0; jj < 16; ++jj) { const int k = lane + 64 * jj;
                const float hval = hv[jj] * rs * mulv[k] + shv[k];
                h2[(size_t)t * 1024 + k] = (bf16)f2bf(hval);
#pragma unroll
                for (int e4 = 0; e4 < 8; ++e4) { const f32x4 wq = WR[e4 * 1024 + k];
                    acc[4 * e4 + 0] += hval * wq[0]; acc[4 * e4 + 1] += hval * wq[1]; acc[4 * e4 + 2] += hval * wq[2]; acc[4 * e4 + 3] += hval * wq[3]; } }
            float r16[16], r8[8], r4[4], r2[2], r1;
            { const bool hi = (lane & 32) != 0;
#pragma unroll
              for (int e = 0; e < 16; ++e) { const float send = hi ? acc[e] : acc[e + 16]; const float recv = __shfl_xor(send, 32); r16[e] = (hi ? acc[e + 16] : acc[e]) + recv; } }
            { const bool hi = (lane & 16) != 0;
#pragma unroll
              for (int e = 0; e < 8; ++e) { const float send = hi ? r16[e] : r16[e + 8]; const float recv = __shfl_xor(send, 16); r8[e] = (hi ? r16[e + 8] : r16[e]) + recv; } }
            { const bool hi = (lane & 8) != 0;
#pragma unroll
              for (int e = 0; e < 4; ++e) { const float send = hi ? r8[e] : r8[e + 4]; const float recv = __shfl_xor(send, 8); r4[e] = (hi ? r8[e + 4] : r8[e]) + recv; } }
            { const bool hi = (lane & 4) != 0;
#pragma unroll
              for (int e = 0; e < 2; ++e) { const float send = hi ? r4[e] : r4[e + 2]; const float recv = __shfl_xor(send, 4); r2[e] = (hi ? r4[e + 2] : r4[e]) + recv; } }
            { const bool hi = (lane & 2) != 0; const float send = hi ? r2[0] : r2[1]; const float recv = __shfl_xor(send, 2); r1 = (hi ? r2[1] : r2[0]) + recv; }
            r1 += __shfl_xor(r1, 1);
            float val = r1 + mybias;
            int sel[4]; float sv[4];
#pragma unroll
            for (int kk = 0; kk < 4; ++kk) {
                float bv = val; int bi = myexp;
#pragma unroll
                for (int o = 1; o < 64; o <<= 1) { const float ov = __shfl_xor(bv, o); const int oi = __shfl_xor(bi, o); if (ov > bv || (ov == bv && oi < bi)) { bv = ov; bi = oi; } }
                sel[kk] = bi; sv[kk] = bv; if (myexp == bi) val = -3.0e38f;
            }
            const float p1 = __expf(sv[1] - sv[0]), p2 = __expf(sv[2] - sv[0]), p3 = __expf(sv[3] - sv[0]);
            const float inv = 1.0f / (1.0f + p1 + p2 + p3);
            const float gt[4] = {inv, p1 * inv, p2 * inv, p3 * inv};
            if (lane < 4) {
                const int e = lane == 0 ? sel[0] : lane == 1 ? sel[1] : lane == 2 ? sel[2] : sel[3];
                const float gg = lane == 0 ? gt[0] : lane == 1 ? gt[1] : lane == 2 ? gt[2] : gt[3];
                const int ls = atomicAdd((int*)&lcnt[e], 1);
                tinfo[(tl * 4 + lane) * 3 + 0] = e; tinfo[(tl * 4 + lane) * 3 + 1] = ls; tinfo[(tl * 4 + lane) * 3 + 2] = __float_as_int(gg);
            }
        }
        __syncthreads();
        if (F.tid < 32) { const int n = lcnt[F.tid]; lbase[F.tid] = (int)__hip_atomic_fetch_add((unsigned*)(F.ctl + CW_ECNT + F.tid), (unsigned)n, RLX_AGENT); }
        __syncthreads();
        { const int tl = F.tid >> 2, kk = F.tid & 3, t = blk * 128 + tl;
          const int e = tinfo[(tl * 4 + kk) * 3 + 0], ls = tinfo[(tl * 4 + kk) * 3 + 1]; const float gg = __int_as_float(tinfo[(tl * 4 + kk) * 3 + 2]);
          const int slot = lbase[e] + ls;
          rowtok[(size_t)e * CAP + slot] = t; tokes[t * 4 + kk] = e * CAP + slot; tokg[t * 4 + kk] = gg; }
        __syncthreads();
        if (F.tid < 32) lcnt[F.tid] = 0;
    }
    __syncthreads();
}

__device__ __forceinline__ void build_mt_table(Frame& F) {
    __syncthreads();
    if (F.tid == 0) { int s = 0;
        for (int e = 0; e < 32; ++e) { const int c = (int)__hip_atomic_load(F.ctl + CW_ECNT + e, RLX_AGENT); F.cl[LW_CNT + e] = (unsigned)c; F.cl[LW_MTS + e] = (unsigned)s; s += (c + 255) >> 8; }
        F.cl[LW_MTS + 32] = (unsigned)s; }
    __syncthreads();
}

__device__ __forceinline__ void phase_final(Frame& F) {
    const float* mod = (const float*)(F.ws + WS_MOD); const bf16* yrows = (const bf16*)(F.ws + WS_YROWS);
    const int* tokes = (const int*)(F.ws + WS_TOKES); const float* tokg = (const float*)(F.ws + WS_TOKG);
    const int gw = F.vcu * NWAVES + F.wave, NGW = F.G * NWAVES, lane = F.lane;
    for (int t = gw; t < TL; t += NGW) {
        const int b = t >> 11;
        float m[16];
#pragma unroll
        for (int e = 0; e < 16; ++e) m[e] = 0.f;
#pragma unroll
        for (int kk = 0; kk < 4; ++kk) {
            const int es = tokes[t * 4 + kk]; const float gg = tokg[t * 4 + kk];
            const int e = es >> 15, slot = es & (CAP - 1);
            const size_t pos = (size_t)F.cl[LW_MTS + e] * 256 + slot;
            float y0[8], y1[8];
            unpack8(*(const u32x4*)(yrows + pos * 1024 + lane * 8), y0); unpack8(*(const u32x4*)(yrows + pos * 1024 + 512 + lane * 8), y1);
#pragma unroll
            for (int q = 0; q < 8; ++q) { m[q] += gg * y0[q]; m[8 + q] += gg * y1[q]; }
        }
        float x2[16]; float ss = 0.f;
#pragma unroll
        for (int hf = 0; hf < 2; ++hf)
#pragma unroll
            for (int q4 = 0; q4 < 2; ++q4) { const int c = hf * 512 + lane * 8 + q4 * 4;
                const f32x4 xv = *(const f32x4*)(F.out + (size_t)t * 1024 + c), gv = *(const f32x4*)(mod + (size_t)b * 6144 + 5 * 1024 + c);
#pragma unroll
                for (int j = 0; j < 4; ++j) { const float v = xv[j] + gv[j] * m[hf * 8 + q4 * 4 + j]; x2[hf * 8 + q4 * 4 + j] = v; ss += v * v; } }
        const float rs = 1.0f / sqrtf(wave_sum(ss) * (1.f / 1024.f) + NORM_EPS);
#pragma unroll
        for (int hf = 0; hf < 2; ++hf)
#pragma unroll
            for (int q4 = 0; q4 < 2; ++q4) { const int c = hf * 512 + lane * 8 + q4 * 4;
                const f32x4 fg = *(const f32x4*)(F.final_g + c); f32x4 o;
#pragma unroll
                for (int j = 0; j < 4; ++j) o[j] = x2[hf * 8 + q4 * 4 + j] * rs * fg[j];
                *(f32x4*)(F.out + (size_t)t * 1024 + c) = o; }
    }
}

constexpr int NPHASE = 11;
__global__ void __launch_bounds__(NWAVES * 64, 2) mk_fwd(Args args) {
    extern __shared__ __attribute__((aligned(16))) unsigned char lds_raw[];
    Frame F;
    F.lds = (LAS unsigned char*)lds_raw;
    F.cl = (volatile LAS unsigned*)(F.lds + CTLDS_OFF);
    F.tid = threadIdx.x; F.lane = F.tid & 63; F.wave = __builtin_amdgcn_readfirstlane(F.tid >> 6);
    F.G = gridDim.x; { const int bx = blockIdx.x; F.vcu = (F.G % 8 == 0) ? (bx % 8) * (F.G / 8) + bx / 8 : bx; }
    F.ws = args.ws; F.ctl = (gu32*)(args.ws + WS_CTL); F.out = args.out;
    F.x = args.in[0]; F.c = args.in[1]; F.ctx = args.in[2]; F.c_ctx = args.in[3]; F.w_mod = args.in[4]; F.b_mod = args.in[5]; F.norm1_g = args.in[6]; F.w_in = args.in[7];
    F.conv_w = args.in[8]; F.conv_b = args.in[9]; F.dt_bias = args.in[10]; F.a_log = args.in[11]; F.ssd_d = args.in[12]; F.ssd_norm_g = args.in[13]; F.sc_conv_w = args.in[14];
    F.w_out = args.in[15]; F.norm2_g = args.in[16]; F.w_router = args.in[17]; F.b_router = args.in[18]; F.w_gu = args.in[19]; F.b_gu = args.in[20]; F.w_dn = args.in[21]; F.b_dn = args.in[22]; F.final_g = args.in[23];
    for (int u = F.tid; u < (LDS_BYTES - CTLDS_OFF) / 4; u += NWAVES * 64) ((LAS unsigned*)(F.lds + CTLDS_OFF))[u] = 0u;
    __syncthreads();
    const int lo = args.ph_lo, hi = args.ph_hi;
    XcdBarrier bar; bar.bar = (unsigned*)(F.ctl + CW_BAR); bar.x = 0; bar.st = nullptr;
    if (hi - lo > 1) bar = xcd_barrier_post((unsigned*)(F.ctl + CW_BAR), F.cl + LW_BARST);
#define IN(k) (lo <= (k) && (k) < hi)
#define SEAM(k) do { if (IN(k) && IN((k) + 1)) xcd_barrier(bar); } while (0)

#define RUNPH(k, body) do { if (IN(k)) { body; if ((PROBE_DOUBLE >> (k)) & 1) { xcd_barrier(bar); body; } SEAM(k); } } while (0)
    RUNPH(0, phase0(F));
    RUNPH(1, phase1(F));
#define BODY2 { SchedIn S{F.G, F.vcu, 1024, (const bf16*)(F.ws + WS_WIN)}; \
        EpiIn E{(bf16*)(F.ws + WS_XRAW), (float*)(F.ws + WS_DT), (bf16*)(F.ws + WS_SZ), (bf16*)(F.ws + WS_SCB), (bf16*)(F.ws + WS_CU), F.dt_bias}; \
        pg8::gemm_phase<EpiIn, SchedIn>(F.lds, (const bf16*)(F.ws + WS_HX), 1024, S, E); }
    RUNPH(2, BODY2);
    RUNPH(3, phase_conv(F));
    RUNPH(4, phase_ssd(F));
    RUNPH(5, phase_combine(F));
#define BODY6 { SchedPlain S{F.G, F.vcu, 2048, 4, 512, (const bf16*)(F.ws + WS_WOUT)}; \
        EpiOut E{F.x, F.out, (const float*)(F.ws + WS_MOD)}; \
        pg8::gemm_phase<EpiOut, SchedPlain>(F.lds, (const bf16*)(F.ws + WS_A2), 2048, S, E); }
    RUNPH(6, BODY6);
    if (IN(7)) { phase_router(F); SEAM(7); }
#define BODY8 { build_mt_table(F); \
        SchedMoe<true> S{F.G, F.vcu, 1024, 8, (const bf16*)(F.ws + WS_WGU), F.cl, (const int*)(F.ws + WS_ROWTOK)}; \
        EpiGU E{(bf16*)(F.ws + WS_ACT), F.b_gu}; \
        pg8::gemm_phase<EpiGU, SchedMoe<true>>(F.lds, (const bf16*)(F.ws + WS_HX), 1024, S, E); }
    RUNPH(8, BODY8);
#define BODY9 { build_mt_table(F); \
        SchedMoe<false> S{F.G, F.vcu, 1024, 4, (const bf16*)(F.ws + WS_WDN), F.cl, nullptr}; \
        EpiDown E{(bf16*)(F.ws + WS_YROWS), F.b_dn}; \
        pg8::gemm_phase<EpiDown, SchedMoe<false>>(F.lds, (const bf16*)(F.ws + WS_ACT), 1024, S, E); }
    RUNPH(9, BODY9);
    if (IN(10)) { build_mt_table(F); phase_final(F); }
#undef IN
#undef SEAM
}

extern "C" void kernel_launch(void* const* d_in, const int* in_sizes, int n_in, void* d_out, int out_size, void* d_ws, size_t ws_size, hipStream_t stream) {
    static int grid = 0;
    if (grid == 0) {
        if (n_in != 24 || out_size != TL * D || ws_size < WS_END) { fprintf(stderr, "kernel_launch: unexpected shapes (n_in %d out %d ws %zu); nothing launched\n", n_in, out_size, ws_size); grid = -1; return; }
        int dev = 0, cus = 0;
        if (hipGetDevice(&dev) != hipSuccess || hipDeviceGetAttribute(&cus, hipDeviceAttributeMultiprocessorCount, dev) != hipSuccess) { grid = -1; return; }
        if (hipFuncSetAttribute((const void*)mk_fwd, hipFuncAttributeMaxDynamicSharedMemorySize, LDS_BYTES) != hipSuccess) { fprintf(stderr, "kernel_launch: hipFuncSetAttribute failed\n"); grid = -1; return; }
        int per_cu = 0;
        if (hipOccupancyMaxActiveBlocksPerMultiprocessor(&per_cu, (const void*)mk_fwd, NWAVES * 64, LDS_BYTES) != hipSuccess || per_cu < 1) fprintf(stderr, "kernel_launch: occupancy query says %d\n", per_cu);
        (void)hipGetLastError();
        grid = cus;
    }
    if (grid < 0) return;
    (void)hipMemsetAsync((char*)d_ws + WS_CTL, 0, CTL_ZERO_BYTES, stream);
    Args a{};
    for (int i = 0; i < 24; ++i) a.in[i] = (const float*)d_in[i];
    a.out = (float*)d_out; a.ws = (unsigned char*)d_ws;
#if MK_ONE_LAUNCH
    a.ph_lo = 0; a.ph_hi = NPHASE;
    hipLaunchKernelGGL(mk_fwd, dim3(grid), dim3(NWAVES * 64), LDS_BYTES, stream, a);
#else
    for (int p = 0; p < NPHASE; ++p) { a.ph_lo = p; a.ph_hi = p + 1; hipLaunchKernelGGL(mk_fwd, dim3(grid), dim3(NWAVES * 64), LDS_BYTES, stream, a); }
#endif
}
```

```cpp
#include <hip/hip_runtime.h>
#include <cstdio>
#include <cstdint>

#ifndef MK_ONE_LAUNCH
#define MK_ONE_LAUNCH 1
#endif
#ifndef PROBE_DOUBLE
#define PROBE_DOUBLE 0
#endif
#ifndef PROBE_EPI2
#define PROBE_EPI2 0
#endif
#ifndef PROBE_KREP
#define PROBE_KREP 1
#endif
#ifndef GEMM_ALIGN_EPI
#define GEMM_ALIGN_EPI 1
#endif
#ifndef GEMM_STAGGER_TICKS
#define GEMM_STAGGER_TICKS 0
#endif

#define LAS __attribute__((address_space(3)))
#define GAS __attribute__((address_space(1)))
typedef unsigned short bf16;
typedef short bf16x8 __attribute__((ext_vector_type(8)));
typedef float f32x4 __attribute__((ext_vector_type(4)));
typedef float f32x2 __attribute__((ext_vector_type(2)));
typedef unsigned u32x4 __attribute__((ext_vector_type(4)));
typedef unsigned u32x2 __attribute__((ext_vector_type(2)));
typedef int i32x4 __attribute__((ext_vector_type(4)));
typedef int i32x8 __attribute__((ext_vector_type(8)));
typedef GAS unsigned gu32;

constexpr int D = 1024, NB = 16, SEQ = 2048, CTXL = 256;
constexpr int TL = NB * SEQ;
constexpr int TC = NB * CTXL;
constexpr int TT = TL + TC;
constexpr int IN_W = 5664, X0 = 1024, B0 = 2048, C0 = 2304, DT0 = 2560, SC0 = 2592;
constexpr int NE = 32, TOPK = 4, DFF = 1024;
constexpr int XBCW = 1536;
constexpr int NT_IN = 23;
constexpr int CAP = TL;
constexpr int ACT_ROWS = TL * TOPK + NE * 256;
constexpr float NORM_EPS = 1e-6f;

constexpr size_t MiB = 1u << 20;
constexpr size_t WS_CTL = 0, CTL_ZERO_BYTES = 1 * MiB;
constexpr size_t WS_MOD = 1 * MiB;
constexpr size_t WS_TOKES = 2 * MiB;
constexpr size_t WS_TOKG = 2 * MiB + 512 * 1024;
constexpr size_t WS_ROWTOK = 3 * MiB;
constexpr size_t WS_WIN = 7 * MiB;
constexpr size_t WS_WOUT = 19 * MiB;
constexpr size_t WS_WGU = 23 * MiB;
constexpr size_t WS_WDN = 151 * MiB;
constexpr size_t WS_HX = 215 * MiB;
constexpr size_t WS_XRAW = 287 * MiB;
constexpr size_t WS_XBC = 395 * MiB;
constexpr size_t WS_DT = 503 * MiB;
constexpr size_t WS_SZ = 508 * MiB;
constexpr size_t WS_SCB = 572 * MiB;
constexpr size_t WS_CU = 636 * MiB;
constexpr size_t WS_YF = 700 * MiB;
constexpr size_t WS_YB = 764 * MiB;
constexpr size_t WS_A2 = 828 * MiB;
constexpr size_t WS_ACT = 287 * MiB;
constexpr size_t WS_YROWS = 572 * MiB;
constexpr size_t WS_X1B = 956 * MiB;
constexpr size_t WS_END = 1020 * MiB;
constexpr int CW_ECNT = 64;
constexpr int CW_BAR = 4096;

constexpr int LDS_BYTES = 147456;
constexpr int CTLDS_OFF = 146432;
constexpr int LW_BARST = 0;
constexpr int LDS_IDX_OFF = 131072, MOE_LIDX_UNITS = 30;
constexpr int LW_MTS = 16;
constexpr int LW_CNT = 64;

constexpr int NWAVES = 8;

#define LDS_WAIT() asm volatile("s_waitcnt lgkmcnt(0)" ::: "memory")
#define VM_WAIT() asm volatile("s_waitcnt vmcnt(0)" ::: "memory")
#define RLX_AGENT __ATOMIC_RELAXED, __HIP_MEMORY_SCOPE_AGENT

__device__ __forceinline__ unsigned f2bf(float f) { unsigned u = __builtin_bit_cast(unsigned, f); return (u + 0x7fffu + ((u >> 16) & 1u)) >> 16; }
typedef __bf16 hwbf16x2 __attribute__((ext_vector_type(2)));
__device__ __forceinline__ unsigned pk2(float lo, float hi) { const f32x2 v = {lo, hi}; const hwbf16x2 b = __builtin_convertvector(v, hwbf16x2); return __builtin_bit_cast(unsigned, b); }
__device__ __forceinline__ unsigned pk4_fp8(float a, float b, float c, float d) { int v = __builtin_amdgcn_cvt_pk_fp8_f32(a, b, 0, false); v = __builtin_amdgcn_cvt_pk_fp8_f32(c, d, v, true); return (unsigned)v; }
__device__ __forceinline__ void unpack8_fp8(const u32x2 w, float (&f)[8]) {
    const f32x2 a = __builtin_amdgcn_cvt_pk_f32_fp8((int)w.x, false), b = __builtin_amdgcn_cvt_pk_f32_fp8((int)w.x, true), c = __builtin_amdgcn_cvt_pk_f32_fp8((int)w.y, false), d = __builtin_amdgcn_cvt_pk_f32_fp8((int)w.y, true);
    f[0] = a[0]; f[1] = a[1]; f[2] = b[0]; f[3] = b[1]; f[4] = c[0]; f[5] = c[1]; f[6] = d[0]; f[7] = d[1]; }
constexpr float W8_SCALE = 64.0f, W8_INV = 1.0f / 64.0f;
__device__ __forceinline__ float bf2f(unsigned b) { return __builtin_bit_cast(float, b << 16); }
__device__ __forceinline__ float bflo(unsigned w) { return __builtin_bit_cast(float, w << 16); }
__device__ __forceinline__ float bfhi(unsigned w) { return __builtin_bit_cast(float, w & 0xffff0000u); }
__device__ __forceinline__ float fsilu(float x) { return x * __builtin_amdgcn_rcpf(1.0f + __expf(-x)); }
__device__ __forceinline__ float wave_sum(float v) {
#pragma unroll
    for (int o = 1; o < 64; o <<= 1) v += __shfl_xor(v, o);
    return v;
}

#define XB_TMO      128
#define XB_XCNT(j)  (256  + 64 * (j))
#define XB_XSUB(j)  (1280 + 64 * (j))
#define XB_XGEN(j)  (2304 + 64 * (j))
#define XB_TOP      3328
#define XB_TOPGEN   3392
#define XCD_BAR_WORDS 3456
#define XB_SPIN_CAP (1u << 18)
__device__ __forceinline__ unsigned xb_ld(unsigned* p)              { return __hip_atomic_load(p, __ATOMIC_RELAXED, __HIP_MEMORY_SCOPE_AGENT); }
__device__ __forceinline__ unsigned xb_add(unsigned* p, unsigned v) { return __hip_atomic_fetch_add(p, v, __ATOMIC_RELAXED, __HIP_MEMORY_SCOPE_AGENT); }
__device__ __forceinline__ unsigned xb_xcc_id() { return (unsigned)__builtin_amdgcn_s_getreg((3 << 11) | 20) & 0xFu; }
#define XB_SPIN(cond, bar) do { unsigned _sp = 0; while (cond) { __builtin_amdgcn_s_sleep(1); \
    if ((++_sp & 255u) == 0u) { if (xb_ld(&(bar)[XB_TMO])) break; if (_sp > XB_SPIN_CAP) { atomicAdd(&(bar)[XB_TMO], 1u); break; } } } } while (0)
struct XcdBarrier { unsigned* bar; unsigned x; volatile LAS unsigned* st; };
__device__ __forceinline__ XcdBarrier xcd_barrier_post(unsigned* bar, volatile LAS unsigned* st) {
    XcdBarrier b; b.bar = bar; b.x = xb_xcc_id(); b.st = st;
    if (threadIdx.x == 0) (void)xb_add(&bar[XB_XCNT(b.x)], 1u);
    return b;
}
__device__ __forceinline__ void xcd_barrier_complete(unsigned* bar, unsigned x, unsigned& nloc, unsigned& nx) {
    const unsigned G = gridDim.x * gridDim.y * gridDim.z;
    unsigned sum, cnt, mine, sp = 0u;
    for (;;) {
        sum = 0u; cnt = 0u; mine = 0u;
#pragma unroll
        for (unsigned j = 0; j < 16; ++j) { const unsigned c = xb_ld(&bar[XB_XCNT(j)]); sum += c; cnt += (c > 0u) ? 1u : 0u; mine = (j == x) ? c : mine; }
        if (sum == G) break;
        __builtin_amdgcn_s_sleep(1);
        if ((++sp & 255u) == 0u) { if (xb_ld(&bar[XB_TMO])) break; if (sp > XB_SPIN_CAP) { atomicAdd(&bar[XB_TMO], 1u); break; } }
    }
    nloc = mine > 0u ? mine : 1u; nx = cnt > 0u ? cnt : 1u;
}
__device__ __forceinline__ void xcd_barrier(const XcdBarrier& b) {
    asm volatile("s_waitcnt vmcnt(0)" ::: "memory");
    __syncthreads();
    if (threadIdx.x == 0) {
        unsigned* bar = b.bar;
        __builtin_amdgcn_s_waitcnt(0);
        unsigned nloc = b.st[0], nx = b.st[1];
        if (nloc == 0u) { xcd_barrier_complete(bar, b.x, nloc, nx); b.st[0] = nloc; b.st[1] = nx; }
        const unsigned old = xb_add(&bar[XB_XSUB(b.x)], 1u);
        const unsigned gen = old / nloc;
        if (old + 1u == (gen + 1u) * nloc) {
            __builtin_amdgcn_fence(__ATOMIC_RELEASE, "agent");
            asm volatile("s_waitcnt vmcnt(0)" ::: "memory");
            const unsigned og = xb_add(&bar[XB_TOP], 1u);
            const unsigned tg = og / nx;
            if (og + 1u == (tg + 1u) * nx) xb_add(&bar[XB_TOPGEN], 1u);
            else XB_SPIN(xb_ld(&bar[XB_TOPGEN]) == tg, bar);
            __builtin_amdgcn_fence(__ATOMIC_ACQUIRE, "agent");
            xb_add(&bar[XB_XGEN(b.x)], 1u);
            asm volatile("s_waitcnt vmcnt(0)" ::: "memory");
        } else {
            XB_SPIN(xb_ld(&bar[XB_XGEN(b.x)]) == gen, bar);
            __builtin_amdgcn_fence(__ATOMIC_ACQUIRE, "agent");
            asm volatile("s_waitcnt vmcnt(0)" ::: "memory");
        }
    }
    __syncthreads();
}

struct Args { const float* in[24]; float* out; unsigned char* ws; int ph_lo, ph_hi; };
struct Frame {
    LAS unsigned char* lds;
    volatile LAS unsigned* cl;
    unsigned char* ws;
    gu32* ctl;
    int tid, lane, wave, vcu, G;
    const float *x, *c, *ctx, *c_ctx, *w_mod, *b_mod, *norm1_g, *w_in, *conv_w, *conv_b, *dt_bias, *a_log, *ssd_d, *ssd_norm_g, *sc_conv_w, *w_out, *norm2_g, *w_router, *b_router, *w_gu, *b_gu, *w_dn, *b_dn, *final_g;
    float* out;
};

namespace pg8 {
constexpr int BM = 256, BK = 64, HALF = 128, HTB = HALF * BK * 2, STAGE_BYTES = 8 * HTB;
__device__ __forceinline__ int lds_byte(int r, int c) { const int st = (r >> 4) * 2 + (c >> 5), rr = r & 15, cc = c & 31, ob = rr * 64 + cc * 2; return st * 1024 + (ob ^ (((ob >> 9) & 1) << 5)); }
__device__ __forceinline__ void stage_rc(int b, int& R, int& C) { const int st = b / 1024, sb = b % 1024, swz = sb ^ (((sb >> 9) & 1) << 5); R = (st >> 1) * 16 + swz / 64; C = (st & 1) * 32 + (swz % 64) / 2; }
__device__ __forceinline__ int perm32(int rho) { const int n = rho >> 4, i = rho & 15; return 8 * (i >> 2) + 4 * n + (i & 3); }
__device__ __forceinline__ i32x8 cat8(bf16x8 a, bf16x8 b) { const i32x4 x = __builtin_bit_cast(i32x4, a), y = __builtin_bit_cast(i32x4, b); return __builtin_shufflevector(x, y, 0, 1, 2, 3, 4, 5, 6, 7); }
__device__ __forceinline__ unsigned cvt_pk_bf16(float lo, float hi) { unsigned r; asm volatile("v_cvt_pk_bf16_f32 %0, %1, %2" : "=v"(r) : "v"(lo), "v"(hi)); return r; }

struct Unit { int pm, pn, e, idx, q; };

template <class Epi, class Sched>
__device__ __forceinline__ void gemm_phase(LAS unsigned char* lds, const bf16* Aptr, const int K, const Sched& S, const Epi& E) {
    const int tid = threadIdx.x, wid = __builtin_amdgcn_readfirstlane(tid >> 6), lane = tid & 63, wr = wid >> 2, wc = wid & 3, fr = lane & 15, fq = lane >> 4;
    constexpr bool F8 = Epi::F8;
    const int nt = F8 ? K / 128 : K / BK;
    unsigned voffB[2];
#pragma unroll
    for (int i = 0; i < 2; ++i) { int R, C; stage_rc(tid * 16 + i * 8192, R, C); const int Rb = Epi::PERM ? ((R & ~31) + perm32(R & 31)) : R;
        voffB[i] = F8 ? (unsigned)(Rb * K + C * 2) : (unsigned)(Rb * K + C) * 2u; }
    const size_t kstep = (size_t)(BK * 2);
    const size_t hstep = (size_t)HALF * K * (F8 ? 1 : 2);
    const unsigned ldsw = (unsigned)wid * 1024u;
    const int aoff = lds_byte(wr * 64 + fr, fq * 8), boff = lds_byte(wc * 32 + fr, fq * 8);
    const char* const Abase = (const char*)Aptr;
#define PG8_SA(b, h) (((b) * 2 + (h)) * HTB)
#define PG8_SB(b, h) ((4 + (b) * 2 + (h)) * HTB)
#define PG8_STAGE(bufoff, gbase, voff) do { _Pragma("unroll") for (int _i = 0; _i < 2; ++_i) \
        __builtin_amdgcn_global_load_lds((const unsigned*)((const char*)(gbase) + (voff)[_i]), (LAS unsigned*)(lds + (bufoff) + ldsw + _i * 8192), 16, 0, 0); } while (0)
#define PG8_LDA(dst, b, h) do { _Pragma("unroll") for (int m = 0; m < 4; ++m) _Pragma("unroll") for (int k = 0; k < 2; ++k) dst[m][k] = *(const LAS bf16x8*)(lds + PG8_SA(b, h) + aoff + m * 2048 + k * 1024); } while (0)
#define PG8_LDB(dst, b, h) do { _Pragma("unroll") for (int n = 0; n < 2; ++n) _Pragma("unroll") for (int k = 0; k < 2; ++k) dst[n][k] = *(const LAS bf16x8*)(lds + PG8_SB(b, h) + boff + n * 2048 + k * 1024); } while (0)
#define PG8_MMA(ai, bj, At, Bt) do { __builtin_amdgcn_s_setprio(1); \
        if constexpr (F8) { _Pragma("unroll") for (int m = 0; m < 4; ++m) _Pragma("unroll") for (int n = 0; n < 2; ++n) \
            acc[ai][bj][m][n] = __builtin_amdgcn_mfma_scale_f32_16x16x128_f8f6f4(cat8(Bt[n][0], Bt[n][1]), cat8(At[m][0], At[m][1]), acc[ai][bj][m][n], 0, 0, 0, 0x7f7f7f7f, 0, 0x7f7f7f7f); } \
        else { _Pragma("unroll") for (int m = 0; m < 4; ++m) _Pragma("unroll") for (int n = 0; n < 2; ++n) _Pragma("unroll") for (int k = 0; k < 2; ++k) \
            acc[ai][bj][m][n] = __builtin_amdgcn_mfma_f32_16x16x32_bf16(Bt[n][k], At[m][k], acc[ai][bj][m][n], 0, 0, 0); } \
        __builtin_amdgcn_s_setprio(0); } while (0)
#define PG8_WAIT_V(n) asm volatile("s_waitcnt vmcnt(" #n ")" ::: "memory")
#define PG8_WAIT_L(n) asm volatile("s_waitcnt lgkmcnt(" #n ")" ::: "memory")
#define PG8_BAR __builtin_amdgcn_s_barrier()
#define PG8_SCHED __builtin_amdgcn_sched_barrier(0)
    Unit cur, nxt; int ui = 0;
    if (!S.next(0, cur)) return;
#if GEMM_STAGGER_TICKS > 0
    if (S.v & 1) { const unsigned long long t0 = __builtin_amdgcn_s_memrealtime(); while (__builtin_amdgcn_s_memrealtime() - t0 < (unsigned long long)GEMM_STAGGER_TICKS) __builtin_amdgcn_s_sleep(8); }
#endif
    f32x4 acc[2][2][4][2];
#pragma unroll
    for (int a = 0; a < 2; ++a)
#pragma unroll
        for (int b = 0; b < 2; ++b)
#pragma unroll
            for (int m = 0; m < 4; ++m)
#pragma unroll
                for (int n = 0; n < 2; ++n) acc[a][b][m][n] = (f32x4){0.f, 0.f, 0.f, 0.f};
    bf16x8 At[4][2], B0[2][2], B1[2][2];
    unsigned va0[2], va1[2];
    { int sR[2], sC[2];
#pragma unroll
      for (int i = 0; i < 2; ++i) stage_rc(tid * 16 + i * 8192, sR[i], sC[i]);
      S.aoff(cur, sR, sC, va0, va1); }
    const char* cB = S.bbase(cur);
    PG8_STAGE(PG8_SB(0, 0), cB, voffB); PG8_STAGE(PG8_SB(0, 1), cB + hstep, voffB); PG8_STAGE(PG8_SA(0, 0), Abase, va0); PG8_STAGE(PG8_SA(0, 1), Abase, va1);
    if (wr == 1) PG8_BAR;
    PG8_WAIT_V(2); PG8_BAR;
    PG8_STAGE(PG8_SB(1, 0), cB + kstep, voffB); PG8_STAGE(PG8_SA(1, 0), Abase + kstep, va0); PG8_STAGE(PG8_SB(1, 1), cB + hstep + kstep, voffB);
    PG8_WAIT_V(6); PG8_BAR;
    for (;;) {
        nxt = cur;
        const bool has_next = S.next(ui + 1, nxt);
        const char* nB = has_next ? S.bbase(nxt) : cB;
#pragma unroll 1
        for (int t = 0; t < nt * PROBE_KREP; t += 2) {
            const bool last = (t == nt * PROBE_KREP - 2);
            const char* a1 = Abase + (size_t)((t + 1) % nt) * kstep;
            const char* a2 = last ? Abase : Abase + (size_t)((t + 2) % nt) * kstep; const char* b2 = last ? nB : cB + (size_t)((t + 2) % nt) * kstep;
            const char* a3 = a2 + kstep; const char* b3 = b2 + kstep;
            unsigned nva0[2], nva1[2];
            nva0[0] = va0[0]; nva0[1] = va0[1]; nva1[0] = va1[0]; nva1[1] = va1[1];
            if (last && has_next) {
                int tq = tid; asm volatile("" : "+v"(tq));
                int sR[2], sC[2];
#pragma unroll
                for (int i = 0; i < 2; ++i) stage_rc(tq * 16 + i * 8192, sR[i], sC[i]);
                S.aoff(nxt, sR, sC, nva0, nva1);
            }
            PG8_LDB(B0, 0, 0); PG8_LDB(B1, 0, 1); PG8_SCHED; PG8_LDA(At, 0, 0); PG8_STAGE(PG8_SA(1, 1), a1, va1);
            if constexpr (Epi::NSTORES == 16) { if (t == 0 && ui > 0) PG8_WAIT_V(24); else PG8_WAIT_V(8); }
            else if constexpr (Epi::NSTORES == 8) { if (t == 0 && ui > 0) PG8_WAIT_V(16); else PG8_WAIT_V(8); }
            else PG8_WAIT_V(8);
            PG8_WAIT_L(0); PG8_BAR; if (cur.q & 1) PG8_MMA(0, 0, At, B0); if (cur.q & 2) PG8_MMA(0, 1, At, B1); PG8_BAR; PG8_SCHED;
            if (last) { va0[0] = nva0[0]; va0[1] = nva0[1]; va1[0] = nva1[0]; va1[1] = nva1[1]; }
            PG8_LDA(At, 0, 1); PG8_STAGE(PG8_SB(0, 0), b2, voffB); PG8_STAGE(PG8_SB(0, 1), b2 + hstep, voffB); PG8_STAGE(PG8_SA(0, 0), a2, va0);
            if constexpr (Epi::NSTORES == 16) { if (t == 0 && ui > 0) PG8_WAIT_V(24); else PG8_WAIT_V(8); }
            else if constexpr (Epi::NSTORES == 8) { if (t == 0 && ui > 0) PG8_WAIT_V(16); else PG8_WAIT_V(8); }
            else PG8_WAIT_V(8);
            PG8_WAIT_L(0); PG8_BAR; if (cur.q & 4) PG8_MMA(1, 0, At, B0); if (cur.q & 8) PG8_MMA(1, 1, At, B1); PG8_BAR; PG8_SCHED;
            PG8_LDB(B0, 1, 0); PG8_LDB(B1, 1, 1); PG8_SCHED; PG8_LDA(At, 1, 0); PG8_STAGE(PG8_SA(0, 1), a2, va1);
            PG8_WAIT_V(8); PG8_WAIT_L(0); PG8_BAR; if (cur.q & 1) PG8_MMA(0, 0, At, B0); if (cur.q & 2) PG8_MMA(0, 1, At, B1); PG8_BAR; PG8_SCHED;
            PG8_LDA(At, 1, 1); PG8_STAGE(PG8_SB(1, 0), b3, voffB); PG8_STAGE(PG8_SB(1, 1), b3 + hstep, voffB); PG8_STAGE(PG8_SA(1, 0), a3, va0);
            PG8_WAIT_V(8); PG8_WAIT_L(0); PG8_BAR; if (cur.q & 4) PG8_MMA(1, 0, At, B0); if (cur.q & 8) PG8_MMA(1, 1, At, B1); PG8_BAR; PG8_SCHED;
        }
#if GEMM_ALIGN_EPI
        if (wr == 0) PG8_BAR;
#endif
#if PROBE_KREP > 1
#pragma unroll
        for (int a = 0; a < 2; ++a)
#pragma unroll
            for (int b = 0; b < 2; ++b)
#pragma unroll
                for (int m = 0; m < 4; ++m)
#pragma unroll
                    for (int n = 0; n < 2; ++n) acc[a][b][m][n] = acc[a][b][m][n] * (1.0f / PROBE_KREP);
#endif
        { int tq = tid; asm volatile("" : "+v"(tq));
          (void)E(acc, cur, wr, wc, tq & 15, (tq & 63) >> 4); }
        if (!has_next) break;
#pragma unroll
        for (int a = 0; a < 2; ++a)
#pragma unroll
            for (int b = 0; b < 2; ++b)
#pragma unroll
                for (int m = 0; m < 4; ++m)
#pragma unroll
                    for (int n = 0; n < 2; ++n) acc[a][b][m][n] = (f32x4){0.f, 0.f, 0.f, 0.f};
        cur = nxt; cB = nB; ++ui;
#if GEMM_ALIGN_EPI
        if (wr == 1) PG8_BAR;
#endif
    }
    PG8_WAIT_V(0);
#if !GEMM_ALIGN_EPI
    if (wr == 0) PG8_BAR;
#endif
    PG8_BAR;
#undef PG8_SA
#undef PG8_SB
#undef PG8_STAGE
#undef PG8_LDA
#undef PG8_LDB
#undef PG8_MMA
#undef PG8_WAIT_V
#undef PG8_WAIT_L
#undef PG8_BAR
#undef PG8_SCHED
}
}

using pg8::Unit;
struct SchedIn {
    static constexpr bool GATHER = false;
    int G, v, K; const bf16* Bt;
    __device__ __forceinline__ bool next(int i, Unit& u) const {
        int L = i * G + v; if (L >= 3040) return false;
        if (L < 2944) { const int gid = L / 184, l = L % 184; u.pm = gid * 8 + (l & 7); u.pn = l >> 3; }
        else { L -= 2944; const int gid = L / 48, l = L % 48; u.pm = 128 + gid * 8 + (l & 7); u.pn = l >> 3; }
        u.e = 0; u.idx = i; u.q = 15; return true;
    }
    __device__ __forceinline__ const char* bbase(const Unit& u) const { return (const char*)Bt + (size_t)u.pn * ((size_t)256 * K * 2); }
    __device__ __forceinline__ void aoff(const Unit& u, const int (&R)[2], const int (&C)[2], unsigned (&v0)[2], unsigned (&v1)[2]) const {
#pragma unroll
        for (int i = 0; i < 2; ++i) { v0[i] = (unsigned)(((u.pm * 256 + R[i]) * K + C[i]) * 2); v1[i] = (unsigned)(((u.pm * 256 + 128 + R[i]) * K + C[i]) * 2); }
    }
};
struct SchedPlain {
    static constexpr bool GATHER = false;
    int G, v, K, nN, nwg; const bf16* Bt;
    __device__ __forceinline__ bool next(int i, Unit& u) const {
        const int L = i * G + v; if (L >= nwg) return false;
        const int per = 8 * nN, gid = L / per, l = L % per; u.pm = gid * 8 + (l & 7); u.pn = l >> 3; u.e = 0; u.idx = i; u.q = 15; return true;
    }
    __device__ __forceinline__ const char* bbase(const Unit& u) const { return (const char*)Bt + (size_t)u.pn * ((size_t)256 * K); }
    __device__ __forceinline__ void aoff(const Unit& u, const int (&R)[2], const int (&C)[2], unsigned (&v0)[2], unsigned (&v1)[2]) const {
#pragma unroll
        for (int i = 0; i < 2; ++i) { v0[i] = (unsigned)((u.pm * 256 + R[i]) * K + C[i] * 2); v1[i] = (unsigned)((u.pm * 256 + 128 + R[i]) * K + C[i] * 2); }
    }
};
template <bool GATH> struct SchedMoe {
    static constexpr bool GATHER = GATH;
    int G, v, K, NT; const bf16* Bt; const volatile LAS unsigned* cl; const int* rowtok; const LAS unsigned short* lidx;
    __device__ __forceinline__ bool next(int i, Unit& u) const {
        const int tot = (int)cl[LW_MTS + 32], U = tot * NT, full = (U / G) * G, R = U - full;
        int L = i * G + v, q = 15;
        if (L >= full) {
            const int t = L - full, s = (!GATH && R * 4 <= G) ? 4 : (R * 2 <= G) ? 2 : 1, un = t / s, qq = t - un * s;
            if (un >= R) return false;
            L = full + un; q = s == 1 ? 15 : s == 2 ? (3 << (2 * qq)) : (1 << qq); }
        int mt = L / NT;
        const int pn = L - mt * NT;
        int e;
        if (GATH) { e = i > 0 ? u.e : 0;
            while (e < 31 && (int)cl[LW_MTS + e + 1] <= mt) ++e; }
        else { mt = tot - 1 - mt;
            e = i > 0 ? u.e : 31;
            while (e > 0 && (int)cl[LW_MTS + e] > mt) --e; }
        u.pm = mt; u.pn = pn; u.e = e; u.idx = i; u.q = q; return true;
    }
    __device__ __forceinline__ const char* bbase(const Unit& u) const { return (const char*)Bt + ((size_t)u.e * NT + u.pn) * ((size_t)256 * K); }
    __device__ __forceinline__ void aoff(const Unit& u, const int (&R)[2], const int (&C)[2], unsigned (&v0)[2], unsigned (&v1)[2]) const {
        if (GATH) {
            if (u.idx < MOE_LIDX_UNITS) {
#pragma unroll
                for (int i = 0; i < 2; ++i) { const int t0 = lidx[u.idx * 256 + R[i]], t1 = lidx[u.idx * 256 + 128 + R[i]];
                    v0[i] = (unsigned)(t0 * K + C[i] * 2); v1[i] = (unsigned)(t1 * K + C[i] * 2); }
            } else {
                const int i0 = (u.pm - (int)cl[LW_MTS + u.e]) * 256, cnt = (int)cl[LW_CNT + u.e];
                const int* rt = rowtok + (size_t)u.e * CAP;
#pragma unroll
                for (int i = 0; i < 2; ++i) {
                    int s0 = i0 + R[i], s1 = i0 + 128 + R[i]; s0 = s0 < cnt ? s0 : 0; s1 = s1 < cnt ? s1 : 0;
                    const int t0 = rt[s0], t1 = rt[s1];
                    v0[i] = (unsigned)(t0 * K + C[i] * 2); v1[i] = (unsigned)(t1 * K + C[i] * 2);
                }
                asm volatile("s_waitcnt vmcnt(0)" ::: "memory");
                asm volatile("" : "+v"(v0[0]), "+v"(v0[1]), "+v"(v1[0]), "+v"(v1[1]));
            }
        } else {
#pragma unroll
            for (int i = 0; i < 2; ++i) { v0[i] = (unsigned)((u.pm * 256 + R[i]) * K + C[i] * 2); v1[i] = (unsigned)((u.pm * 256 + 128 + R[i]) * K + C[i] * 2); }
        }
    }
};

__device__ __forceinline__ float softplusf(float x) { return x > 20.f ? x : log1pf(__expf(x)); }

struct EpiIn {
    static constexpr bool PERM = true, F8 = false; static constexpr int NSTORES = 0;
    bf16* xraw; float* dt; bf16* sz; bf16* scb; bf16* cu; const float* dt_bias;
    __device__ __forceinline__ int operator()(const f32x4 (&acc)[2][2][4][2], const Unit& u, int wr, int wc, int fr, int fq) const {
        const int row0 = u.pm * 256 + wr * 64 + fr, pn = u.pn, cl = wc * 32 + 8 * fq;
        if (pn <= 4 || pn == 6 || (pn >= 11 && pn <= 14)) {
            bf16* base; int ld;
            if (pn <= 4) { base = xraw + pn * 256; ld = XBCW; } else if (pn == 6) { base = xraw + 1280; ld = XBCW; } else { base = scb + (pn - 11) * 256; ld = 1024; }
#pragma unroll
            for (int ai = 0; ai < 2; ++ai)
#pragma unroll
                for (int m = 0; m < 4; ++m) { bf16* rowp = base + (size_t)(row0 + ai * 128 + m * 16) * ld + cl;
#pragma unroll
                    for (int bj = 0; bj < 2; ++bj) { const f32x4 v0 = acc[ai][bj][m][0], v1 = acc[ai][bj][m][1];
                        u32x4 w; w.x = pk2(v0[0], v0[1]); w.y = pk2(v0[2], v0[3]); w.z = pk2(v1[0], v1[1]); w.w = pk2(v1[2], v1[3]);
                        *(u32x4*)(rowp + bj * 128) = w; } }
            return 16;
        } else if (pn == 5) {
            if (wc == 0) {
                const f32x4 b0 = *(const f32x4*)(dt_bias + 8 * fq), b1 = *(const f32x4*)(dt_bias + 8 * fq + 4);
#pragma unroll
                for (int ai = 0; ai < 2; ++ai)
#pragma unroll
                    for (int m = 0; m < 4; ++m) { float* rowp = dt + (size_t)(row0 + ai * 128 + m * 16) * 32 + 8 * fq;
                        const f32x4 v0 = acc[ai][0][m][0] + b0, v1 = acc[ai][0][m][1] + b1; f32x4 o0, o1;
#pragma unroll
                        for (int j = 0; j < 4; ++j) { o0[j] = softplusf(v0[j]); o1[j] = softplusf(v1[j]); }
                        *(f32x4*)rowp = o0; *(f32x4*)(rowp + 4) = o1; }
                return 16;
            }
            return 0;
        } else if (pn <= 10) {
            bf16* base = sz + (pn - 7) * 256;
#pragma unroll
            for (int ai = 0; ai < 2; ++ai)
#pragma unroll
                for (int m = 0; m < 4; ++m) { bf16* rowp = base + (size_t)(row0 + ai * 128 + m * 16) * 1024 + cl;
#pragma unroll
                    for (int bj = 0; bj < 2; ++bj) { f32x4 v0 = acc[ai][bj][m][0], v1 = acc[ai][bj][m][1];
#pragma unroll
                        for (int j = 0; j < 4; ++j) { v0[j] = fsilu(v0[j]); v1[j] = fsilu(v1[j]); }
                        u32x4 w; w.x = pk2(v0[0], v0[1]); w.y = pk2(v0[2], v0[3]); w.z = pk2(v1[0], v1[1]); w.w = pk2(v1[2], v1[3]);
                        *(u32x4*)(rowp + bj * 128) = w; } }
            return 16;
        } else {
            bf16* base = cu + (pn - 15) * 128;
#pragma unroll
            for (int ai = 0; ai < 2; ++ai)
#pragma unroll
                for (int m = 0; m < 4; ++m) { bf16* rowp = base + (size_t)(row0 + ai * 128 + m * 16) * 1024 + cl;
                    const f32x4 v0 = acc[ai][0][m][0] * acc[ai][1][m][0], v1 = acc[ai][0][m][1] * acc[ai][1][m][1];
                    u32x4 w; w.x = pk2(v0[0], v0[1]); w.y = pk2(v0[2], v0[3]); w.z = pk2(v1[0], v1[1]); w.w = pk2(v1[2], v1[3]);
                    *(u32x4*)rowp = w; }
            return 8;
        }
    }
};
struct EpiOut {
    static constexpr bool PERM = true, F8 = true; static constexpr int NSTORES = 0;
    const float* x; bf16* x1b; const float* mod;
    __device__ __forceinline__ int operator()(const f32x4 (&acc)[2][2][4][2], const Unit& u, int wr, int wc, int fr, int fq) const {
        const int row0 = u.pm * 256 + wr * 64 + fr, col0 = u.pn * 256 + wc * 32 + 8 * fq, b = u.pm >> 3;
        f32x4 gv[2][2];
#pragma unroll
        for (int bj = 0; bj < 2; ++bj)
#pragma unroll
            for (int n = 0; n < 2; ++n) gv[bj][n] = *(const f32x4*)(mod + (size_t)b * 6144 + 2048 + col0 + bj * 128 + n * 4) * W8_INV;
#pragma unroll
        for (int ai = 0; ai < 2; ++ai)
#pragma unroll
            for (int m = 0; m < 4; ++m) { const size_t off = (size_t)(row0 + ai * 128 + m * 16) * 1024 + col0;
#pragma unroll
                for (int bj = 0; bj < 2; ++bj) { const f32x4 x0 = *(const f32x4*)(x + off + bj * 128), x1 = *(const f32x4*)(x + off + bj * 128 + 4);
                    const f32x4 v0 = x0 + gv[bj][0] * acc[ai][bj][m][0], v1 = x1 + gv[bj][1] * acc[ai][bj][m][1];
                    u32x4 w; w.x = pk2(v0[0], v0[1]); w.y = pk2(v0[2], v0[3]); w.z = pk2(v1[0], v1[1]); w.w = pk2(v1[2], v1[3]);
                    *(u32x4*)(x1b + off + bj * 128) = w; }
                if (m & 1) asm volatile("" ::: "memory"); }
        return 16;
    }
};
struct EpiGU {
    static constexpr bool PERM = true, F8 = true; static constexpr int NSTORES = 8;
    unsigned char* act; const float* bgu;
    static __device__ __forceinline__ f32x2 swiglu2(const f32x2 g, const f32x2 l) {
        f32x2 ga, la; ga[0] = fminf(g[0], 7.f); ga[1] = fminf(g[1], 7.f);
        la[0] = __builtin_amdgcn_fmed3f(l[0], -7.f, 7.f); la[1] = __builtin_amdgcn_fmed3f(l[1], -7.f, 7.f);
        const f32x2 tt = ga * (-1.702f * 1.4426950408889634f);
        f32x2 d; d[0] = __builtin_amdgcn_exp2f(tt[0]); d[1] = __builtin_amdgcn_exp2f(tt[1]);
        d = d + 1.0f;
        f32x2 r; r[0] = __builtin_amdgcn_rcpf(d[0]); r[1] = __builtin_amdgcn_rcpf(d[1]);
        return ga * r * (la + 1.0f);
    }
    __device__ __forceinline__ int operator()(const f32x4 (&acc)[2][2][4][2], const Unit& u, int wr, int wc, int fr, int fq) const {
        const int row0 = u.pm * 256 + wr * 64 + fr, cl = wc * 32 + 8 * fq, ch0 = u.pn * 128 + cl;
        const float* bp = bgu + (size_t)u.e * 2048 + ch0;
        const f32x4 bg0 = *(const f32x4*)bp, bg1 = *(const f32x4*)(bp + 4), bl0 = *(const f32x4*)(bp + 1024), bl1 = *(const f32x4*)(bp + 1028);
#pragma unroll
        for (int ai = 0; ai < 2; ++ai) { if (!((u.q >> (2 * ai)) & 1)) continue;
#pragma unroll
            for (int m = 0; m < 4; ++m) { unsigned char* rowp = act + (size_t)(row0 + ai * 128 + m * 16) * 1024 + ch0;
                const f32x4 g0 = acc[ai][0][m][0] * W8_INV + bg0, g1 = acc[ai][0][m][1] * W8_INV + bg1, l0 = acc[ai][1][m][0] * W8_INV + bl0, l1 = acc[ai][1][m][1] * W8_INV + bl1;
                const f32x2 oa = swiglu2(g0.xy, l0.xy), ob = swiglu2(g0.zw, l0.zw), oc = swiglu2(g1.xy, l1.xy), od = swiglu2(g1.zw, l1.zw);
                u32x2 w; w.x = pk4_fp8(oa[0], oa[1], ob[0], ob[1]); w.y = pk4_fp8(oc[0], oc[1], od[0], od[1]);
                *(u32x2*)rowp = w; } }
        return 8;
    }
};
struct EpiDown {
    static constexpr bool PERM = true, F8 = true; static constexpr int NSTORES = 16;
    unsigned char* y; const float* bdn;
    __device__ __forceinline__ int operator()(const f32x4 (&acc)[2][2][4][2], const Unit& u, int wr, int wc, int fr, int fq) const {
        const int row0 = u.pm * 256 + wr * 64 + fr, col0 = u.pn * 256 + wc * 32 + 8 * fq;
        const float* bp = bdn + (size_t)u.e * 1024 + col0;
#pragma unroll
        for (int bj = 0; bj < 2; ++bj) { const f32x4 b0 = *(const f32x4*)(bp + bj * 128), b1 = *(const f32x4*)(bp + bj * 128 + 4);
#pragma unroll
            for (int ai = 0; ai < 2; ++ai) { if (!((u.q >> (2 * ai + bj)) & 1)) continue;
#pragma unroll
                for (int m = 0; m < 4; ++m) { unsigned char* rowp = y + (size_t)(row0 + ai * 128 + m * 16) * 1024 + col0;
                    const f32x4 v0 = acc[ai][bj][m][0] * W8_INV + b0, v1 = acc[ai][bj][m][1] * W8_INV + b1;
                    u32x2 w; w.x = pk4_fp8(v0[0], v0[1], v0[2], v0[3]); w.y = pk4_fp8(v1[0], v1[1], v1[2], v1[3]);
                    *(u32x2*)(rowp + bj * 128) = w; } } }
        return 16;
    }
};

template <class Sched> __device__ __forceinline__ void preload_row_indices(Frame& F, const Sched& S) {
    LAS unsigned short* li = (LAS unsigned short*)(F.lds + LDS_IDX_OFF);
    volatile LAS unsigned* ut = F.cl + 128;
    if (F.tid < 64) {
        Unit u; u.e = 0; int n = 0;
        for (int i = 0; i < MOE_LIDX_UNITS; ++i) { if (!S.next(i, u)) break;
            if (F.lane == 0) { ut[2 * i] = (unsigned)u.e; ut[2 * i + 1] = (unsigned)((u.pm - (int)F.cl[LW_MTS + u.e]) * 256); }
            n = i + 1; }
        if (F.lane == 0) ut[60] = (unsigned)n;
    }
    __syncthreads();
    const int n = (int)ut[60];
    unsigned short v[15];
#pragma unroll
    for (int k = 0; k < 15; ++k) { const int entry = F.tid + 512 * k, i = entry >> 8, r = entry & 255; v[k] = 0;
        if (i < n) { const int e = (int)ut[2 * i], i0 = (int)ut[2 * i + 1], cnt = (int)F.cl[LW_CNT + e];
            const int sl = i0 + r < cnt ? i0 + r : 0;
            v[k] = (unsigned short)S.rowtok[(size_t)e * CAP + sl]; } }
#pragma unroll
    for (int k = 0; k < 15; ++k) { const int entry = F.tid + 512 * k; if ((entry >> 8) < n) li[entry] = v[k]; }
    __syncthreads();
}
__device__ __forceinline__ void p0_item(const float* W, int ldw, int K, int k0, int n0, bf16* WT, int drow0, const float* kscale, LAS float* scr, int lane) {
#pragma unroll 8
    for (int i = 0; i < 32; ++i) { const int kk = 2 * i + (lane >> 5); float w = W[(size_t)(k0 + kk) * ldw + n0 + (lane & 31)]; if (kscale) w *= kscale[k0 + kk]; scr[kk * 33 + (lane & 31)] = w; }
    LDS_WAIT(); asm volatile("" ::: "memory");
    const int c = lane & 7;
#pragma unroll
    for (int j = 0; j < 4; ++j) { const int n = (lane >> 3) + 8 * j; const LAS float* s = scr + (8 * c) * 33 + n;
        u32x4 o; o.x = pk2(s[0 * 33], s[1 * 33]); o.y = pk2(s[2 * 33], s[3 * 33]); o.z = pk2(s[4 * 33], s[5 * 33]); o.w = pk2(s[6 * 33], s[7 * 33]);
        *(u32x4*)(WT + (size_t)(drow0 + n) * K + k0 + 8 * c) = o; }
    LDS_WAIT(); asm volatile("" ::: "memory");
}
__device__ __forceinline__ int win_drow(int n) {
    if (n < X0) return (7 + (n >> 8)) * 256 + (n & 255);
    if (n < B0) return n - X0;
    if (n < C0) return 4 * 256 + (n - B0);
    if (n < DT0) return 6 * 256 + (n - C0);
    if (n < SC0) return 5 * 256 + (n - DT0);
    n -= SC0;
    if (n < 1024) return (11 + (n >> 8)) * 256 + (n & 255);
    if (n < 2048) { n -= 1024; return (15 + (n >> 7)) * 256 + (n & 127); }
    n -= 2048; return (15 + (n >> 7)) * 256 + 128 + (n & 127);
}
__device__ __forceinline__ void phase0(Frame& F) {
    float* mod = (float*)(F.ws + WS_MOD);
    for (int it = F.vcu; it < 192; it += F.G) {
        typedef float f32x16 __attribute__((ext_vector_type(16)));
        LAS float* sc = (LAS float*)F.lds;
        LAS float* red = (LAS float*)(F.lds + 69760);
        const int lane = F.lane, w = F.wave, n0 = it * 32, r = lane & 31, kh = lane >> 5;
        float cv[34];
#pragma unroll
        for (int q = 0; q < 34; ++q) { const int i = F.tid + 512 * q, rr = i >> 10, k = i & 1023; cv[q] = (rr < 16) ? F.c[rr * 1024 + k] : F.c_ctx[k]; }
        float wl[64];
        const float* wbase = F.w_mod + (size_t)(128 * w) * 6144 + n0; const int loff = kh * 6144 + r;
#pragma unroll
        for (int q = 0; q < 64; ++q) wl[q] = (wbase + (size_t)q * 12288)[loff];
#pragma unroll
        for (int q = 0; q < 34; ++q) { const int i = F.tid + 512 * q; sc[(i >> 10) * 1025 + (i & 1023)] = fsilu(cv[q]); }
        __syncthreads();
        f32x16 acc;
#pragma unroll
        for (int e = 0; e < 16; ++e) acc[e] = 0.f;
        const LAS float* ap = sc + (r < 17 ? r : 0) * 1025 + 128 * w + kh;
#pragma unroll
        for (int q = 0; q < 64; ++q) { const float av = r < 17 ? ap[2 * q] : 0.f; acc = __builtin_amdgcn_mfma_f32_32x32x2f32(av, wl[q], acc, 0, 0, 0); }
#pragma unroll
        for (int reg = 0; reg < 8; ++reg) red[(w * 17 + (reg & 3) + 8 * (reg >> 2) + 4 * kh) * 32 + r] = acc[reg];
        if (kh == 0) red[(w * 17 + 16) * 32 + r] = acc[8];
        __syncthreads();
        for (int o = F.tid; o < 17 * 32; o += 512) { const int rr = o >> 5, cc = o & 31; float sm = F.b_mod[n0 + cc];
            for (int g = 0; g < 8; ++g) sm += red[(g * 17 + rr) * 32 + cc];
            mod[(size_t)rr * 6144 + n0 + cc] = sm; }
        __syncthreads();
    }
    const int gw = F.vcu * NWAVES + F.wave, NGW = F.G * NWAVES, lane = F.lane;
    constexpr int I_IN = 16 * 177, I_OUT = 32 * 32;
    bf16* win = (bf16*)(F.ws + WS_WIN); bf16* wout = (bf16*)(F.ws + WS_WOUT);
    for (int it = gw; it < I_IN + I_OUT; it += NGW) {
        const float* src; int ldw, K; bf16* dst = nullptr; unsigned char* dst8 = nullptr; const float* ksc = nullptr;
        if (it < I_IN) { const int kb = it / 177, nb = it % 177; ldw = IN_W; K = 1024; src = F.w_in + (size_t)(kb * 64) * IN_W + nb * 32; dst = win + (size_t)win_drow(nb * 32) * 1024 + kb * 64; }
        else { const int r = it - I_IN, kb = r >> 5, nb = r & 31; ldw = 1024; K = 2048; src = F.w_out + (size_t)(kb * 64) * 1024 + nb * 32; dst8 = (unsigned char*)wout + (size_t)(nb * 32) * 2048 + kb * 64; if (kb < 16) ksc = F.ssd_norm_g + kb * 64; }
        const int lo = (lane >> 3) * 8 * ldw + (lane & 7) * 4;
        f32x4 wr_[8];
#pragma unroll
        for (int e = 0; e < 8; ++e) wr_[e] = *(const f32x4*)(src + (size_t)e * ldw + lo);
        if (ksc) {
#pragma unroll
            for (int e = 0; e < 8; ++e) wr_[e] = wr_[e] * ksc[(lane >> 3) * 8 + e]; }
        if (dst8) {
            unsigned char* dl = dst8 + (size_t)((lane & 7) * 4) * K + (lane >> 3) * 8;
#pragma unroll
            for (int c = 0; c < 4; ++c) { u32x2 o; o.x = pk4_fp8(wr_[0][c] * W8_SCALE, wr_[1][c] * W8_SCALE, wr_[2][c] * W8_SCALE, wr_[3][c] * W8_SCALE);
                o.y = pk4_fp8(wr_[4][c] * W8_SCALE, wr_[5][c] * W8_SCALE, wr_[6][c] * W8_SCALE, wr_[7][c] * W8_SCALE);
                *(u32x2*)(dl + (size_t)c * K) = o; }
        } else {
            bf16* dl = dst + (size_t)((lane & 7) * 4) * K + (lane >> 3) * 8;
#pragma unroll
            for (int c = 0; c < 4; ++c) { u32x4 o; o.x = pk2(wr_[0][c], wr_[1][c]); o.y = pk2(wr_[2][c], wr_[3][c]); o.z = pk2(wr_[4][c], wr_[5][c]); o.w = pk2(wr_[6][c], wr_[7][c]);
                *(u32x4*)(dl + (size_t)c * K) = o; }
        }
    }
}

__device__ __forceinline__ void phase1(Frame& F) {
    const float* mod = (const float*)(F.ws + WS_MOD); bf16* hx = (bf16*)(F.ws + WS_HX);
    const int gw = F.vcu * NWAVES + F.wave, NGW = F.G * NWAVES, per = (TT + NGW - 1) / NGW;
    const int rbeg = gw * per, rend = (rbeg + per < TT) ? rbeg + per : TT;
    f32x4 mulv[4], shv[4]; int curb = -1;
    for (int row0 = rbeg; row0 < rend; row0 += 3) {
        f32x4 v[3][4];
#pragma unroll
        for (int u = 0; u < 3; ++u) { const int row = row0 + u; if (row < rend) { const float* src = row < TL ? F.x + (size_t)row * 1024 : F.ctx + (size_t)(row - TL) * 1024;
#pragma unroll
            for (int j = 0; j < 4; ++j) v[u][j] = *(const f32x4*)(src + 4 * F.lane + 256 * j); } }
#pragma unroll
        for (int u = 0; u < 3; ++u) { const int row = row0 + u; if (row < rend) {
            const int mb = row < TL ? (row >> 11) : 16;
            if (mb != curb) { curb = mb; const float* shift = mod + (size_t)mb * 6144, *scale = shift + 1024;
#pragma unroll
                for (int j = 0; j < 4; ++j) { const int c = 4 * F.lane + 256 * j; mulv[j] = *(const f32x4*)(F.norm1_g + c) * (*(const f32x4*)(scale + c) + 1.0f); shv[j] = *(const f32x4*)(shift + c); } }
            float s = 0.f;
#pragma unroll
            for (int j = 0; j < 4; ++j) s += (v[u][j][0] * v[u][j][0] + v[u][j][1] * v[u][j][1]) + (v[u][j][2] * v[u][j][2] + v[u][j][3] * v[u][j][3]);
            const float rs = 1.0f / sqrtf(wave_sum(s) * (1.f / 1024.f) + NORM_EPS);
#pragma unroll
            for (int j = 0; j < 4; ++j) { const int c = 4 * F.lane + 256 * j;
                const f32x4 o = v[u][j] * rs * mulv[j] + shv[j];
                u32x2 w; w.x = pk2(o[0], o[1]); w.y = pk2(o[2], o[3]);
                *(u32x2*)(hx + (size_t)row * 1024 + c) = w; } } }
    }
}

__device__ __forceinline__ void unpack8(const u32x4 w, float (&f)[8]) { f[0] = bflo(w.x); f[1] = bfhi(w.x); f[2] = bflo(w.y); f[3] = bfhi(w.y); f[4] = bflo(w.z); f[5] = bfhi(w.z); f[6] = bflo(w.w); f[7] = bfhi(w.w); }
__device__ __forceinline__ void phase_conv(Frame& F) {
    const bf16* xraw = (const bf16*)(F.ws + WS_XRAW); bf16* xbc = (bf16*)(F.ws + WS_XBC);
    if (F.tid >= 384) return;
    const int cp = F.tid % 192, rs = F.tid / 192, c0 = cp * 8;
    float w0[8], w1[8], w2[8], bb[8];
#pragma unroll
    for (int e = 0; e < 8; ++e) { w0[e] = F.conv_w[c0 + e]; w1[e] = F.conv_w[XBCW + c0 + e]; w2[e] = F.conv_w[2 * XBCW + c0 + e]; bb[e] = F.conv_b[c0 + e]; }
    for (int it = F.vcu; it < TT / 32; it += F.G) {
        const int r0 = it * 32 + rs * 16;
        const bool isctx = r0 >= TL;
        if (isctx && c0 >= 1280) continue;
        const int L = isctx ? CTXL : SEQ, t0 = isctx ? ((r0 - TL) & (CTXL - 1)) : (r0 & (SEQ - 1));
        const u32x4 zero = (u32x4){0u, 0u, 0u, 0u};
        u32x4 rw[18];
#pragma unroll
        for (int i = 0; i < 18; ++i) rw[i] = (t0 + i - 1 >= 0 && t0 + i - 1 < L) ? *(const u32x4*)(xraw + (size_t)(r0 + i - 1) * XBCW + c0) : zero;
#pragma unroll
        for (int i = 0; i < 16; ++i) {
            float a[8], b[8], c[8], o[8]; unpack8(rw[i], a); unpack8(rw[i + 1], b); unpack8(rw[i + 2], c);
#pragma unroll
            for (int e = 0; e < 8; ++e) o[e] = fsilu(w0[e] * a[e] + w1[e] * b[e] + w2[e] * c[e] + bb[e]);
            u32x4 w; w.x = pk2(o[0], o[1]); w.y = pk2(o[2], o[3]); w.z = pk2(o[4], o[5]); w.w = pk2(o[6], o[7]);
            *(u32x4*)(xbc + (size_t)(r0 + i) * XBCW + c0) = w;
        }
    }
}

namespace ssd {
constexpr int LDC = 136, LDJ = 72;
constexpr int S_CC = 0, S_BC = 17408, S_X = 34816, S_XW = 44032, S_G = 53248, S_HB = 62464, HS = 45056;
constexpr int S_SC = 124928, SCS = 2048;
__device__ __forceinline__ bf16x8 ldfrag(const LAS unsigned char* base, int row, int ld, int k) { return *(const LAS bf16x8*)(base + (size_t)(row * ld + k) * 2); }
typedef short v4i16_t __attribute__((ext_vector_type(4)));
__device__ __forceinline__ bf16x8 ldfrag_tr(const LAS unsigned char* base, int ld, int k0, int c0, int lane) {
    const int g = lane >> 4, q = (lane & 15) >> 2, p = lane & 3;
    const LAS unsigned char* a = base + (size_t)((k0 + 8 * g + q) * ld + c0 + 4 * p) * 2;
    const v4i16_t lo = __builtin_amdgcn_ds_read_tr16_b64_v4i16((LAS v4i16_t*)a);
    const v4i16_t hi = __builtin_amdgcn_ds_read_tr16_b64_v4i16((LAS v4i16_t*)(a + (size_t)4 * ld * 2));
    return __builtin_shufflevector(lo, hi, 0, 1, 2, 3, 4, 5, 6, 7);
}
}
__device__ __forceinline__ int ssd_rowbase(int b, int dir, int s) {
    return s < 4 ? TL + b * CTXL + (dir ? (3 - s) : s) * 64 : b * SEQ + (dir ? (35 - s) : (s - 4)) * 64;
}
#define SSD_LOADS(sidx) do { const int rb_ = ssd_rowbase(b, dir, (sidx)); const bool ctx_ = (sidx) < 4; \
    const char* rbp_ = (const char*)xbc + (size_t)rb_ * (XBCW * 2) + (size_t)((1024 + g * 128) * 2);        \
    _Pragma("unroll") for (int q2 = 0; q2 < 2; ++q2) { \
        bR[q2] = *(const u32x4*)(rbp_ + (bcoff + (unsigned)(q2 * 32 * XBCW * 2))); cR[q2] = ctx_ ? (u32x4){0u, 0u, 0u, 0u} : *(const u32x4*)(rbp_ + (bcoff + (unsigned)(q2 * 32 * XBCW * 2 + 512))); } \
    { const char* xp_ = (const char*)xbc + (size_t)rb_ * (XBCW * 2) + (size_t)(hA * 128); xR[0] = *(const u32x4*)(xp_ + xoff); xR[1] = *(const u32x4*)(xp_ + (xoff + 128u)); } \
    } while (0)
#define SSD_SCAN(dtj_, par_) do { const int j = dir ? (63 - lane) : lane; float v = (dtj_) * aw; \
    _Pragma("unroll") for (int o = 1; o < 64; o <<= 1) { const float t = __shfl_up(v, o); v += (lane >= o) ? t : 0.f; } \
    const float total = __shfl(v, 63); \
    scw[(par_) * 64 + j] = v; scw[128 + (par_) * 64 + j] = (dtj_); scw[256 + (par_) * 64 + j] = __expf(total - v) * (dtj_); if (lane == 0) scw[384 + (par_)] = total; } while (0)
constexpr int WC_TILES_GU = 32 * 16 * 64, WC_TILES = WC_TILES_GU + 32 * 16 * 32;
__device__ __forceinline__ void wc_tile_base(const Frame& F, int T, const float*& src, int& ldw, unsigned char*& dst) {
    if (T < WC_TILES_GU) { const int e = T >> 10, q = T & 1023, kb = q >> 6, nb = q & 63, n0 = nb * 32;
        const int drow0 = n0 < 1024 ? (n0 >> 7) * 256 + (n0 & 127) : ((n0 - 1024) >> 7) * 256 + 128 + ((n0 - 1024) & 127);
        ldw = 2048; src = F.w_gu + (size_t)e * 1024 * 2048 + (size_t)(kb * 64) * 2048 + n0;
        dst = (unsigned char*)(F.ws + WS_WGU) + (size_t)e * 2048 * 1024 + (size_t)drow0 * 1024 + kb * 64; }
    else { const int T2 = T - WC_TILES_GU, e = T2 >> 9, q = T2 & 511, kb = q >> 5, nb = q & 31, n0 = nb * 32;
        ldw = 1024; src = F.w_dn + (size_t)e * 1024 * 1024 + (size_t)(kb * 64) * 1024 + n0;
        dst = (unsigned char*)(F.ws + WS_WDN) + (size_t)e * 1024 * 1024 + (size_t)n0 * 1024 + kb * 64; }
}
#define WC_LOAD(T_) do { const float* src_; int ldw_; unsigned char* dst_; wc_tile_base(F, (T_), src_, ldw_, dst_); \
    const int lo_ = (lane >> 3) * 8 * ldw_ + (lane & 7) * 4; \
    _Pragma("unroll") for (int e = 0; e < 8; ++e) wR[e] = *(const f32x4*)((src_ + (size_t)e * ldw_) + lo_); } while (0)
#define WC_STORE(T_) do { const float* src_; int ldw_; unsigned char* dst_; wc_tile_base(F, (T_), src_, ldw_, dst_); \
    _Pragma("unroll") for (int e = 0; e < 8; ++e) asm volatile("" : "+v"(wR[e])); \
    unsigned char* dl_ = dst_ + ((lane & 7) * 4 * 1024 + (lane >> 3) * 8); \
    _Pragma("unroll") for (int c = 0; c < 4; ++c) { u32x2 o_; o_.x = pk4_fp8(wR[0][c] * W8_SCALE, wR[1][c] * W8_SCALE, wR[2][c] * W8_SCALE, wR[3][c] * W8_SCALE); \
        o_.y = pk4_fp8(wR[4][c] * W8_SCALE, wR[5][c] * W8_SCALE, wR[6][c] * W8_SCALE, wR[7][c] * W8_SCALE); \
        *(u32x2*)(dl_ + c * 1024) = o_; } } while (0)
#define WC_TILE_K(k_) __builtin_amdgcn_readfirstlane((((k_) * F.G + F.vcu) * 8 + w))
#define WC_TILE_OF(cs_) (((cs_) % 3) < 2 ? WC_TILE_K(((cs_) / 3) * 2 + (cs_) % 3) : 0x7fffffff)
__device__ __forceinline__ void phase_ssd(Frame& F) {
    using namespace ssd;
    const bf16* xbc = (const bf16*)(F.ws + WS_XBC); const float* dtb = (const float*)(F.ws + WS_DT); const bf16* szb = (const bf16*)(F.ws + WS_SZ);
    LAS unsigned char* const L0 = F.lds;
    const int tid = F.tid, lane = F.lane, w = F.wave, fr = lane & 15, fq = lane >> 4;
    LAS float* scw = (LAS float*)(L0 + S_SC + (w & 1) * SCS);
    f32x4 wR[8]; int cstep = 0;
    int Tpend = WC_TILE_OF(cstep);
    if (Tpend < WC_TILES) { WC_LOAD(Tpend); }
    for (int it = F.vcu; it < 256; it += F.G) {
        const int b = it >> 4, g = (it >> 3) & 1, hp = (it >> 1) & 3, dir = it & 1, hA = g * 8 + hp * 2;
        const float aw = -__expf(F.a_log[dir * 16 + hA + (w & 1)]);
        const int dtcolw = dir * 16 + hA + (w & 1);
        bf16* ydir = (bf16*)(F.ws + (dir ? WS_YB : WS_YF));
        f32x4 Hacc[2][4];
#pragma unroll
        for (int hd = 0; hd < 2; ++hd)
#pragma unroll
            for (int tp = 0; tp < 4; ++tp) Hacc[hd][tp] = (f32x4){0.f, 0.f, 0.f, 0.f};
        u32x4 cR[2], bR[2], xR[2];
        const unsigned bcoff = (unsigned)(((tid >> 4) * XBCW + (tid & 15) * 8) * 2), xoff = (unsigned)(((tid >> 3) * XBCW + (tid & 7) * 8) * 2);
        const float dsk0 = dir ? 0.f : F.ssd_d[hA], dsk1 = dir ? 0.f : F.ssd_d[hA + 1];
        if (w < 2) { const int j = dir ? (63 - lane) : lane; const float d0 = dtb[(size_t)(ssd_rowbase(b, dir, 0) + j) * 32 + dtcolw]; SSD_SCAN(d0, 0); }
        SSD_LOADS(0);
        __syncthreads();
        for (int s = 0; s < 36; ++s) {
            const bool isctx = s < 4; const int par = s & 1;
            const int rowbase = ssd_rowbase(b, dir, s);
            unsigned lb = 0u; asm volatile("" : "+s"(lb));
            LAS unsigned char* const L = L0 + lb;
#pragma unroll
            for (int q2 = 0; q2 < 2; ++q2) asm volatile("" : "+v"(bR[q2]), "+v"(cR[q2]));
            asm volatile("" : "+v"(xR[0]), "+v"(xR[1]));
            u32x2 zc00 = (u32x2){0u, 0u}, zc01 = zc00, zc10 = zc00, zc11 = zc00;
#pragma unroll
            for (int q2 = 0; q2 < 2; ++q2) { const int q = tid + 512 * q2, row = q >> 4, n8 = q & 15;
                *(LAS u32x4*)(L + S_BC + (size_t)(row * LDC + n8 * 8) * 2) = bR[q2];
                *(LAS u32x4*)(L + S_CC + (size_t)(row * LDC + n8 * 8) * 2) = cR[q2]; }
#pragma unroll
            for (int hd = 0; hd < 2; ++hd) { const int row = tid >> 3, p8 = tid & 7;
                *(LAS u32x4*)(L + hd * HS + S_X + (size_t)(row * LDJ + p8 * 8) * 2) = xR[hd];
                float f[8]; unpack8(xR[hd], f); const float wj = ((const LAS float*)(L + S_SC + hd * SCS))[256 + par * 64 + row];
                u32x4 o; o.x = pk2(f[0] * wj, f[1] * wj); o.y = pk2(f[2] * wj, f[3] * wj); o.z = pk2(f[4] * wj, f[5] * wj); o.w = pk2(f[6] * wj, f[7] * wj);
                *(LAS u32x4*)(L + hd * HS + S_XW + (size_t)(row * LDJ + p8 * 8) * 2) = o; }
            __syncthreads();
            if (Tpend < WC_TILES) { WC_STORE(Tpend); }
            float dnext = 0.f;
            if (s + 1 < 36) {
                if (w < 2) { const int j = dir ? (63 - lane) : lane; dnext = dtb[(size_t)(ssd_rowbase(b, dir, s + 1) + j) * 32 + dtcolw]; }
                SSD_LOADS(s + 1);
            }
            ++cstep; Tpend = WC_TILE_OF(cstep);
            if (Tpend < WC_TILES) { WC_LOAD(Tpend); }
            if (!isctx) {
                {
                    const int ti = w & 3, tj0 = w >> 2, tj1 = tj0 + 2;
                    const bool need0 = dir ? (tj0 >= ti) : (tj0 <= ti), need1 = dir ? (tj1 >= ti) : (tj1 <= ti);
                    bf16x8 cf[4], bf0[4], bf1[4];
#pragma unroll
                    for (int k = 0; k < 4; ++k) cf[k] = ldfrag(L + S_CC, 16 * ti + fr, LDC, 32 * k + 8 * fq);
                    if (need0) {
#pragma unroll
                        for (int k = 0; k < 4; ++k) bf0[k] = ldfrag(L + S_BC, 16 * tj0 + fr, LDC, 32 * k + 8 * fq); }
                    if (need1) {
#pragma unroll
                        for (int k = 0; k < 4; ++k) bf1[k] = ldfrag(L + S_BC, 16 * tj1 + fr, LDC, 32 * k + 8 * fq); }
                    f32x4 a0 = (f32x4){0.f, 0.f, 0.f, 0.f}, a1 = (f32x4){0.f, 0.f, 0.f, 0.f};
                    if (need0) {
#pragma unroll
                        for (int k = 0; k < 4; ++k) a0 = __builtin_amdgcn_mfma_f32_16x16x32_bf16(bf0[k], cf[k], a0, 0, 0, 0); }
                    if (need1) {
#pragma unroll
                        for (int k = 0; k < 4; ++k) a1 = __builtin_amdgcn_mfma_f32_16x16x32_bf16(bf1[k], cf[k], a1, 0, 0, 0); }
                    const int i = 16 * ti + fr;
#pragma unroll
                    for (int hd = 0; hd < 2; ++hd) {
                        const LAS float* sc = (const LAS float*)(L + S_SC + hd * SCS);
                        const float csi = sc[par * 64 + i];
                        const f32x4 csj0 = *(const LAS f32x4*)(sc + par * 64 + 16 * tj0 + 4 * fq), csj1 = *(const LAS f32x4*)(sc + par * 64 + 16 * tj1 + 4 * fq);
                        const f32x4 dtj0 = *(const LAS f32x4*)(sc + 128 + par * 64 + 16 * tj0 + 4 * fq), dtj1 = *(const LAS f32x4*)(sc + 128 + par * 64 + 16 * tj1 + 4 * fq);
                        float g0[4], g1[4];
#pragma unroll
                        for (int r = 0; r < 4; ++r) {
                            const int j0 = 16 * tj0 + 4 * fq + r, j1 = 16 * tj1 + 4 * fq + r;
                            const bool ok0 = dir ? (j0 >= i) : (j0 <= i), ok1 = dir ? (j1 >= i) : (j1 <= i);
                            g0[r] = ok0 ? a0[r] * __expf(csi - csj0[r]) * dtj0[r] : 0.f;
                            g1[r] = ok1 ? a1[r] * __expf(csi - csj1[r]) * dtj1[r] : 0.f; }
                        u32x2 o0, o1; o0.x = pk2(g0[0], g0[1]); o0.y = pk2(g0[2], g0[3]); o1.x = pk2(g1[0], g1[1]); o1.y = pk2(g1[2], g1[3]);
                        *(LAS u32x2*)(L + hd * HS + S_G + (size_t)(i * LDJ + 16 * tj0 + 4 * fq) * 2) = o0;
                        *(LAS u32x2*)(L + hd * HS + S_G + (size_t)(i * LDJ + 16 * tj1 + 4 * fq) * 2) = o1;
                        asm volatile("" ::: "memory");
                    }
                }
                __syncthreads();
                { const char* zp_ = (const char*)szb + (size_t)rowbase * 2048 + (size_t)(hA * 128);
                    const unsigned zoff = (unsigned)(((16 * (w & 3) + fr) * 1024 + 4 * fq + 16 * (w >> 2)) * 2);
                    zc00 = *(const u32x2*)(zp_ + zoff); zc01 = *(const u32x2*)(zp_ + (zoff + 64u)); zc10 = *(const u32x2*)(zp_ + (zoff + 128u)); zc11 = *(const u32x2*)(zp_ + (zoff + 192u)); }
            }
            if (w < 2 && s + 1 < 36) { SSD_SCAN(dnext, par ^ 1); }
            {
                bf16x8 af[2];
#pragma unroll
                for (int k = 0; k < 2; ++k) af[k] = ldfrag_tr(L + S_BC, LDC, 32 * k, 16 * w, lane);
#pragma unroll
                for (int hd = 0; hd < 2; ++hd) {
                    bf16x8 xwf[4][2];
#pragma unroll
                    for (int k = 0; k < 2; ++k)
#pragma unroll
                        for (int tp = 0; tp < 4; ++tp) xwf[tp][k] = ldfrag_tr(L + hd * HS + S_XW, LDJ, 32 * k, 16 * tp, lane);
                    const float dec = __expf(((const LAS float*)(L + S_SC + hd * SCS))[384 + par]);
#pragma unroll
                    for (int tp = 0; tp < 4; ++tp) { Hacc[hd][tp] = Hacc[hd][tp] * dec;
#pragma unroll
                        for (int k = 0; k < 2; ++k) Hacc[hd][tp] = __builtin_amdgcn_mfma_f32_16x16x32_bf16(af[k], xwf[tp][k], Hacc[hd][tp], 0, 0, 0); }
                    asm volatile("" ::: "memory");
                }
            }
            if (!isctx) {
                const int ti = w & 3, tp0 = w >> 2, tp1 = tp0 + 2;
                bf16x8 cf[4];
#pragma unroll
                for (int k = 0; k < 4; ++k) cf[k] = ldfrag(L + S_CC, 16 * ti + fr, LDC, 32 * k + 8 * fq);
                const int i = 16 * ti + fr;
#pragma unroll
                for (int hd = 0; hd < 2; ++hd) {
                    const LAS unsigned char* Lh = L + hd * HS;
                    bf16x8 gf[2], h0[4], h1[4];
#pragma unroll
                    for (int k = 0; k < 2; ++k) gf[k] = ldfrag(Lh + S_G, 16 * ti + fr, LDJ, 32 * k + 8 * fq);
#pragma unroll
                    for (int k = 0; k < 4; ++k) { h0[k] = ldfrag(Lh + S_HB, 16 * tp0 + fr, LDC, 32 * k + 8 * fq); h1[k] = ldfrag(Lh + S_HB, 16 * tp1 + fr, LDC, 32 * k + 8 * fq); }
                    const float ei = __expf(((const LAS float*)(L + S_SC + hd * SCS))[par * 64 + i]);
                    f32x4 yd0 = (f32x4){0.f, 0.f, 0.f, 0.f}, yd1 = yd0, yo0 = yd0, yo1 = yd0;
#pragma unroll
                    for (int k = 0; k < 2; ++k) { const bf16x8 xa = ldfrag_tr(Lh + S_X, LDJ, 32 * k, 16 * tp0, lane), xb = ldfrag_tr(Lh + S_X, LDJ, 32 * k, 16 * tp1, lane);
                        yd0 = __builtin_amdgcn_mfma_f32_16x16x32_bf16(xa, gf[k], yd0, 0, 0, 0); yd1 = __builtin_amdgcn_mfma_f32_16x16x32_bf16(xb, gf[k], yd1, 0, 0, 0); }
#pragma unroll
                    for (int k = 0; k < 4; ++k) { yo0 = __builtin_amdgcn_mfma_f32_16x16x32_bf16(h0[k], cf[k], yo0, 0, 0, 0); yo1 = __builtin_amdgcn_mfma_f32_16x16x32_bf16(h1[k], cf[k], yo1, 0, 0, 0); }
                    const u32x2 xq0 = *(const LAS u32x2*)(Lh + S_X + (size_t)(i * LDJ + 16 * tp0 + 4 * fq) * 2), xq1 = *(const LAS u32x2*)(Lh + S_X + (size_t)(i * LDJ + 16 * tp1 + 4 * fq) * 2);
                    const f32x4 xa = (f32x4){bflo(xq0.x), bfhi(xq0.x), bflo(xq0.y), bfhi(xq0.y)}, xb = (f32x4){bflo(xq1.x), bfhi(xq1.x), bflo(xq1.y), bfhi(xq1.y)};
                    const u32x2 zc0 = hd ? zc10 : zc00, zc1 = hd ? zc11 : zc01;
                    const float dsk = hd ? dsk1 : dsk0;
                    const f32x4 za = (f32x4){bflo(zc0.x), bfhi(zc0.x), bflo(zc0.y), bfhi(zc0.y)}, zb = (f32x4){bflo(zc1.x), bfhi(zc1.x), bflo(zc1.y), bfhi(zc1.y)};
                    const f32x4 y0 = (yd0 + yo0 * ei + xa * dsk) * za, y1 = (yd1 + yo1 * ei + xb * dsk) * zb;
                    u32x2 o0, o1; o0.x = pk2(y0[0], y0[1]); o0.y = pk2(y0[2], y0[3]); o1.x = pk2(y1[0], y1[1]); o1.y = pk2(y1[2], y1[3]);
                    char* yp = (char*)ydir + (size_t)rowbase * 2048 + (size_t)((hA + hd) * 128);
                    const unsigned yoff = (unsigned)((i * 1024 + 4 * fq + 16 * tp0) * 2);
                    *(u32x2*)(yp + yoff) = o0; *(u32x2*)(yp + (yoff + 64u)) = o1;
                    asm volatile("" ::: "memory");
                }
            }
            __syncthreads();
#pragma unroll
            for (int hd = 0; hd < 2; ++hd)
#pragma unroll
                for (int tp = 0; tp < 4; ++tp) { u32x2 o; o.x = pk2(Hacc[hd][tp][0], Hacc[hd][tp][1]); o.y = pk2(Hacc[hd][tp][2], Hacc[hd][tp][3]);
                    *(LAS u32x2*)(L + hd * HS + S_HB + (size_t)((16 * tp + fr) * LDC + 16 * w + 4 * fq) * 2) = o; }
        }
        __syncthreads();
    }
    if (Tpend < WC_TILES) { WC_STORE(Tpend); }
    for (int k = ((cstep + 1) / 3) * 2 + ((cstep + 1) % 3 < 2 ? (cstep + 1) % 3 : 2); ; ++k) { const int T = WC_TILE_K(k); if (T >= WC_TILES) break; WC_LOAD(T); WC_STORE(T); }
}

__device__ __forceinline__ void phase_combine(Frame& F) {
    const bf16* xbc = (const bf16*)(F.ws + WS_XBC); const bf16* yf = (const bf16*)(F.ws + WS_YF); const bf16* yb = (const bf16*)(F.ws + WS_YB);
    const bf16* sz = (const bf16*)(F.ws + WS_SZ); const bf16* scb = (const bf16*)(F.ws + WS_SCB); const bf16* cu = (const bf16*)(F.ws + WS_CU);
    unsigned char* a2 = (unsigned char*)(F.ws + WS_A2);
    const int g = F.wave & 1, sub = F.wave >> 1, c = g * 512 + F.lane * 8;
    const int c2 = (F.tid & 127) * 8, sub2 = F.tid >> 7;
    float k0[8], k1[8], k2[8];
#pragma unroll
    for (int e = 0; e < 8; ++e) { k0[e] = F.sc_conv_w[c2 + e]; k1[e] = F.sc_conv_w[1024 + c2 + e]; k2[e] = F.sc_conv_w[2048 + c2 + e]; }
    for (int it = F.vcu; it < TL / 64; it += F.G) {
        const int tb = it * 64;
        for (int i0 = 0; i0 < 16; i0 += 4) {
            u32x4 ra[4], rb[4];
#pragma unroll
            for (int u = 0; u < 4; ++u) { const int t = tb + sub * 16 + i0 + u; ra[u] = *(const u32x4*)(yf + (size_t)t * 1024 + c); rb[u] = *(const u32x4*)(yb + (size_t)t * 1024 + c); }
#pragma unroll
            for (int u = 0; u < 4; ++u) { const int t = tb + sub * 16 + i0 + u;
                float a[8], b2[8], v[8]; float ss = 0.f; unpack8(ra[u], a); unpack8(rb[u], b2);
#pragma unroll
                for (int e = 0; e < 8; ++e) { v[e] = a[e] + b2[e]; ss += v[e] * v[e]; }
                const float rs = 1.0f / sqrtf(wave_sum(ss) * (1.f / 512.f) + NORM_EPS);
                u32x2 o; o.x = pk4_fp8(v[0] * rs, v[1] * rs, v[2] * rs, v[3] * rs); o.y = pk4_fp8(v[4] * rs, v[5] * rs, v[6] * rs, v[7] * rs);
                *(u32x2*)(a2 + (size_t)t * 2048 + c) = o; }
        }
        for (int i0 = 0; i0 < 16; i0 += 4) {
            const u32x4 zero = (u32x4){0u, 0u, 0u, 0u};
            u32x4 rp[4], rq[4], rn[4], rs_[4];
#pragma unroll
            for (int u = 0; u < 4; ++u) { const int t = tb + sub2 * 16 + i0 + u, tt = t & (SEQ - 1);
                rp[u] = tt >= 64 ? *(const u32x4*)(cu + (size_t)(t - 64) * 1024 + c2) : zero;
                rq[u] = *(const u32x4*)(cu + (size_t)t * 1024 + c2);
                rn[u] = tt + 64 < SEQ ? *(const u32x4*)(cu + (size_t)(t + 64) * 1024 + c2) : zero;
                rs_[u] = *(const u32x4*)(scb + (size_t)t * 1024 + c2); }
#pragma unroll
            for (int u = 0; u < 4; ++u) { const int t = tb + sub2 * 16 + i0 + u;
                float p[8], q[8], n[8], sb[8], o8[8]; unpack8(rp[u], p); unpack8(rq[u], q); unpack8(rn[u], n); unpack8(rs_[u], sb);
#pragma unroll
                for (int e = 0; e < 8; ++e) o8[e] = sb[e] * (k0[e] * p[e] + k1[e] * q[e] + k2[e] * n[e]);
                u32x2 o; o.x = pk4_fp8(o8[0], o8[1], o8[2], o8[3]); o.y = pk4_fp8(o8[4], o8[5], o8[6], o8[7]);
                *(u32x2*)(a2 + (size_t)t * 2048 + 1024 + c2) = o; }
        }
    }
}

__device__ __forceinline__ void route_token(const float (&acc)[32], int tl, int lane, int myexp, float mybias, LAS int* lcnt, LAS int* tinfo) {
            float r16[16], r8[8], r4[4], r2[2], r1;
            { const bool hi = (lane & 32) != 0;
#pragma unroll
              for (int e = 0; e < 16; ++e) { const float send = hi ? acc[e] : acc[e + 16]; const float recv = __shfl_xor(send, 32); r16[e] = (hi ? acc[e + 16] : acc[e]) + recv; } }
            { const bool hi = (lane & 16) != 0;
#pragma unroll
              for (int e = 0; e < 8; ++e) { const float send = hi ? r16[e] : r16[e + 8]; const float recv = __shfl_xor(send, 16); r8[e] = (hi ? r16[e + 8] : r16[e]) + recv; } }
            { const bool hi = (lane & 8) != 0;
#pragma unroll
              for (int e = 0; e < 4; ++e) { const float send = hi ? r8[e] : r8[e + 4]; const float recv = __shfl_xor(send, 8); r4[e] = (hi ? r8[e + 4] : r8[e]) + recv; } }
            { const bool hi = (lane & 4) != 0;
#pragma unroll
              for (int e = 0; e < 2; ++e) { const float send = hi ? r4[e] : r4[e + 2]; const float recv = __shfl_xor(send, 4); r2[e] = (hi ? r4[e + 2] : r4[e]) + recv; } }
            { const bool hi = (lane & 2) != 0; const float send = hi ? r2[0] : r2[1]; const float recv = __shfl_xor(send, 2); r1 = (hi ? r2[1] : r2[0]) + recv; }
            r1 += __shfl_xor(r1, 1);
            float val = r1 + mybias;
            int sel[4]; float sv[4];
#pragma unroll
            for (int kk = 0; kk < 4; ++kk) {
                float bv = val; int bi = myexp;
#pragma unroll
                for (int o = 1; o < 64; o <<= 1) { const float ov = __shfl_xor(bv, o); const int oi = __shfl_xor(bi, o); if (ov > bv || (ov == bv && oi < bi)) { bv = ov; bi = oi; } }
                sel[kk] = bi; sv[kk] = bv; if (myexp == bi) val = -3.0e38f;
            }
            const float p1 = __expf(sv[1] - sv[0]), p2 = __expf(sv[2] - sv[0]), p3 = __expf(sv[3] - sv[0]);
            const float inv = 1.0f / (1.0f + p1 + p2 + p3);
            const float gt[4] = {inv, p1 * inv, p2 * inv, p3 * inv};
            if (lane < 4) {
                const int e = lane == 0 ? sel[0] : lane == 1 ? sel[1] : lane == 2 ? sel[2] : sel[3];
                const float gg = lane == 0 ? gt[0] : lane == 1 ? gt[1] : lane == 2 ? gt[2] : gt[3];
                const int ls = atomicAdd((int*)&lcnt[e], 1);
                tinfo[(tl * 4 + lane) * 3 + 0] = e; tinfo[(tl * 4 + lane) * 3 + 1] = ls; tinfo[(tl * 4 + lane) * 3 + 2] = __float_as_int(gg);
            }
}
__device__ __forceinline__ void phase_router(Frame& F) {
    const float* mod = (const float*)(F.ws + WS_MOD); unsigned char* h2 = (unsigned char*)(F.ws + WS_HX);
    int* rowtok = (int*)(F.ws + WS_ROWTOK); int* tokes = (int*)(F.ws + WS_TOKES); float* tokg = (float*)(F.ws + WS_TOKG);
    LAS unsigned char* L = F.lds;
    LAS f32x4* WR = (LAS f32x4*)L;
    LAS float* mulv = (LAS float*)(L + 131072);
    LAS float* shv = (LAS float*)(L + 131072 + 4096);
    LAS int* tinfo = (LAS int*)(L + 131072 + 8192);
    LAS int* lcnt = (LAS int*)(L + 131072 + 8192 + 6144);
    LAS int* lbase = lcnt + 32;
    for (int i = F.tid; i < 8192; i += 512) { const int k = i >> 3, e4 = i & 7; WR[((k >> 6) * 8 + e4) * 64 + (k & 63)] = *(const f32x4*)(F.w_router + (size_t)k * 32 + e4 * 4); }
    if (F.tid < 32) lcnt[F.tid] = 0;
    const int lane = F.lane;
    const int myexp = ((lane >> 5) & 1) * 16 + ((lane >> 4) & 1) * 8 + ((lane >> 3) & 1) * 4 + ((lane >> 2) & 1) * 2 + ((lane >> 1) & 1);
    const float mybias = F.b_router[myexp];
    for (int blk = F.vcu; blk < TL / 128; blk += F.G) {
        const int bb = (blk * 128) >> 11;
        __syncthreads();
        for (int k = F.tid; k < 1024; k += 512) { mulv[k] = F.norm2_g[k] * (1.0f + mod[(size_t)bb * 6144 + 4 * 1024 + k]); shv[k] = mod[(size_t)bb * 6144 + 3 * 1024 + k]; }
        __syncthreads();
#pragma unroll 1
        for (int i = 0; i < 16; i += 2) {
            const int tl0 = F.wave * 16 + i, tq0 = blk * 128 + tl0;
            float hv[2][16], rsv[2];
#pragma unroll
            for (int u = 0; u < 2; ++u) { const bf16* xr = (const bf16*)(F.ws + WS_X1B) + (size_t)(tq0 + u) * 1024;
#pragma unroll
                for (int jj = 0; jj < 16; ++jj) hv[u][jj] = bf2f(xr[lane + 64 * jj]); }
#pragma unroll
            for (int u = 0; u < 2; ++u) { float ss = 0.f;
#pragma unroll
                for (int jj = 0; jj < 16; ++jj) ss += hv[u][jj] * hv[u][jj];
                rsv[u] = 1.0f / sqrtf(wave_sum(ss) * (1.f / 1024.f) + NORM_EPS); }
            f32x2 acc[2][16];
#pragma unroll
            for (int u = 0; u < 2; ++u)
#pragma unroll
                for (int e = 0; e < 16; ++e) acc[u][e] = (f32x2){0.f, 0.f};
            const LAS f32x4* wlo = WR + lane; const LAS f32x4* whi = WR + 4096 + lane;
            asm volatile("" : "+v"(wlo), "+v"(whi));
#pragma unroll
            for (int jj = 0; jj < 16; ++jj) { const int k = lane + 64 * jj;
                const float mk = (mulv + lane)[64 * jj], sk = (shv + lane)[64 * jj];
                const float h0 = hv[0][jj] * rsv[0] * mk + sk, h1 = hv[1][jj] * rsv[1] * mk + sk;
                { const unsigned hb = (unsigned)__builtin_amdgcn_cvt_pk_fp8_f32(h0, h1, 0, false); h2[(size_t)tq0 * 1024 + k] = (unsigned char)(hb & 0xffu); h2[(size_t)(tq0 + 1) * 1024 + k] = (unsigned char)((hb >> 8) & 0xffu); }
                const f32x2 h0v = (f32x2){h0, h0}, h1v = (f32x2){h1, h1};
#pragma unroll
                for (int e4 = 0; e4 < 8; ++e4) { const f32x4 wq = (jj < 8 ? wlo : whi)[((jj & 7) * 8 + e4) * 64];
                    acc[0][2 * e4] += h0v * wq.xy; acc[0][2 * e4 + 1] += h0v * wq.zw; acc[1][2 * e4] += h1v * wq.xy; acc[1][2 * e4 + 1] += h1v * wq.zw; }
                asm volatile("" ::: "memory"); }
#pragma unroll 1
            for (int u = 0; u < 2; ++u) {
                float au[32];
#pragma unroll
                for (int e = 0; e < 16; ++e) { const f32x2 a2 = u ? acc[1][e] : acc[0][e]; au[2 * e] = a2[0]; au[2 * e + 1] = a2[1]; }
                route_token(au, tl0 + u, lane, myexp, mybias, lcnt, tinfo);
            }
        }
        __syncthreads();
        if (F.tid < 32) { const int n = lcnt[F.tid]; lbase[F.tid] = (int)__hip_atomic_fetch_add((unsigned*)(F.ctl + CW_ECNT + F.tid), (unsigned)n, RLX_AGENT); }
        __syncthreads();
        { const int tl = F.tid >> 2, kk = F.tid & 3, t = blk * 128 + tl;
          const int e = tinfo[(tl * 4 + kk) * 3 + 0], ls = tinfo[(tl * 4 + kk) * 3 + 1]; const float gg = __int_as_float(tinfo[(tl * 4 + kk) * 3 + 2]);
          const int slot = lbase[e] + ls;
          rowtok[(size_t)e * CAP + slot] = t; tokes[t * 4 + kk] = e * CAP + slot; tokg[t * 4 + kk] = gg; }
        __syncthreads();
        if (F.tid < 32) lcnt[F.tid] = 0;
    }
    __syncthreads();
}

__device__ __forceinline__ void build_mt_table(Frame& F) {
    __syncthreads();
    if (F.tid < 64) {
        const int lane = F.lane, e = lane & 31;
        const int c = (int)__hip_atomic_load(F.ctl + CW_ECNT + e, RLX_AGENT);
        const int mtc = (c + 255) >> 8;
        int incl = mtc;
#pragma unroll
        for (int o = 1; o < 32; o <<= 1) { const int t = __shfl_up(incl, o); incl += (lane >= o && lane < 32) ? t : 0; }
        if (lane < 32) { F.cl[LW_CNT + e] = (unsigned)c; F.cl[LW_MTS + e] = (unsigned)(incl - mtc); }
        if (lane == 31) F.cl[LW_MTS + 32] = (unsigned)incl;
    }
    __syncthreads();
}

__device__ __forceinline__ void phase_final(Frame& F) {
    const float* mod = (const float*)(F.ws + WS_MOD); const unsigned char* yrows = (const unsigned char*)(F.ws + WS_YROWS);
    const int* tokes = (const int*)(F.ws + WS_TOKES); const float* tokg = (const float*)(F.ws + WS_TOKG);
    const int gw = F.vcu * NWAVES + F.wave, NGW = F.G * NWAVES, lane = F.lane;
    const bf16* x1b = (const bf16*)(F.ws + WS_X1B);
    constexpr int FT = 4;
    for (int t0 = gw; t0 < TL; t0 += FT * NGW) {
        u32x2 yr[FT][4][2]; u32x4 xr[FT][2]; float gk[FT][4];
#pragma unroll
        for (int u = 0; u < FT; ++u) { const int t = t0 + u * NGW; if (t < TL) {
#pragma unroll
            for (int kk = 0; kk < 4; ++kk) { const int es = tokes[t * 4 + kk]; gk[u][kk] = tokg[t * 4 + kk];
                const int e = es >> 15, slot = es & (CAP - 1);
                const size_t pos = (size_t)F.cl[LW_MTS + e] * 256 + slot;
                yr[u][kk][0] = *(const u32x2*)(yrows + pos * 1024 + lane * 8); yr[u][kk][1] = *(const u32x2*)(yrows + pos * 1024 + 512 + lane * 8); }
            xr[u][0] = *(const u32x4*)(x1b + (size_t)t * 1024 + lane * 8); xr[u][1] = *(const u32x4*)(x1b + (size_t)t * 1024 + 512 + lane * 8); } }
#pragma unroll
        for (int u = 0; u < FT; ++u) { const int t = t0 + u * NGW; if (t < TL) {
            const int b = t >> 11;
            float m[16];
#pragma unroll
            for (int e = 0; e < 16; ++e) m[e] = 0.f;
#pragma unroll
            for (int kk = 0; kk < 4; ++kk) { float y0[8], y1[8]; unpack8_fp8(yr[u][kk][0], y0); unpack8_fp8(yr[u][kk][1], y1);
#pragma unroll
                for (int q = 0; q < 8; ++q) { m[q] += gk[u][kk] * y0[q]; m[8 + q] += gk[u][kk] * y1[q]; } }
            float x2[16]; float ss = 0.f;
#pragma unroll
            for (int hf = 0; hf < 2; ++hf) { const int c = hf * 512 + lane * 8;
                float xv[8]; unpack8(xr[u][hf], xv);
                const f32x4 g0 = *(const f32x4*)(mod + (size_t)b * 6144 + 5 * 1024 + c), g1 = *(const f32x4*)(mod + (size_t)b * 6144 + 5 * 1024 + c + 4);
#pragma unroll
                for (int j = 0; j < 4; ++j) { const float v0 = xv[j] + g0[j] * m[hf * 8 + j], v1 = xv[4 + j] + g1[j] * m[hf * 8 + 4 + j];
                    x2[hf * 8 + j] = v0; x2[hf * 8 + 4 + j] = v1; ss += v0 * v0 + v1 * v1; } }
            const float rs = 1.0f / sqrtf(wave_sum(ss) * (1.f / 1024.f) + NORM_EPS);
#pragma unroll
            for (int hf = 0; hf < 2; ++hf)
#pragma unroll
                for (int q4 = 0; q4 < 2; ++q4) { const int c = hf * 512 + lane * 8 + q4 * 4;
                    const f32x4 fg = *(const f32x4*)(F.final_g + c); f32x4 o;
#pragma unroll
                    for (int j = 0; j < 4; ++j) o[j] = x2[hf * 8 + q4 * 4 + j] * rs * fg[j];
                    *(f32x4*)(F.out + (size_t)t * 1024 + c) = o; } } }
    }
}

constexpr int NPHASE = 11;
__global__ void __launch_bounds__(NWAVES * 64, 2) mk_fwd(Args args) {
    extern __shared__ __attribute__((aligned(16))) unsigned char lds_raw[];
    Frame F;
    F.lds = (LAS unsigned char*)lds_raw;
    F.cl = (volatile LAS unsigned*)(F.lds + CTLDS_OFF);
    F.tid = threadIdx.x; F.lane = F.tid & 63; F.wave = __builtin_amdgcn_readfirstlane(F.tid >> 6);
    F.G = gridDim.x; { const int bx = blockIdx.x; F.vcu = (F.G % 8 == 0) ? (bx % 8) * (F.G / 8) + bx / 8 : bx; }
    F.ws = args.ws; F.ctl = (gu32*)(args.ws + WS_CTL); F.out = args.out;
    F.x = args.in[0]; F.c = args.in[1]; F.ctx = args.in[2]; F.c_ctx = args.in[3]; F.w_mod = args.in[4]; F.b_mod = args.in[5]; F.norm1_g = args.in[6]; F.w_in = args.in[7];
    F.conv_w = args.in[8]; F.conv_b = args.in[9]; F.dt_bias = args.in[10]; F.a_log = args.in[11]; F.ssd_d = args.in[12]; F.ssd_norm_g = args.in[13]; F.sc_conv_w = args.in[14];
    F.w_out = args.in[15]; F.norm2_g = args.in[16]; F.w_router = args.in[17]; F.b_router = args.in[18]; F.w_gu = args.in[19]; F.b_gu = args.in[20]; F.w_dn = args.in[21]; F.b_dn = args.in[22]; F.final_g = args.in[23];
    for (int u = F.tid; u < (LDS_BYTES - CTLDS_OFF) / 4; u += NWAVES * 64) ((LAS unsigned*)(F.lds + CTLDS_OFF))[u] = 0u;
    __syncthreads();
    const int lo = args.ph_lo, hi = args.ph_hi;
    XcdBarrier bar; bar.bar = (unsigned*)(F.ctl + CW_BAR); bar.x = 0; bar.st = nullptr;
    if (hi - lo > 1) bar = xcd_barrier_post((unsigned*)(F.ctl + CW_BAR), F.cl + LW_BARST);
#define IN(k) (lo <= (k) && (k) < hi)
#define SEAM(k) do { if (IN(k) && IN((k) + 1)) xcd_barrier(bar); } while (0)

#define RUNPH(k, body) do { if (IN(k)) { body; if ((PROBE_DOUBLE >> (k)) & 1) { xcd_barrier(bar); body; } SEAM(k); } } while (0)
    RUNPH(0, phase0(F));
    RUNPH(1, phase1(F));
#define BODY2 { SchedIn S{F.G, F.vcu, 1024, (const bf16*)(F.ws + WS_WIN)}; \
        EpiIn E{(bf16*)(F.ws + WS_XRAW), (float*)(F.ws + WS_DT), (bf16*)(F.ws + WS_SZ), (bf16*)(F.ws + WS_SCB), (bf16*)(F.ws + WS_CU), F.dt_bias}; \
        pg8::gemm_phase<EpiIn, SchedIn>(F.lds, (const bf16*)(F.ws + WS_HX), 1024, S, E); }
    RUNPH(2, BODY2);
    RUNPH(3, phase_conv(F));
    RUNPH(4, phase_ssd(F));
    RUNPH(5, phase_combine(F));
#define BODY6 { SchedPlain S{F.G, F.vcu, 2048, 4, 512, (const bf16*)(F.ws + WS_WOUT)}; \
        EpiOut E{F.x, (bf16*)(F.ws + WS_X1B), (const float*)(F.ws + WS_MOD)}; \
        pg8::gemm_phase<EpiOut, SchedPlain>(F.lds, (const bf16*)(F.ws + WS_A2), 2048, S, E); }
    RUNPH(6, BODY6);
    if (IN(7)) { phase_router(F); SEAM(7); }
#define BODY8 { build_mt_table(F); \
        SchedMoe<true> S{F.G, F.vcu, 1024, 8, (const bf16*)(F.ws + WS_WGU), F.cl, (const int*)(F.ws + WS_ROWTOK), (const LAS unsigned short*)(F.lds + LDS_IDX_OFF)}; \
        preload_row_indices(F, S); \
        EpiGU E{(unsigned char*)(F.ws + WS_ACT), F.b_gu}; \
        pg8::gemm_phase<EpiGU, SchedMoe<true>>(F.lds, (const bf16*)(F.ws + WS_HX), 1024, S, E); }
    RUNPH(8, BODY8);
#define BODY9 { build_mt_table(F); \
        SchedMoe<false> S{F.G, F.vcu, 1024, 4, (const bf16*)(F.ws + WS_WDN), F.cl, nullptr, nullptr}; \
        EpiDown E{(unsigned char*)(F.ws + WS_YROWS), F.b_dn}; \
        pg8::gemm_phase<EpiDown, SchedMoe<false>>(F.lds, (const bf16*)(F.ws + WS_ACT), 1024, S, E); }
    RUNPH(9, BODY9);
    if (IN(10)) { build_mt_table(F); phase_final(F); }
#undef IN
#undef SEAM
}

extern "C" void kernel_launch(void* const* d_in, const int* in_sizes, int n_in, void* d_out, int out_size, void* d_ws, size_t ws_size, hipStream_t stream) {
    static int grid = 0;
    if (grid == 0) {
        if (n_in != 24 || out_size != TL * D || ws_size < WS_END) { fprintf(stderr, "kernel_launch: unexpected shapes (n_in %d out %d ws %zu); nothing launched\n", n_in, out_size, ws_size); grid = -1; return; }
        int dev = 0, cus = 0;
        if (hipGetDevice(&dev) != hipSuccess || hipDeviceGetAttribute(&cus, hipDeviceAttributeMultiprocessorCount, dev) != hipSuccess) { grid = -1; return; }
        if (hipFuncSetAttribute((const void*)mk_fwd, hipFuncAttributeMaxDynamicSharedMemorySize, LDS_BYTES) != hipSuccess) { fprintf(stderr, "kernel_launch: hipFuncSetAttribute failed\n"); grid = -1; return; }
        int per_cu = 0;
        if (hipOccupancyMaxActiveBlocksPerMultiprocessor(&per_cu, (const void*)mk_fwd, NWAVES * 64, LDS_BYTES) != hipSuccess || per_cu < 1) fprintf(stderr, "kernel_launch: occupancy query says %d\n", per_cu);
        (void)hipGetLastError();
        grid = cus;
    }
    if (grid < 0) return;
    (void)hipMemsetAsync((char*)d_ws + WS_CTL, 0, CTL_ZERO_BYTES, stream);
    Args a{};
    for (int i = 0; i < 24; ++i) a.in[i] = (const float*)d_in[i];
    a.out = (float*)d_out; a.ws = (unsigned char*)d_ws;
#if MK_ONE_LAUNCH
    a.ph_lo = 0; a.ph_hi = NPHASE;
    hipLaunchKernelGGL(mk_fwd, dim3(grid), dim3(NWAVES * 64), LDS_BYTES, stream, a);
#else
    for (int p = 0; p < NPHASE; ++p) { a.ph_lo = p; a.ph_hi = p + 1; hipLaunchKernelGGL(mk_fwd, dim3(grid), dim3(NWAVES * 64), LDS_BYTES, stream, a); }
#endif
}
```

```cpp
#include <hip/hip_runtime.h>
#include <cstdio>
#include <cstdint>

#ifndef MK_ONE_LAUNCH
#define MK_ONE_LAUNCH 1
#endif
#ifndef PROBE_DOUBLE
#define PROBE_DOUBLE 0
#endif
#ifndef PROBE_EPI2
#define PROBE_EPI2 0
#endif
#ifndef PROBE_KREP
#define PROBE_KREP 1
#endif
#ifndef GEMM_ALIGN_EPI
#define GEMM_ALIGN_EPI 1
#endif
#ifndef GEMM_STAGGER_TICKS
#define GEMM_STAGGER_TICKS 0
#endif

#define LAS __attribute__((address_space(3)))
#define GAS __attribute__((address_space(1)))
typedef unsigned short bf16;
typedef short bf16x8 __attribute__((ext_vector_type(8)));
typedef float f32x4 __attribute__((ext_vector_type(4)));
typedef float f32x2 __attribute__((ext_vector_type(2)));
typedef unsigned u32x4 __attribute__((ext_vector_type(4)));
typedef unsigned u32x2 __attribute__((ext_vector_type(2)));
typedef int i32x4 __attribute__((ext_vector_type(4)));
typedef int i32x8 __attribute__((ext_vector_type(8)));
typedef GAS unsigned gu32;

constexpr int D = 1024, NB = 16, SEQ = 2048, CTXL = 256;
constexpr int TL = NB * SEQ;
constexpr int TC = NB * CTXL;
constexpr int TT = TL + TC;
constexpr int IN_W = 5664, X0 = 1024, B0 = 2048, C0 = 2304, DT0 = 2560, SC0 = 2592;
constexpr int NE = 32, TOPK = 4, DFF = 1024;
constexpr int XBCW = 1536;
constexpr int NT_IN = 23;
constexpr int CAP = TL;
constexpr int ACT_ROWS = TL * TOPK + NE * 256;
constexpr float NORM_EPS = 1e-6f;

constexpr size_t MiB = 1u << 20;
constexpr size_t WS_CTL = 0, CTL_ZERO_BYTES = 1 * MiB;
constexpr size_t WS_MOD = 1 * MiB;
constexpr size_t WS_TOKES = 2 * MiB;
constexpr size_t WS_TOKG = 2 * MiB + 512 * 1024;
constexpr size_t WS_ROWTOK = 3 * MiB;
constexpr size_t WS_WIN = 7 * MiB;
constexpr size_t WS_WOUT = 19 * MiB;
constexpr size_t WS_WGU = 23 * MiB;
constexpr size_t WS_WDN = 151 * MiB;
constexpr size_t WS_HX = 215 * MiB;
constexpr size_t WS_XRAW = 287 * MiB;
constexpr size_t WS_XBC = 395 * MiB;
constexpr size_t WS_DT = 503 * MiB;
constexpr size_t WS_SZ = 508 * MiB;
constexpr size_t WS_SCB = 572 * MiB;
constexpr size_t WS_CU = 636 * MiB;
constexpr size_t WS_YF = 700 * MiB;
constexpr size_t WS_YB = 764 * MiB;
constexpr size_t WS_A2 = 828 * MiB;
constexpr size_t WS_ACT = 287 * MiB;
constexpr size_t WS_YROWS = 572 * MiB;
constexpr size_t WS_X1B = 956 * MiB;
constexpr size_t WS_END = 1020 * MiB;
constexpr int CW_ECNT = 64;
constexpr int CW_BAR = 4096;

constexpr int LDS_BYTES = 147456;
constexpr int CTLDS_OFF = 146432;
constexpr int LW_BARST = 0;
constexpr int LDS_IDX_OFF = 131072, MOE_LIDX_UNITS = 30;
constexpr int LW_MTS = 16;
constexpr int LW_CNT = 64;

constexpr int NWAVES = 8;

#define LDS_WAIT() asm volatile("s_waitcnt lgkmcnt(0)" ::: "memory")
#define VM_WAIT() asm volatile("s_waitcnt vmcnt(0)" ::: "memory")
#define RLX_AGENT __ATOMIC_RELAXED, __HIP_MEMORY_SCOPE_AGENT

__device__ __forceinline__ unsigned f2bf(float f) { unsigned u = __builtin_bit_cast(unsigned, f); return (u + 0x7fffu + ((u >> 16) & 1u)) >> 16; }
typedef __bf16 hwbf16x2 __attribute__((ext_vector_type(2)));
__device__ __forceinline__ unsigned pk2(float lo, float hi) { const f32x2 v = {lo, hi}; const hwbf16x2 b = __builtin_convertvector(v, hwbf16x2); return __builtin_bit_cast(unsigned, b); }
__device__ __forceinline__ unsigned pk4_fp8(float a, float b, float c, float d) { int v = __builtin_amdgcn_cvt_pk_fp8_f32(a, b, 0, false); v = __builtin_amdgcn_cvt_pk_fp8_f32(c, d, v, true); return (unsigned)v; }
__device__ __forceinline__ void unpack8_fp8(const u32x2 w, float (&f)[8]) {
    const f32x2 a = __builtin_amdgcn_cvt_pk_f32_fp8((int)w.x, false), b = __builtin_amdgcn_cvt_pk_f32_fp8((int)w.x, true), c = __builtin_amdgcn_cvt_pk_f32_fp8((int)w.y, false), d = __builtin_amdgcn_cvt_pk_f32_fp8((int)w.y, true);
    f[0] = a[0]; f[1] = a[1]; f[2] = b[0]; f[3] = b[1]; f[4] = c[0]; f[5] = c[1]; f[6] = d[0]; f[7] = d[1]; }
constexpr float W8_SCALE = 64.0f, W8_INV = 1.0f / 64.0f;
__device__ __forceinline__ float bf2f(unsigned b) { return __builtin_bit_cast(float, b << 16); }
__device__ __forceinline__ float bflo(unsigned w) { return __builtin_bit_cast(float, w << 16); }
__device__ __forceinline__ float bfhi(unsigned w) { return __builtin_bit_cast(float, w & 0xffff0000u); }
__device__ __forceinline__ float fsilu(float x) { return x * __builtin_amdgcn_rcpf(1.0f + __expf(-x)); }
__device__ __forceinline__ float wave_sum(float v) {
#pragma unroll
    for (int o = 1; o < 64; o <<= 1) v += __shfl_xor(v, o);
    return v;
}

#define XB_TMO      128
#define XB_XCNT(j)  (256  + 64 * (j))
#define XB_XSUB(j)  (1280 + 64 * (j))
#define XB_XGEN(j)  (2304 + 64 * (j))
#define XB_TOP      3328
#define XB_TOPGEN   3392
#define XCD_BAR_WORDS 3456
#define XB_SPIN_CAP (1u << 18)
__device__ __forceinline__ unsigned xb_ld(unsigned* p)              { return __hip_atomic_load(p, __ATOMIC_RELAXED, __HIP_MEMORY_SCOPE_AGENT); }
__device__ __forceinline__ unsigned xb_add(unsigned* p, unsigned v) { return __hip_atomic_fetch_add(p, v, __ATOMIC_RELAXED, __HIP_MEMORY_SCOPE_AGENT); }
__device__ __forceinline__ unsigned xb_xcc_id() { return (unsigned)__builtin_amdgcn_s_getreg((3 << 11) | 20) & 0xFu; }
#define XB_SPIN(cond, bar) do { unsigned _sp = 0; while (cond) { __builtin_amdgcn_s_sleep(1); \
    if ((++_sp & 255u) == 0u) { if (xb_ld(&(bar)[XB_TMO])) break; if (_sp > XB_SPIN_CAP) { atomicAdd(&(bar)[XB_TMO], 1u); break; } } } } while (0)
struct XcdBarrier { unsigned* bar; unsigned x; volatile LAS unsigned* st; };
__device__ __forceinline__ XcdBarrier xcd_barrier_post(unsigned* bar, volatile LAS unsigned* st) {
    XcdBarrier b; b.bar = bar; b.x = xb_xcc_id(); b.st = st;
    if (threadIdx.x == 0) (void)xb_add(&bar[XB_XCNT(b.x)], 1u);
    return b;
}
__device__ __forceinline__ void xcd_barrier_complete(unsigned* bar, unsigned x, unsigned& nloc, unsigned& nx) {
    const unsigned G = gridDim.x * gridDim.y * gridDim.z;
    unsigned sum, cnt, mine, sp = 0u;
    for (;;) {
        sum = 0u; cnt = 0u; mine = 0u;
#pragma unroll
        for (unsigned j = 0; j < 16; ++j) { const unsigned c = xb_ld(&bar[XB_XCNT(j)]); sum += c; cnt += (c > 0u) ? 1u : 0u; mine = (j == x) ? c : mine; }
        if (sum == G) break;
        __builtin_amdgcn_s_sleep(1);
        if ((++sp & 255u) == 0u) { if (xb_ld(&bar[XB_TMO])) break; if (sp > XB_SPIN_CAP) { atomicAdd(&bar[XB_TMO], 1u); break; } }
    }
    nloc = mine > 0u ? mine : 1u; nx = cnt > 0u ? cnt : 1u;
}
__device__ __forceinline__ void xcd_barrier(const XcdBarrier& b) {
    asm volatile("s_waitcnt vmcnt(0)" ::: "memory");
    __syncthreads();
    if (threadIdx.x == 0) {
        unsigned* bar = b.bar;
        __builtin_amdgcn_s_waitcnt(0);
        unsigned nloc = b.st[0], nx = b.st[1];
        if (nloc == 0u) { xcd_barrier_complete(bar, b.x, nloc, nx); b.st[0] = nloc; b.st[1] = nx; }
        const unsigned old = xb_add(&bar[XB_XSUB(b.x)], 1u);
        const unsigned gen = old / nloc;
        if (old + 1u == (gen + 1u) * nloc) {
            __builtin_amdgcn_fence(__ATOMIC_RELEASE, "agent");
            asm volatile("s_waitcnt vmcnt(0)" ::: "memory");
            const unsigned og = xb_add(&bar[XB_TOP], 1u);
            const unsigned tg = og / nx;
            if (og + 1u == (tg + 1u) * nx) xb_add(&bar[XB_TOPGEN], 1u);
            else XB_SPIN(xb_ld(&bar[XB_TOPGEN]) == tg, bar);
            __builtin_amdgcn_fence(__ATOMIC_ACQUIRE, "agent");
            xb_add(&bar[XB_XGEN(b.x)], 1u);
            asm volatile("s_waitcnt vmcnt(0)" ::: "memory");
        } else {
            XB_SPIN(xb_ld(&bar[XB_XGEN(b.x)]) == gen, bar);
            __builtin_amdgcn_fence(__ATOMIC_ACQUIRE, "agent");
            asm volatile("s_waitcnt vmcnt(0)" ::: "memory");
        }
    }
    __syncthreads();
}

struct Args { const float* in[24]; float* out; unsigned char* ws; int ph_lo, ph_hi; };
struct Frame {
    LAS unsigned char* lds;
    volatile LAS unsigned* cl;
    unsigned char* ws;
    gu32* ctl;
    int tid, lane, wave, vcu, G;
    const float *x, *c, *ctx, *c_ctx, *w_mod, *b_mod, *norm1_g, *w_in, *conv_w, *conv_b, *dt_bias, *a_log, *ssd_d, *ssd_norm_g, *sc_conv_w, *w_out, *norm2_g, *w_router, *b_router, *w_gu, *b_gu, *w_dn, *b_dn, *final_g;
    float* out;
};

namespace pg8 {
constexpr int BM = 256, BK = 64, HALF = 128, HTB = HALF * BK * 2, STAGE_BYTES = 8 * HTB;
__device__ __forceinline__ int lds_byte(int r, int c) { const int st = (r >> 4) * 2 + (c >> 5), rr = r & 15, cc = c & 31, ob = rr * 64 + cc * 2; return st * 1024 + (ob ^ (((ob >> 9) & 1) << 5)); }
__device__ __forceinline__ void stage_rc(int b, int& R, int& C) { const int st = b / 1024, sb = b % 1024, swz = sb ^ (((sb >> 9) & 1) << 5); R = (st >> 1) * 16 + swz / 64; C = (st & 1) * 32 + (swz % 64) / 2; }
__device__ __forceinline__ int perm32(int rho) { const int n = rho >> 4, i = rho & 15; return 8 * (i >> 2) + 4 * n + (i & 3); }
__device__ __forceinline__ i32x8 cat8(bf16x8 a, bf16x8 b) { const i32x4 x = __builtin_bit_cast(i32x4, a), y = __builtin_bit_cast(i32x4, b); return __builtin_shufflevector(x, y, 0, 1, 2, 3, 4, 5, 6, 7); }
__device__ __forceinline__ unsigned cvt_pk_bf16(float lo, float hi) { unsigned r; asm volatile("v_cvt_pk_bf16_f32 %0, %1, %2" : "=v"(r) : "v"(lo), "v"(hi)); return r; }

struct Unit { int pm, pn, e, idx, q; };

template <class Epi, class Sched>
__device__ __forceinline__ void gemm_phase(LAS unsigned char* lds, const bf16* Aptr, const int K, const Sched& S, const Epi& E) {
    const int tid = threadIdx.x, wid = __builtin_amdgcn_readfirstlane(tid >> 6), lane = tid & 63, wr = wid >> 2, wc = wid & 3, fr = lane & 15, fq = lane >> 4;
    constexpr bool F8 = Epi::F8;
    const int nt = F8 ? K / 128 : K / BK;
    unsigned voffB[2];
#pragma unroll
    for (int i = 0; i < 2; ++i) { int R, C; stage_rc(tid * 16 + i * 8192, R, C); const int Rb = Epi::PERM ? ((R & ~31) + perm32(R & 31)) : R;
        voffB[i] = F8 ? (unsigned)(Rb * K + C * 2) : (unsigned)(Rb * K + C) * 2u; }
    const size_t kstep = (size_t)(BK * 2);
    const size_t hstep = (size_t)HALF * K * (F8 ? 1 : 2);
    const unsigned ldsw = (unsigned)wid * 1024u;
    const int aoff = lds_byte(wr * 64 + fr, fq * 8), boff = lds_byte(wc * 32 + fr, fq * 8);
    const char* const Abase = (const char*)Aptr;
#define PG8_SA(b, h) (((b) * 2 + (h)) * HTB)
#define PG8_SB(b, h) ((4 + (b) * 2 + (h)) * HTB)
#define PG8_STAGE(bufoff, gbase, voff) do { _Pragma("unroll") for (int _i = 0; _i < 2; ++_i) \
        __builtin_amdgcn_global_load_lds((const unsigned*)((const char*)(gbase) + (voff)[_i]), (LAS unsigned*)(lds + (bufoff) + ldsw + _i * 8192), 16, 0, 0); } while (0)
#define PG8_LDA(dst, b, h) do { _Pragma("unroll") for (int m = 0; m < 4; ++m) _Pragma("unroll") for (int k = 0; k < 2; ++k) dst[m][k] = *(const LAS bf16x8*)(lds + PG8_SA(b, h) + aoff + m * 2048 + k * 1024); } while (0)
#define PG8_LDB(dst, b, h) do { _Pragma("unroll") for (int n = 0; n < 2; ++n) _Pragma("unroll") for (int k = 0; k < 2; ++k) dst[n][k] = *(const LAS bf16x8*)(lds + PG8_SB(b, h) + boff + n * 2048 + k * 1024); } while (0)
#define PG8_MMA(ai, bj, At, Bt) do { __builtin_amdgcn_s_setprio(1); \
        if constexpr (F8) { _Pragma("unroll") for (int m = 0; m < 4; ++m) _Pragma("unroll") for (int n = 0; n < 2; ++n) \
            acc[ai][bj][m][n] = __builtin_amdgcn_mfma_scale_f32_16x16x128_f8f6f4(cat8(Bt[n][0], Bt[n][1]), cat8(At[m][0], At[m][1]), acc[ai][bj][m][n], 0, 0, 0, 0x7f7f7f7f, 0, 0x7f7f7f7f); } \
        else { _Pragma("unroll") for (int m = 0; m < 4; ++m) _Pragma("unroll") for (int n = 0; n < 2; ++n) _Pragma("unroll") for (int k = 0; k < 2; ++k) \
            acc[ai][bj][m][n] = __builtin_amdgcn_mfma_f32_16x16x32_bf16(Bt[n][k], At[m][k], acc[ai][bj][m][n], 0, 0, 0); } \
        __builtin_amdgcn_s_setprio(0); } while (0)
#define PG8_WAIT_V(n) asm volatile("s_waitcnt vmcnt(" #n ")" ::: "memory")
#define PG8_WAIT_L(n) asm volatile("s_waitcnt lgkmcnt(" #n ")" ::: "memory")
#define PG8_BAR __builtin_amdgcn_s_barrier()
#define PG8_SCHED __builtin_amdgcn_sched_barrier(0)
    Unit cur, nxt; int ui = 0;
    if (!S.next(0, cur)) return;
#if GEMM_STAGGER_TICKS > 0
    if (S.v & 1) { const unsigned long long t0 = __builtin_amdgcn_s_memrealtime(); while (__builtin_amdgcn_s_memrealtime() - t0 < (unsigned long long)GEMM_STAGGER_TICKS) __builtin_amdgcn_s_sleep(8); }
#endif
    f32x4 acc[2][2][4][2];
#pragma unroll
    for (int a = 0; a < 2; ++a)
#pragma unroll
        for (int b = 0; b < 2; ++b)
#pragma unroll
            for (int m = 0; m < 4; ++m)
#pragma unroll
                for (int n = 0; n < 2; ++n) acc[a][b][m][n] = (f32x4){0.f, 0.f, 0.f, 0.f};
    bf16x8 At[4][2], B0[2][2], B1[2][2];
    unsigned va0[2], va1[2];
    { int sR[2], sC[2];
#pragma unroll
      for (int i = 0; i < 2; ++i) stage_rc(tid * 16 + i * 8192, sR[i], sC[i]);
      S.aoff(cur, sR, sC, va0, va1); }
    const char* cB = S.bbase(cur);
    PG8_STAGE(PG8_SB(0, 0), cB, voffB); PG8_STAGE(PG8_SB(0, 1), cB + hstep, voffB); PG8_STAGE(PG8_SA(0, 0), Abase, va0); PG8_STAGE(PG8_SA(0, 1), Abase, va1);
    if (wr == 1) PG8_BAR;
    PG8_WAIT_V(2); PG8_BAR;
    PG8_STAGE(PG8_SB(1, 0), cB + kstep, voffB); PG8_STAGE(PG8_SA(1, 0), Abase + kstep, va0); PG8_STAGE(PG8_SB(1, 1), cB + hstep + kstep, voffB);
    PG8_WAIT_V(6); PG8_BAR;
    for (;;) {
        nxt = cur;
        const bool has_next = S.next(ui + 1, nxt);
        const char* nB = has_next ? S.bbase(nxt) : cB;
#pragma unroll 1
        for (int t = 0; t < nt * PROBE_KREP; t += 2) {
            const bool last = (t == nt * PROBE_KREP - 2);
            const char* a1 = Abase + (size_t)((t + 1) % nt) * kstep;
            const char* a2 = last ? Abase : Abase + (size_t)((t + 2) % nt) * kstep; const char* b2 = last ? nB : cB + (size_t)((t + 2) % nt) * kstep;
            const char* a3 = a2 + kstep; const char* b3 = b2 + kstep;
            unsigned nva0[2], nva1[2];
            nva0[0] = va0[0]; nva0[1] = va0[1]; nva1[0] = va1[0]; nva1[1] = va1[1];
            if (last && has_next) {
                int tq = tid; asm volatile("" : "+v"(tq));
                int sR[2], sC[2];
#pragma unroll
                for (int i = 0; i < 2; ++i) stage_rc(tq * 16 + i * 8192, sR[i], sC[i]);
                S.aoff(nxt, sR, sC, nva0, nva1);
            }
            PG8_LDB(B0, 0, 0); PG8_LDB(B1, 0, 1); PG8_SCHED; PG8_LDA(At, 0, 0); PG8_STAGE(PG8_SA(1, 1), a1, va1);
            if constexpr (Epi::NSTORES == 16) { if (t == 0 && ui > 0) PG8_WAIT_V(24); else PG8_WAIT_V(8); }
            else if constexpr (Epi::NSTORES == 8) { if (t == 0 && ui > 0) PG8_WAIT_V(16); else PG8_WAIT_V(8); }
            else PG8_WAIT_V(8);
            PG8_WAIT_L(0); PG8_BAR; if (cur.q & 1) PG8_MMA(0, 0, At, B0); if (cur.q & 2) PG8_MMA(0, 1, At, B1); PG8_BAR; PG8_SCHED;
            if (last) { va0[0] = nva0[0]; va0[1] = nva0[1]; va1[0] = nva1[0]; va1[1] = nva1[1]; }
            PG8_LDA(At, 0, 1); PG8_STAGE(PG8_SB(0, 0), b2, voffB); PG8_STAGE(PG8_SB(0, 1), b2 + hstep, voffB); PG8_STAGE(PG8_SA(0, 0), a2, va0);
            if constexpr (Epi::NSTORES == 16) { if (t == 0 && ui > 0) PG8_WAIT_V(24); else PG8_WAIT_V(8); }
            else if constexpr (Epi::NSTORES == 8) { if (t == 0 && ui > 0) PG8_WAIT_V(16); else PG8_WAIT_V(8); }
            else PG8_WAIT_V(8);
            PG8_WAIT_L(0); PG8_BAR; if (cur.q & 4) PG8_MMA(1, 0, At, B0); if (cur.q & 8) PG8_MMA(1, 1, At, B1); PG8_BAR; PG8_SCHED;
            PG8_LDB(B0, 1, 0); PG8_LDB(B1, 1, 1); PG8_SCHED; PG8_LDA(At, 1, 0); PG8_STAGE(PG8_SA(0, 1), a2, va1);
            PG8_WAIT_V(8); PG8_WAIT_L(0); PG8_BAR; if (cur.q & 1) PG8_MMA(0, 0, At, B0); if (cur.q & 2) PG8_MMA(0, 1, At, B1); PG8_BAR; PG8_SCHED;
            PG8_LDA(At, 1, 1); PG8_STAGE(PG8_SB(1, 0), b3, voffB); PG8_STAGE(PG8_SB(1, 1), b3 + hstep, voffB); PG8_STAGE(PG8_SA(1, 0), a3, va0);
            PG8_WAIT_V(8); PG8_WAIT_L(0); PG8_BAR; if (cur.q & 4) PG8_MMA(1, 0, At, B0); if (cur.q & 8) PG8_MMA(1, 1, At, B1); PG8_BAR; PG8_SCHED;
        }
#if GEMM_ALIGN_EPI
        if (wr == 0) PG8_BAR;
#endif
#if PROBE_KREP > 1
#pragma unroll
        for (int a = 0; a < 2; ++a)
#pragma unroll
            for (int b = 0; b < 2; ++b)
#pragma unroll
                for (int m = 0; m < 4; ++m)
#pragma unroll
                    for (int n = 0; n < 2; ++n) acc[a][b][m][n] = acc[a][b][m][n] * (1.0f / PROBE_KREP);
#endif
        { int tq = tid; asm volatile("" : "+v"(tq));
          (void)E(acc, cur, wr, wc, tq & 15, (tq & 63) >> 4); }
        if (!has_next) break;
#pragma unroll
        for (int a = 0; a < 2; ++a)
#pragma unroll
            for (int b = 0; b < 2; ++b)
#pragma unroll
                for (int m = 0; m < 4; ++m)
#pragma unroll
                    for (int n = 0; n < 2; ++n) acc[a][b][m][n] = (f32x4){0.f, 0.f, 0.f, 0.f};
        cur = nxt; cB = nB; ++ui;
#if GEMM_ALIGN_EPI
        if (wr == 1) PG8_BAR;
#endif
    }
    PG8_WAIT_V(0);
#if !GEMM_ALIGN_EPI
    if (wr == 0) PG8_BAR;
#endif
    PG8_BAR;
#undef PG8_SA
#undef PG8_SB
#undef PG8_STAGE
#undef PG8_LDA
#undef PG8_LDB
#undef PG8_MMA
#undef PG8_WAIT_V
#undef PG8_WAIT_L
#undef PG8_BAR
#undef PG8_SCHED
}
}

using pg8::Unit;
struct SchedIn {
    static constexpr bool GATHER = false;
    int G, v, K; const bf16* Bt;
    __device__ __forceinline__ bool next(int i, Unit& u) const {
        int L = i * G + v; if (L >= 3040) return false;
        if (L < 2944) { const int gid = L / 184, l = L % 184; u.pm = gid * 8 + (l & 7); u.pn = l >> 3; }
        else { L -= 2944; const int gid = L / 48, l = L % 48; u.pm = 128 + gid * 8 + (l & 7); u.pn = l >> 3; }
        u.e = 0; u.idx = i; u.q = 15; return true;
    }
    __device__ __forceinline__ const char* bbase(const Unit& u) const { return (const char*)Bt + (size_t)u.pn * ((size_t)256 * K * 2); }
    __device__ __forceinline__ void aoff(const Unit& u, const int (&R)[2], const int (&C)[2], unsigned (&v0)[2], unsigned (&v1)[2]) const {
#pragma unroll
        for (int i = 0; i < 2; ++i) { v0[i] = (unsigned)(((u.pm * 256 + R[i]) * K + C[i]) * 2); v1[i] = (unsigned)(((u.pm * 256 + 128 + R[i]) * K + C[i]) * 2); }
    }
};
struct SchedPlain {
    static constexpr bool GATHER = false;
    int G, v, K, nN, nwg; const bf16* Bt;
    __device__ __forceinline__ bool next(int i, Unit& u) const {
        const int L = i * G + v; if (L >= nwg) return false;
        const int per = 8 * nN, gid = L / per, l = L % per; u.pm = gid * 8 + (l & 7); u.pn = l >> 3; u.e = 0; u.idx = i; u.q = 15; return true;
    }
    __device__ __forceinline__ const char* bbase(const Unit& u) const { return (const char*)Bt + (size_t)u.pn * ((size_t)256 * K); }
    __device__ __forceinline__ void aoff(const Unit& u, const int (&R)[2], const int (&C)[2], unsigned (&v0)[2], unsigned (&v1)[2]) const {
#pragma unroll
        for (int i = 0; i < 2; ++i) { v0[i] = (unsigned)((u.pm * 256 + R[i]) * K + C[i] * 2); v1[i] = (unsigned)((u.pm * 256 + 128 + R[i]) * K + C[i] * 2); }
    }
};
template <bool GATH> struct SchedMoe {
    static constexpr bool GATHER = GATH;
    int G, v, K, NT; const bf16* Bt; const volatile LAS unsigned* cl; const int* rowtok; const LAS unsigned short* lidx;
    __device__ __forceinline__ bool next(int i, Unit& u) const {
        const int tot = (int)cl[LW_MTS + 32], U = tot * NT, full = (U / G) * G, R = U - full;
        int L = i * G + v, q = 15;
        if (L >= full) {
            const int t = L - full, s = (!GATH && R * 4 <= G) ? 4 : (R * 2 <= G) ? 2 : 1, un = t / s, qq = t - un * s;
            if (un >= R) return false;
            L = full + un; q = s == 1 ? 15 : s == 2 ? (3 << (2 * qq)) : (1 << qq); }
        int mt = L / NT;
        const int pn = L - mt * NT;
        int e;
        if (GATH) { e = i > 0 ? u.e : 0;
            while (e < 31 && (int)cl[LW_MTS + e + 1] <= mt) ++e; }
        else { mt = tot - 1 - mt;
            e = i > 0 ? u.e : 31;
            while (e > 0 && (int)cl[LW_MTS + e] > mt) --e; }
        u.pm = mt; u.pn = pn; u.e = e; u.idx = i; u.q = q; return true;
    }
    __device__ __forceinline__ const char* bbase(const Unit& u) const { return (const char*)Bt + ((size_t)u.e * NT + u.pn) * ((size_t)256 * K); }
    __device__ __forceinline__ void aoff(const Unit& u, const int (&R)[2], const int (&C)[2], unsigned (&v0)[2], unsigned (&v1)[2]) const {
        if (GATH) {
            if (u.idx < MOE_LIDX_UNITS) {
#pragma unroll
                for (int i = 0; i < 2; ++i) { const int t0 = lidx[u.idx * 256 + R[i]], t1 = lidx[u.idx * 256 + 128 + R[i]];
                    v0[i] = (unsigned)(t0 * K + C[i] * 2); v1[i] = (unsigned)(t1 * K + C[i] * 2); }
            } else {
                const int i0 = (u.pm - (int)cl[LW_MTS + u.e]) * 256, cnt = (int)cl[LW_CNT + u.e];
                const int* rt = rowtok + (size_t)u.e * CAP;
#pragma unroll
                for (int i = 0; i < 2; ++i) {
                    int s0 = i0 + R[i], s1 = i0 + 128 + R[i]; s0 = s0 < cnt ? s0 : 0; s1 = s1 < cnt ? s1 : 0;
                    const int t0 = rt[s0], t1 = rt[s1];
                    v0[i] = (unsigned)(t0 * K + C[i] * 2); v1[i] = (unsigned)(t1 * K + C[i] * 2);
                }
                asm volatile("s_waitcnt vmcnt(0)" ::: "memory");
                asm volatile("" : "+v"(v0[0]), "+v"(v0[1]), "+v"(v1[0]), "+v"(v1[1]));
            }
        } else {
#pragma unroll
            for (int i = 0; i < 2; ++i) { v0[i] = (unsigned)((u.pm * 256 + R[i]) * K + C[i] * 2); v1[i] = (unsigned)((u.pm * 256 + 128 + R[i]) * K + C[i] * 2); }
        }
    }
};

__device__ __forceinline__ float softplusf(float x) { return x > 20.f ? x : log1pf(__expf(x)); }

struct EpiIn {
    static constexpr bool PERM = true, F8 = false; static constexpr int NSTORES = 0;
    bf16* xraw; float* dt; bf16* sz; bf16* scb; bf16* cu; const float* dt_bias;
    __device__ __forceinline__ int operator()(const f32x4 (&acc)[2][2][4][2], const Unit& u, int wr, int wc, int fr, int fq) const {
        const int row0 = u.pm * 256 + wr * 64 + fr, pn = u.pn, cl = wc * 32 + 8 * fq;
        if (pn <= 4 || pn == 6 || (pn >= 11 && pn <= 14)) {
            bf16* base; int ld;
            if (pn <= 4) { base = xraw + pn * 256; ld = XBCW; } else if (pn == 6) { base = xraw + 1280; ld = XBCW; } else { base = scb + (pn - 11) * 256; ld = 1024; }
#pragma unroll
            for (int ai = 0; ai < 2; ++ai)
#pragma unroll
                for (int m = 0; m < 4; ++m) { bf16* rowp = base + (size_t)(row0 + ai * 128 + m * 16) * ld + cl;
#pragma unroll
                    for (int bj = 0; bj < 2; ++bj) { const f32x4 v0 = acc[ai][bj][m][0], v1 = acc[ai][bj][m][1];
                        u32x4 w; w.x = pk2(v0[0], v0[1]); w.y = pk2(v0[2], v0[3]); w.z = pk2(v1[0], v1[1]); w.w = pk2(v1[2], v1[3]);
                        *(u32x4*)(rowp + bj * 128) = w; } }
            return 16;
        } else if (pn == 5) {
            if (wc == 0) {
                const f32x4 b0 = *(const f32x4*)(dt_bias + 8 * fq), b1 = *(const f32x4*)(dt_bias + 8 * fq + 4);
#pragma unroll
                for (int ai = 0; ai < 2; ++ai)
#pragma unroll
                    for (int m = 0; m < 4; ++m) { float* rowp = dt + (size_t)(row0 + ai * 128 + m * 16) * 32 + 8 * fq;
                        const f32x4 v0 = acc[ai][0][m][0] + b0, v1 = acc[ai][0][m][1] + b1; f32x4 o0, o1;
#pragma unroll
                        for (int j = 0; j < 4; ++j) { o0[j] = softplusf(v0[j]); o1[j] = softplusf(v1[j]); }
                        *(f32x4*)rowp = o0; *(f32x4*)(rowp + 4) = o1; }
                return 16;
            }
            return 0;
        } else if (pn <= 10) {
            bf16* base = sz + (pn - 7) * 256;
#pragma unroll
            for (int ai = 0; ai < 2; ++ai)
#pragma unroll
                for (int m = 0; m < 4; ++m) { bf16* rowp = base + (size_t)(row0 + ai * 128 + m * 16) * 1024 + cl;
#pragma unroll
                    for (int bj = 0; bj < 2; ++bj) { f32x4 v0 = acc[ai][bj][m][0], v1 = acc[ai][bj][m][1];
#pragma unroll
                        for (int j = 0; j < 4; ++j) { v0[j] = fsilu(v0[j]); v1[j] = fsilu(v1[j]); }
                        u32x4 w; w.x = pk2(v0[0], v0[1]); w.y = pk2(v0[2], v0[3]); w.z = pk2(v1[0], v1[1]); w.w = pk2(v1[2], v1[3]);
                        *(u32x4*)(rowp + bj * 128) = w; } }
            return 16;
        } else {
            bf16* base = cu + (pn - 15) * 128;
#pragma unroll
            for (int ai = 0; ai < 2; ++ai)
#pragma unroll
                for (int m = 0; m < 4; ++m) { bf16* rowp = base + (size_t)(row0 + ai * 128 + m * 16) * 1024 + cl;
                    const f32x4 v0 = acc[ai][0][m][0] * acc[ai][1][m][0], v1 = acc[ai][0][m][1] * acc[ai][1][m][1];
                    u32x4 w; w.x = pk2(v0[0], v0[1]); w.y = pk2(v0[2], v0[3]); w.z = pk2(v1[0], v1[1]); w.w = pk2(v1[2], v1[3]);
                    *(u32x4*)rowp = w; }
            return 8;
        }
    }
};
struct EpiOut {
    static constexpr bool PERM = true, F8 = true; static constexpr int NSTORES = 0;
    const float* x; bf16* x1b; const float* mod;
    __device__ __forceinline__ int operator()(const f32x4 (&acc)[2][2][4][2], const Unit& u, int wr, int wc, int fr, int fq) const {
        const int row0 = u.pm * 256 + wr * 64 + fr, col0 = u.pn * 256 + wc * 32 + 8 * fq, b = u.pm >> 3;
        f32x4 gv[2][2];
#pragma unroll
        for (int bj = 0; bj < 2; ++bj)
#pragma unroll
            for (int n = 0; n < 2; ++n) gv[bj][n] = *(const f32x4*)(mod + (size_t)b * 6144 + 2048 + col0 + bj * 128 + n * 4) * W8_INV;
#pragma unroll
        for (int ai = 0; ai < 2; ++ai)
#pragma unroll
            for (int m = 0; m < 4; ++m) { const size_t off = (size_t)(row0 + ai * 128 + m * 16) * 1024 + col0;
#pragma unroll
                for (int bj = 0; bj < 2; ++bj) { const f32x4 x0 = *(const f32x4*)(x + off + bj * 128), x1 = *(const f32x4*)(x + off + bj * 128 + 4);
                    const f32x4 v0 = x0 + gv[bj][0] * acc[ai][bj][m][0], v1 = x1 + gv[bj][1] * acc[ai][bj][m][1];
                    u32x4 w; w.x = pk2(v0[0], v0[1]); w.y = pk2(v0[2], v0[3]); w.z = pk2(v1[0], v1[1]); w.w = pk2(v1[2], v1[3]);
                    *(u32x4*)(x1b + off + bj * 128) = w; }
                if (m & 1) asm volatile("" ::: "memory"); }
        return 16;
    }
};
struct EpiGU {
    static constexpr bool PERM = true, F8 = true; static constexpr int NSTORES = 8;
    unsigned char* act; const float* bgu;
    static __device__ __forceinline__ f32x2 swiglu2(const f32x2 g, const f32x2 l) {
        f32x2 ga, la; ga[0] = fminf(g[0], 7.f); ga[1] = fminf(g[1], 7.f);
        la[0] = __builtin_amdgcn_fmed3f(l[0], -7.f, 7.f); la[1] = __builtin_amdgcn_fmed3f(l[1], -7.f, 7.f);
        const f32x2 tt = ga * (-1.702f * 1.4426950408889634f);
        f32x2 d; d[0] = __builtin_amdgcn_exp2f(tt[0]); d[1] = __builtin_amdgcn_exp2f(tt[1]);
        d = d + 1.0f;
        f32x2 r; r[0] = __builtin_amdgcn_rcpf(d[0]); r[1] = __builtin_amdgcn_rcpf(d[1]);
        return ga * r * (la + 1.0f);
    }
    __device__ __forceinline__ int operator()(const f32x4 (&acc)[2][2][4][2], const Unit& u, int wr, int wc, int fr, int fq) const {
        const int row0 = u.pm * 256 + wr * 64 + fr, cl = wc * 32 + 8 * fq, ch0 = u.pn * 128 + cl;
        const float* bp = bgu + (size_t)u.e * 2048 + ch0;
        const f32x4 bg0 = *(const f32x4*)bp, bg1 = *(const f32x4*)(bp + 4), bl0 = *(const f32x4*)(bp + 1024), bl1 = *(const f32x4*)(bp + 1028);
#pragma unroll
        for (int ai = 0; ai < 2; ++ai) { if (!((u.q >> (2 * ai)) & 1)) continue;
#pragma unroll
            for (int m = 0; m < 4; ++m) { unsigned char* rowp = act + (size_t)(row0 + ai * 128 + m * 16) * 1024 + ch0;
                const f32x4 g0 = acc[ai][0][m][0] * W8_INV + bg0, g1 = acc[ai][0][m][1] * W8_INV + bg1, l0 = acc[ai][1][m][0] * W8_INV + bl0, l1 = acc[ai][1][m][1] * W8_INV + bl1;
                const f32x2 oa = swiglu2(g0.xy, l0.xy), ob = swiglu2(g0.zw, l0.zw), oc = swiglu2(g1.xy, l1.xy), od = swiglu2(g1.zw, l1.zw);
                u32x2 w; w.x = pk4_fp8(oa[0], oa[1], ob[0], ob[1]); w.y = pk4_fp8(oc[0], oc[1], od[0], od[1]);
                *(u32x2*)rowp = w; } }
        return 8;
    }
};
struct EpiDown {
    static constexpr bool PERM = true, F8 = true; static constexpr int NSTORES = 16;
    unsigned char* y; const float* bdn;
    __device__ __forceinline__ int operator()(const f32x4 (&acc)[2][2][4][2], const Unit& u, int wr, int wc, int fr, int fq) const {
        const int row0 = u.pm * 256 + wr * 64 + fr, col0 = u.pn * 256 + wc * 32 + 8 * fq;
        const float* bp = bdn + (size_t)u.e * 1024 + col0;
#pragma unroll
        for (int bj = 0; bj < 2; ++bj) { const f32x4 b0 = *(const f32x4*)(bp + bj * 128), b1 = *(const f32x4*)(bp + bj * 128 + 4);
#pragma unroll
            for (int ai = 0; ai < 2; ++ai) { if (!((u.q >> (2 * ai + bj)) & 1)) continue;
#pragma unroll
                for (int m = 0; m < 4; ++m) { unsigned char* rowp = y + (size_t)(row0 + ai * 128 + m * 16) * 1024 + col0;
                    const f32x4 v0 = acc[ai][bj][m][0] * W8_INV + b0, v1 = acc[ai][bj][m][1] * W8_INV + b1;
                    u32x2 w; w.x = pk4_fp8(v0[0], v0[1], v0[2], v0[3]); w.y = pk4_fp8(v1[0], v1[1], v1[2], v1[3]);
                    *(u32x2*)(rowp + bj * 128) = w; } } }
        return 16;
    }
};

template <class Sched> __device__ __forceinline__ void preload_row_indices(Frame& F, const Sched& S) {
    LAS unsigned short* li = (LAS unsigned short*)(F.lds + LDS_IDX_OFF);
    const int r = F.tid & 255;
    Unit u; u.e = 0;
    for (int i = 0; i < MOE_LIDX_UNITS; ++i) {
        if (!S.next(i, u)) break;
        if ((F.tid >> 8) == (i & 1)) {
            const int i0 = (u.pm - (int)F.cl[LW_MTS + u.e]) * 256, cnt = (int)F.cl[LW_CNT + u.e];
            const int sl = i0 + r < cnt ? i0 + r : 0;
            li[i * 256 + r] = (unsigned short)S.rowtok[(size_t)u.e * CAP + sl]; }
    }
    __syncthreads();
}
__device__ __forceinline__ void p0_item(const float* W, int ldw, int K, int k0, int n0, bf16* WT, int drow0, const float* kscale, LAS float* scr, int lane) {
#pragma unroll 8
    for (int i = 0; i < 32; ++i) { const int kk = 2 * i + (lane >> 5); float w = W[(size_t)(k0 + kk) * ldw + n0 + (lane & 31)]; if (kscale) w *= kscale[k0 + kk]; scr[kk * 33 + (lane & 31)] = w; }
    LDS_WAIT(); asm volatile("" ::: "memory");
    const int c = lane & 7;
#pragma unroll
    for (int j = 0; j < 4; ++j) { const int n = (lane >> 3) + 8 * j; const LAS float* s = scr + (8 * c) * 33 + n;
        u32x4 o; o.x = pk2(s[0 * 33], s[1 * 33]); o.y = pk2(s[2 * 33], s[3 * 33]); o.z = pk2(s[4 * 33], s[5 * 33]); o.w = pk2(s[6 * 33], s[7 * 33]);
        *(u32x4*)(WT + (size_t)(drow0 + n) * K + k0 + 8 * c) = o; }
    LDS_WAIT(); asm volatile("" ::: "memory");
}
__device__ __forceinline__ int win_drow(int n) {
    if (n < X0) return (7 + (n >> 8)) * 256 + (n & 255);
    if (n < B0) return n - X0;
    if (n < C0) return 4 * 256 + (n - B0);
    if (n < DT0) return 6 * 256 + (n - C0);
    if (n < SC0) return 5 * 256 + (n - DT0);
    n -= SC0;
    if (n < 1024) return (11 + (n >> 8)) * 256 + (n & 255);
    if (n < 2048) { n -= 1024; return (15 + (n >> 7)) * 256 + (n & 127); }
    n -= 2048; return (15 + (n >> 7)) * 256 + 128 + (n & 127);
}
__device__ __forceinline__ void phase0(Frame& F) {
    float* mod = (float*)(F.ws + WS_MOD);
    for (int it = F.vcu; it < 192; it += F.G) {
        typedef float f32x16 __attribute__((ext_vector_type(16)));
        LAS float* sc = (LAS float*)F.lds;
        LAS float* red = (LAS float*)(F.lds + 69760);
        const int lane = F.lane, w = F.wave, n0 = it * 32, r = lane & 31, kh = lane >> 5;
        float cv[34];
#pragma unroll
        for (int q = 0; q < 34; ++q) { const int i = F.tid + 512 * q, rr = i >> 10, k = i & 1023; cv[q] = (rr < 16) ? F.c[rr * 1024 + k] : F.c_ctx[k]; }
        float wl[64];
        const float* wbase = F.w_mod + (size_t)(128 * w) * 6144 + n0; const int loff = kh * 6144 + r;
#pragma unroll
        for (int q = 0; q < 64; ++q) wl[q] = (wbase + (size_t)q * 12288)[loff];
#pragma unroll
        for (int q = 0; q < 34; ++q) { const int i = F.tid + 512 * q; sc[(i >> 10) * 1025 + (i & 1023)] = fsilu(cv[q]); }
        __syncthreads();
        f32x16 acc;
#pragma unroll
        for (int e = 0; e < 16; ++e) acc[e] = 0.f;
        const LAS float* ap = sc + (r < 17 ? r : 0) * 1025 + 128 * w + kh;
#pragma unroll
        for (int q = 0; q < 64; ++q) { const float av = r < 17 ? ap[2 * q] : 0.f; acc = __builtin_amdgcn_mfma_f32_32x32x2f32(av, wl[q], acc, 0, 0, 0); }
#pragma unroll
        for (int reg = 0; reg < 8; ++reg) red[(w * 17 + (reg & 3) + 8 * (reg >> 2) + 4 * kh) * 32 + r] = acc[reg];
        if (kh == 0) red[(w * 17 + 16) * 32 + r] = acc[8];
        __syncthreads();
        for (int o = F.tid; o < 17 * 32; o += 512) { const int rr = o >> 5, cc = o & 31; float sm = F.b_mod[n0 + cc];
            for (int g = 0; g < 8; ++g) sm += red[(g * 17 + rr) * 32 + cc];
            mod[(size_t)rr * 6144 + n0 + cc] = sm; }
        __syncthreads();
    }
    const int gw = F.vcu * NWAVES + F.wave, NGW = F.G * NWAVES, lane = F.lane;
    constexpr int I_IN = 16 * 177, I_OUT = 32 * 32;
    bf16* win = (bf16*)(F.ws + WS_WIN); bf16* wout = (bf16*)(F.ws + WS_WOUT);
    for (int it = gw; it < I_IN + I_OUT; it += NGW) {
        const float* src; int ldw, K; bf16* dst = nullptr; unsigned char* dst8 = nullptr; const float* ksc = nullptr;
        if (it < I_IN) { const int kb = it / 177, nb = it % 177; ldw = IN_W; K = 1024; src = F.w_in + (size_t)(kb * 64) * IN_W + nb * 32; dst = win + (size_t)win_drow(nb * 32) * 1024 + kb * 64; }
        else { const int r = it - I_IN, kb = r >> 5, nb = r & 31; ldw = 1024; K = 2048; src = F.w_out + (size_t)(kb * 64) * 1024 + nb * 32; dst8 = (unsigned char*)wout + (size_t)(nb * 32) * 2048 + kb * 64; if (kb < 16) ksc = F.ssd_norm_g + kb * 64; }
        const int lo = (lane >> 3) * 8 * ldw + (lane & 7) * 4;
        f32x4 wr_[8];
#pragma unroll
        for (int e = 0; e < 8; ++e) wr_[e] = *(const f32x4*)(src + (size_t)e * ldw + lo);
        if (ksc) {
#pragma unroll
            for (int e = 0; e < 8; ++e) wr_[e] = wr_[e] * ksc[(lane >> 3) * 8 + e]; }
        if (dst8) {
            unsigned char* dl = dst8 + (size_t)((lane & 7) * 4) * K + (lane >> 3) * 8;
#pragma unroll
            for (int c = 0; c < 4; ++c) { u32x2 o; o.x = pk4_fp8(wr_[0][c] * W8_SCALE, wr_[1][c] * W8_SCALE, wr_[2][c] * W8_SCALE, wr_[3][c] * W8_SCALE);
                o.y = pk4_fp8(wr_[4][c] * W8_SCALE, wr_[5][c] * W8_SCALE, wr_[6][c] * W8_SCALE, wr_[7][c] * W8_SCALE);
                *(u32x2*)(dl + (size_t)c * K) = o; }
        } else {
            bf16* dl = dst + (size_t)((lane & 7) * 4) * K + (lane >> 3) * 8;
#pragma unroll
            for (int c = 0; c < 4; ++c) { u32x4 o; o.x = pk2(wr_[0][c], wr_[1][c]); o.y = pk2(wr_[2][c], wr_[3][c]); o.z = pk2(wr_[4][c], wr_[5][c]); o.w = pk2(wr_[6][c], wr_[7][c]);
                *(u32x4*)(dl + (size_t)c * K) = o; }
        }
    }
}

__device__ __forceinline__ void phase1(Frame& F) {
    const float* mod = (const float*)(F.ws + WS_MOD); bf16* hx = (bf16*)(F.ws + WS_HX);
    const int gw = F.vcu * NWAVES + F.wave, NGW = F.G * NWAVES, per = (TT + NGW - 1) / NGW;
    const int rbeg = gw * per, rend = (rbeg + per < TT) ? rbeg + per : TT;
    f32x4 mulv[4], shv[4]; int curb = -1;
    for (int row0 = rbeg; row0 < rend; row0 += 3) {
        f32x4 v[3][4];
#pragma unroll
        for (int u = 0; u < 3; ++u) { const int row = row0 + u; if (row < rend) { const float* src = row < TL ? F.x + (size_t)row * 1024 : F.ctx + (size_t)(row - TL) * 1024;
#pragma unroll
            for (int j = 0; j < 4; ++j) v[u][j] = *(const f32x4*)(src + 4 * F.lane + 256 * j); } }
#pragma unroll
        for (int u = 0; u < 3; ++u) { const int row = row0 + u; if (row < rend) {
            const int mb = row < TL ? (row >> 11) : 16;
            if (mb != curb) { curb = mb; const float* shift = mod + (size_t)mb * 6144, *scale = shift + 1024;
#pragma unroll
                for (int j = 0; j < 4; ++j) { const int c = 4 * F.lane + 256 * j; mulv[j] = *(const f32x4*)(F.norm1_g + c) * (*(const f32x4*)(scale + c) + 1.0f); shv[j] = *(const f32x4*)(shift + c); } }
            float s = 0.f;
#pragma unroll
            for (int j = 0; j < 4; ++j) s += (v[u][j][0] * v[u][j][0] + v[u][j][1] * v[u][j][1]) + (v[u][j][2] * v[u][j][2] + v[u][j][3] * v[u][j][3]);
            const float rs = 1.0f / sqrtf(wave_sum(s) * (1.f / 1024.f) + NORM_EPS);
#pragma unroll
            for (int j = 0; j < 4; ++j) { const int c = 4 * F.lane + 256 * j;
                const f32x4 o = v[u][j] * rs * mulv[j] + shv[j];
                u32x2 w; w.x = pk2(o[0], o[1]); w.y = pk2(o[2], o[3]);
                *(u32x2*)(hx + (size_t)row * 1024 + c) = w; } } }
    }
}

__device__ __forceinline__ void unpack8(const u32x4 w, float (&f)[8]) { f[0] = bflo(w.x); f[1] = bfhi(w.x); f[2] = bflo(w.y); f[3] = bfhi(w.y); f[4] = bflo(w.z); f[5] = bfhi(w.z); f[6] = bflo(w.w); f[7] = bfhi(w.w); }
__device__ __forceinline__ void phase_conv(Frame& F) {
    const bf16* xraw = (const bf16*)(F.ws + WS_XRAW); bf16* xbc = (bf16*)(F.ws + WS_XBC);
    if (F.tid >= 384) return;
    const int cp = F.tid % 192, rs = F.tid / 192, c0 = cp * 8;
    float w0[8], w1[8], w2[8], bb[8];
#pragma unroll
    for (int e = 0; e < 8; ++e) { w0[e] = F.conv_w[c0 + e]; w1[e] = F.conv_w[XBCW + c0 + e]; w2[e] = F.conv_w[2 * XBCW + c0 + e]; bb[e] = F.conv_b[c0 + e]; }
    for (int it = F.vcu; it < TT / 32; it += F.G) {
        const int r0 = it * 32 + rs * 16;
        const bool isctx = r0 >= TL;
        if (isctx && c0 >= 1280) continue;
        const int L = isctx ? CTXL : SEQ, t0 = isctx ? ((r0 - TL) & (CTXL - 1)) : (r0 & (SEQ - 1));
        const u32x4 zero = (u32x4){0u, 0u, 0u, 0u};
        u32x4 rw[18];
#pragma unroll
        for (int i = 0; i < 18; ++i) rw[i] = (t0 + i - 1 >= 0 && t0 + i - 1 < L) ? *(const u32x4*)(xraw + (size_t)(r0 + i - 1) * XBCW + c0) : zero;
#pragma unroll
        for (int i = 0; i < 16; ++i) {
            float a[8], b[8], c[8], o[8]; unpack8(rw[i], a); unpack8(rw[i + 1], b); unpack8(rw[i + 2], c);
#pragma unroll
            for (int e = 0; e < 8; ++e) o[e] = fsilu(w0[e] * a[e] + w1[e] * b[e] + w2[e] * c[e] + bb[e]);
            u32x4 w; w.x = pk2(o[0], o[1]); w.y = pk2(o[2], o[3]); w.z = pk2(o[4], o[5]); w.w = pk2(o[6], o[7]);
            *(u32x4*)(xbc + (size_t)(r0 + i) * XBCW + c0) = w;
        }
    }
}

namespace ssd {
constexpr int LDC = 136, LDJ = 72;
constexpr int S_CC = 0, S_BC = 17408, S_X = 34816, S_XW = 44032, S_G = 53248, S_HB = 62464, HS = 45056;
constexpr int S_SC = 124928, SCS = 2048;
__device__ __forceinline__ bf16x8 ldfrag(const LAS unsigned char* base, int row, int ld, int k) { return *(const LAS bf16x8*)(base + (size_t)(row * ld + k) * 2); }
typedef short v4i16_t __attribute__((ext_vector_type(4)));
__device__ __forceinline__ bf16x8 ldfrag_tr(const LAS unsigned char* base, int ld, int k0, int c0, int lane) {
    const int g = lane >> 4, q = (lane & 15) >> 2, p = lane & 3;
    const LAS unsigned char* a = base + (size_t)((k0 + 8 * g + q) * ld + c0 + 4 * p) * 2;
    const v4i16_t lo = __builtin_amdgcn_ds_read_tr16_b64_v4i16((LAS v4i16_t*)a);
    const v4i16_t hi = __builtin_amdgcn_ds_read_tr16_b64_v4i16((LAS v4i16_t*)(a + (size_t)4 * ld * 2));
    return __builtin_shufflevector(lo, hi, 0, 1, 2, 3, 4, 5, 6, 7);
}
}
__device__ __forceinline__ int ssd_rowbase(int b, int dir, int s) {
    return s < 4 ? TL + b * CTXL + (dir ? (3 - s) : s) * 64 : b * SEQ + (dir ? (35 - s) : (s - 4)) * 64;
}
#define SSD_LOADS(sidx) do { const int rb_ = ssd_rowbase(b, dir, (sidx)); const bool ctx_ = (sidx) < 4; \
    const char* rbp_ = (const char*)xbc + (size_t)rb_ * (XBCW * 2) + (size_t)((1024 + g * 128) * 2);        \
    _Pragma("unroll") for (int q2 = 0; q2 < 2; ++q2) { \
        bR[q2] = *(const u32x4*)(rbp_ + (bcoff + (unsigned)(q2 * 32 * XBCW * 2))); cR[q2] = ctx_ ? (u32x4){0u, 0u, 0u, 0u} : *(const u32x4*)(rbp_ + (bcoff + (unsigned)(q2 * 32 * XBCW * 2 + 512))); } \
    { const char* xp_ = (const char*)xbc + (size_t)rb_ * (XBCW * 2) + (size_t)(hA * 128); xR[0] = *(const u32x4*)(xp_ + xoff); xR[1] = *(const u32x4*)(xp_ + (xoff + 128u)); } \
    } while (0)
#define SSD_SCAN(dtj_, par_) do { const int j = dir ? (63 - lane) : lane; float v = (dtj_) * aw; \
    _Pragma("unroll") for (int o = 1; o < 64; o <<= 1) { const float t = __shfl_up(v, o); v += (lane >= o) ? t : 0.f; } \
    const float total = __shfl(v, 63); \
    scw[(par_) * 64 + j] = v; scw[128 + (par_) * 64 + j] = (dtj_); scw[256 + (par_) * 64 + j] = __expf(total - v) * (dtj_); if (lane == 0) scw[384 + (par_)] = total; } while (0)
constexpr int WC_TILES_GU = 32 * 16 * 64, WC_TILES = WC_TILES_GU + 32 * 16 * 32;
__device__ __forceinline__ void wc_tile_base(const Frame& F, int T, const float*& src, int& ldw, unsigned char*& dst) {
    if (T < WC_TILES_GU) { const int e = T >> 10, q = T & 1023, kb = q >> 6, nb = q & 63, n0 = nb * 32;
        const int drow0 = n0 < 1024 ? (n0 >> 7) * 256 + (n0 & 127) : ((n0 - 1024) >> 7) * 256 + 128 + ((n0 - 1024) & 127);
        ldw = 2048; src = F.w_gu + (size_t)e * 1024 * 2048 + (size_t)(kb * 64) * 2048 + n0;
        dst = (unsigned char*)(F.ws + WS_WGU) + (size_t)e * 2048 * 1024 + (size_t)drow0 * 1024 + kb * 64; }
    else { const int T2 = T - WC_TILES_GU, e = T2 >> 9, q = T2 & 511, kb = q >> 5, nb = q & 31, n0 = nb * 32;
        ldw = 1024; src = F.w_dn + (size_t)e * 1024 * 1024 + (size_t)(kb * 64) * 1024 + n0;
        dst = (unsigned char*)(F.ws + WS_WDN) + (size_t)e * 1024 * 1024 + (size_t)n0 * 1024 + kb * 64; }
}
#define WC_LOAD(T_) do { const float* src_; int ldw_; unsigned char* dst_; wc_tile_base(F, (T_), src_, ldw_, dst_); \
    const int lo_ = (lane >> 3) * 8 * ldw_ + (lane & 7) * 4; \
    _Pragma("unroll") for (int e = 0; e < 8; ++e) wR[e] = *(const f32x4*)((src_ + (size_t)e * ldw_) + lo_); } while (0)
#define WC_STORE(T_) do { const float* src_; int ldw_; unsigned char* dst_; wc_tile_base(F, (T_), src_, ldw_, dst_); \
    _Pragma("unroll") for (int e = 0; e < 8; ++e) asm volatile("" : "+v"(wR[e])); \
    unsigned char* dl_ = dst_ + ((lane & 7) * 4 * 1024 + (lane >> 3) * 8); \
    _Pragma("unroll") for (int c = 0; c < 4; ++c) { u32x2 o_; o_.x = pk4_fp8(wR[0][c] * W8_SCALE, wR[1][c] * W8_SCALE, wR[2][c] * W8_SCALE, wR[3][c] * W8_SCALE); \
        o_.y = pk4_fp8(wR[4][c] * W8_SCALE, wR[5][c] * W8_SCALE, wR[6][c] * W8_SCALE, wR[7][c] * W8_SCALE); \
        *(u32x2*)(dl_ + c * 1024) = o_; } } while (0)
#define WC_TILE_K(k_) __builtin_amdgcn_readfirstlane((((k_) * F.G + F.vcu) * 8 + w))
#define WC_TILE_OF(cs_) (((cs_) % 3) < 2 ? WC_TILE_K(((cs_) / 3) * 2 + (cs_) % 3) : 0x7fffffff)
__device__ __forceinline__ void phase_ssd(Frame& F) {
    using namespace ssd;
    const bf16* xbc = (const bf16*)(F.ws + WS_XBC); const float* dtb = (const float*)(F.ws + WS_DT); const bf16* szb = (const bf16*)(F.ws + WS_SZ);
    LAS unsigned char* const L0 = F.lds;
    const int tid = F.tid, lane = F.lane, w = F.wave, fr = lane & 15, fq = lane >> 4;
    LAS float* scw = (LAS float*)(L0 + S_SC + (w & 1) * SCS);
    f32x4 wR[8]; int cstep = 0;
    int Tpend = WC_TILE_OF(cstep);
    if (Tpend < WC_TILES) { WC_LOAD(Tpend); }
    for (int it = F.vcu; it < 256; it += F.G) {
        const int b = it >> 4, g = (it >> 3) & 1, hp = (it >> 1) & 3, dir = it & 1, hA = g * 8 + hp * 2;
        const float aw = -__expf(F.a_log[dir * 16 + hA + (w & 1)]);
        const int dtcolw = dir * 16 + hA + (w & 1);
        bf16* ydir = (bf16*)(F.ws + (dir ? WS_YB : WS_YF));
        f32x4 Hacc[2][4];
#pragma unroll
        for (int hd = 0; hd < 2; ++hd)
#pragma unroll
            for (int tp = 0; tp < 4; ++tp) Hacc[hd][tp] = (f32x4){0.f, 0.f, 0.f, 0.f};
        u32x4 cR[2], bR[2], xR[2];
        const unsigned bcoff = (unsigned)(((tid >> 4) * XBCW + (tid & 15) * 8) * 2), xoff = (unsigned)(((tid >> 3) * XBCW + (tid & 7) * 8) * 2);
        const float dsk0 = dir ? 0.f : F.ssd_d[hA], dsk1 = dir ? 0.f : F.ssd_d[hA + 1];
        if (w < 2) { const int j = dir ? (63 - lane) : lane; const float d0 = dtb[(size_t)(ssd_rowbase(b, dir, 0) + j) * 32 + dtcolw]; SSD_SCAN(d0, 0); }
        SSD_LOADS(0);
        __syncthreads();
        for (int s = 0; s < 36; ++s) {
            const bool isctx = s < 4; const int par = s & 1;
            const int rowbase = ssd_rowbase(b, dir, s);
            unsigned lb = 0u; asm volatile("" : "+s"(lb));
            LAS unsigned char* const L = L0 + lb;
#pragma unroll
            for (int q2 = 0; q2 < 2; ++q2) asm volatile("" : "+v"(bR[q2]), "+v"(cR[q2]));
            asm volatile("" : "+v"(xR[0]), "+v"(xR[1]));
            u32x2 zc00 = (u32x2){0u, 0u}, zc01 = zc00, zc10 = zc00, zc11 = zc00;
#pragma unroll
            for (int q2 = 0; q2 < 2; ++q2) { const int q = tid + 512 * q2, row = q >> 4, n8 = q & 15;
                *(LAS u32x4*)(L + S_BC + (size_t)(row * LDC + n8 * 8) * 2) = bR[q2];
                *(LAS u32x4*)(L + S_CC + (size_t)(row * LDC + n8 * 8) * 2) = cR[q2]; }
#pragma unroll
            for (int hd = 0; hd < 2; ++hd) { const int row = tid >> 3, p8 = tid & 7;
                *(LAS u32x4*)(L + hd * HS + S_X + (size_t)(row * LDJ + p8 * 8) * 2) = xR[hd];
                float f[8]; unpack8(xR[hd], f); const float wj = ((const LAS float*)(L + S_SC + hd * SCS))[256 + par * 64 + row];
                u32x4 o; o.x = pk2(f[0] * wj, f[1] * wj); o.y = pk2(f[2] * wj, f[3] * wj); o.z = pk2(f[4] * wj, f[5] * wj); o.w = pk2(f[6] * wj, f[7] * wj);
                *(LAS u32x4*)(L + hd * HS + S_XW + (size_t)(row * LDJ + p8 * 8) * 2) = o; }
            __syncthreads();
            if (Tpend < WC_TILES) { WC_STORE(Tpend); }
            float dnext = 0.f;
            if (s + 1 < 36) {
                if (w < 2) { const int j = dir ? (63 - lane) : lane; dnext = dtb[(size_t)(ssd_rowbase(b, dir, s + 1) + j) * 32 + dtcolw]; }
                SSD_LOADS(s + 1);
            }
            ++cstep; Tpend = WC_TILE_OF(cstep);
            if (Tpend < WC_TILES) { WC_LOAD(Tpend); }
            if (!isctx) {
                {
                    const int ti = w & 3, tj0 = w >> 2, tj1 = tj0 + 2;
                    const bool need0 = dir ? (tj0 >= ti) : (tj0 <= ti), need1 = dir ? (tj1 >= ti) : (tj1 <= ti);
                    bf16x8 cf[4], bf0[4], bf1[4];
#pragma unroll
                    for (int k = 0; k < 4; ++k) cf[k] = ldfrag(L + S_CC, 16 * ti + fr, LDC, 32 * k + 8 * fq);
                    if (need0) {
#pragma unroll
                        for (int k = 0; k < 4; ++k) bf0[k] = ldfrag(L + S_BC, 16 * tj0 + fr, LDC, 32 * k + 8 * fq); }
                    if (need1) {
#pragma unroll
                        for (int k = 0; k < 4; ++k) bf1[k] = ldfrag(L + S_BC, 16 * tj1 + fr, LDC, 32 * k + 8 * fq); }
                    f32x4 a0 = (f32x4){0.f, 0.f, 0.f, 0.f}, a1 = (f32x4){0.f, 0.f, 0.f, 0.f};
                    if (need0) {
#pragma unroll
                        for (int k = 0; k < 4; ++k) a0 = __builtin_amdgcn_mfma_f32_16x16x32_bf16(bf0[k], cf[k], a0, 0, 0, 0); }
                    if (need1) {
#pragma unroll
                        for (int k = 0; k < 4; ++k) a1 = __builtin_amdgcn_mfma_f32_16x16x32_bf16(bf1[k], cf[k], a1, 0, 0, 0); }
                    const int i = 16 * ti + fr;
#pragma unroll
                    for (int hd = 0; hd < 2; ++hd) {
                        const LAS float* sc = (const LAS float*)(L + S_SC + hd * SCS);
                        const float csi = sc[par * 64 + i];
                        const f32x4 csj0 = *(const LAS f32x4*)(sc + par * 64 + 16 * tj0 + 4 * fq), csj1 = *(const LAS f32x4*)(sc + par * 64 + 16 * tj1 + 4 * fq);
                        const f32x4 dtj0 = *(const LAS f32x4*)(sc + 128 + par * 64 + 16 * tj0 + 4 * fq), dtj1 = *(const LAS f32x4*)(sc + 128 + par * 64 + 16 * tj1 + 4 * fq);
                        float g0[4], g1[4];
#pragma unroll
                        for (int r = 0; r < 4; ++r) {
                            const int j0 = 16 * tj0 + 4 * fq + r, j1 = 16 * tj1 + 4 * fq + r;
                            const bool ok0 = dir ? (j0 >= i) : (j0 <= i), ok1 = dir ? (j1 >= i) : (j1 <= i);
                            g0[r] = ok0 ? a0[r] * __expf(csi - csj0[r]) * dtj0[r] : 0.f;
                            g1[r] = ok1 ? a1[r] * __expf(csi - csj1[r]) * dtj1[r] : 0.f; }
                        u32x2 o0, o1; o0.x = pk2(g0[0], g0[1]); o0.y = pk2(g0[2], g0[3]); o1.x = pk2(g1[0], g1[1]); o1.y = pk2(g1[2], g1[3]);
                        *(LAS u32x2*)(L + hd * HS + S_G + (size_t)(i * LDJ + 16 * tj0 + 4 * fq) * 2) = o0;
                        *(LAS u32x2*)(L + hd * HS + S_G + (size_t)(i * LDJ + 16 * tj1 + 4 * fq) * 2) = o1;
                    }
                }
                __syncthreads();
                { const char* zp_ = (const char*)szb + (size_t)rowbase * 2048 + (size_t)(hA * 128);
                    const unsigned zoff = (unsigned)(((16 * (w & 3) + fr) * 1024 + 4 * fq + 16 * (w >> 2)) * 2);
                    zc00 = *(const u32x2*)(zp_ + zoff); zc01 = *(const u32x2*)(zp_ + (zoff + 64u)); zc10 = *(const u32x2*)(zp_ + (zoff + 128u)); zc11 = *(const u32x2*)(zp_ + (zoff + 192u)); }
            }
            if (w < 2 && s + 1 < 36) { SSD_SCAN(dnext, par ^ 1); }
            {
                bf16x8 af[2];
#pragma unroll
                for (int k = 0; k < 2; ++k) af[k] = ldfrag_tr(L + S_BC, LDC, 32 * k, 16 * w, lane);
#pragma unroll
                for (int hd = 0; hd < 2; ++hd) {
                    bf16x8 xwf[4][2];
#pragma unroll
                    for (int k = 0; k < 2; ++k)
#pragma unroll
                        for (int tp = 0; tp < 4; ++tp) xwf[tp][k] = ldfrag_tr(L + hd * HS + S_XW, LDJ, 32 * k, 16 * tp, lane);
                    const float dec = __expf(((const LAS float*)(L + S_SC + hd * SCS))[384 + par]);
#pragma unroll
                    for (int tp = 0; tp < 4; ++tp) { Hacc[hd][tp] = Hacc[hd][tp] * dec;
#pragma unroll
                        for (int k = 0; k < 2; ++k) Hacc[hd][tp] = __builtin_amdgcn_mfma_f32_16x16x32_bf16(af[k], xwf[tp][k], Hacc[hd][tp], 0, 0, 0); }

                }
            }
            if (!isctx) {
                const int ti = w & 3, tp0 = w >> 2, tp1 = tp0 + 2;
                bf16x8 cf[4];
#pragma unroll
                for (int k = 0; k < 4; ++k) cf[k] = ldfrag(L + S_CC, 16 * ti + fr, LDC, 32 * k + 8 * fq);
                const int i = 16 * ti + fr;
#pragma unroll
                for (int hd = 0; hd < 2; ++hd) {
                    const LAS unsigned char* Lh = L + hd * HS;
                    bf16x8 gf[2], h0[4], h1[4];
#pragma unroll
                    for (int k = 0; k < 2; ++k) gf[k] = ldfrag(Lh + S_G, 16 * ti + fr, LDJ, 32 * k + 8 * fq);
#pragma unroll
                    for (int k = 0; k < 4; ++k) { h0[k] = ldfrag(Lh + S_HB, 16 * tp0 + fr, LDC, 32 * k + 8 * fq); h1[k] = ldfrag(Lh + S_HB, 16 * tp1 + fr, LDC, 32 * k + 8 * fq); }
                    const float ei = __expf(((const LAS float*)(L + S_SC + hd * SCS))[par * 64 + i]);
                    f32x4 yd0 = (f32x4){0.f, 0.f, 0.f, 0.f}, yd1 = yd0, yo0 = yd0, yo1 = yd0;
#pragma unroll
                    for (int k = 0; k < 2; ++k) { const bf16x8 xa = ldfrag_tr(Lh + S_X, LDJ, 32 * k, 16 * tp0, lane), xb = ldfrag_tr(Lh + S_X, LDJ, 32 * k, 16 * tp1, lane);
                        yd0 = __builtin_amdgcn_mfma_f32_16x16x32_bf16(xa, gf[k], yd0, 0, 0, 0); yd1 = __builtin_amdgcn_mfma_f32_16x16x32_bf16(xb, gf[k], yd1, 0, 0, 0); }
#pragma unroll
                    for (int k = 0; k < 4; ++k) { yo0 = __builtin_amdgcn_mfma_f32_16x16x32_bf16(h0[k], cf[k], yo0, 0, 0, 0); yo1 = __builtin_amdgcn_mfma_f32_16x16x32_bf16(h1[k], cf[k], yo1, 0, 0, 0); }
                    const u32x2 xq0 = *(const LAS u32x2*)(Lh + S_X + (size_t)(i * LDJ + 16 * tp0 + 4 * fq) * 2), xq1 = *(const LAS u32x2*)(Lh + S_X + (size_t)(i * LDJ + 16 * tp1 + 4 * fq) * 2);
                    const f32x4 xa = (f32x4){bflo(xq0.x), bfhi(xq0.x), bflo(xq0.y), bfhi(xq0.y)}, xb = (f32x4){bflo(xq1.x), bfhi(xq1.x), bflo(xq1.y), bfhi(xq1.y)};
                    const u32x2 zc0 = hd ? zc10 : zc00, zc1 = hd ? zc11 : zc01;
                    const float dsk = hd ? dsk1 : dsk0;
                    const f32x4 za = (f32x4){bflo(zc0.x), bfhi(zc0.x), bflo(zc0.y), bfhi(zc0.y)}, zb = (f32x4){bflo(zc1.x), bfhi(zc1.x), bflo(zc1.y), bfhi(zc1.y)};
                    const f32x4 y0 = (yd0 + yo0 * ei + xa * dsk) * za, y1 = (yd1 + yo1 * ei + xb * dsk) * zb;
                    u32x2 o0, o1; o0.x = pk2(y0[0], y0[1]); o0.y = pk2(y0[2], y0[3]); o1.x = pk2(y1[0], y1[1]); o1.y = pk2(y1[2], y1[3]);
                    char* yp = (char*)ydir + (size_t)rowbase * 2048 + (size_t)((hA + hd) * 128);
                    const unsigned yoff = (unsigned)((i * 1024 + 4 * fq + 16 * tp0) * 2);
                    *(u32x2*)(yp + yoff) = o0; *(u32x2*)(yp + (yoff + 64u)) = o1;
                    asm volatile("" ::: "memory");
                }
            }
            __syncthreads();
#pragma unroll
            for (int hd = 0; hd < 2; ++hd)
#pragma unroll
                for (int tp = 0; tp < 4; ++tp) { u32x2 o; o.x = pk2(Hacc[hd][tp][0], Hacc[hd][tp][1]); o.y = pk2(Hacc[hd][tp][2], Hacc[hd][tp][3]);
                    *(LAS u32x2*)(L + hd * HS + S_HB + (size_t)((16 * tp + fr) * LDC + 16 * w + 4 * fq) * 2) = o; }
        }
        __syncthreads();
    }
    if (Tpend < WC_TILES) { WC_STORE(Tpend); }
    for (int k = ((cstep + 1) / 3) * 2 + ((cstep + 1) % 3 < 2 ? (cstep + 1) % 3 : 2); ; ++k) { const int T = WC_TILE_K(k); if (T >= WC_TILES) break; WC_LOAD(T); WC_STORE(T); }
}

__device__ __forceinline__ void phase_combine(Frame& F) {
    const bf16* xbc = (const bf16*)(F.ws + WS_XBC); const bf16* yf = (const bf16*)(F.ws + WS_YF); const bf16* yb = (const bf16*)(F.ws + WS_YB);
    const bf16* sz = (const bf16*)(F.ws + WS_SZ); const bf16* scb = (const bf16*)(F.ws + WS_SCB); const bf16* cu = (const bf16*)(F.ws + WS_CU);
    unsigned char* a2 = (unsigned char*)(F.ws + WS_A2);
    const int g = F.wave & 1, sub = F.wave >> 1, c = g * 512 + F.lane * 8;
    const int c2 = (F.tid & 127) * 8, sub2 = F.tid >> 7;
    float k0[8], k1[8], k2[8];
#pragma unroll
    for (int e = 0; e < 8; ++e) { k0[e] = F.sc_conv_w[c2 + e]; k1[e] = F.sc_conv_w[1024 + c2 + e]; k2[e] = F.sc_conv_w[2048 + c2 + e]; }
    for (int it = F.vcu; it < TL / 64; it += F.G) {
        const int tb = it * 64;
        for (int i0 = 0; i0 < 16; i0 += 4) {
            u32x4 ra[4], rb[4];
#pragma unroll
            for (int u = 0; u < 4; ++u) { const int t = tb + sub * 16 + i0 + u; ra[u] = *(const u32x4*)(yf + (size_t)t * 1024 + c); rb[u] = *(const u32x4*)(yb + (size_t)t * 1024 + c); }
#pragma unroll
            for (int u = 0; u < 4; ++u) { const int t = tb + sub * 16 + i0 + u;
                float a[8], b2[8], v[8]; float ss = 0.f; unpack8(ra[u], a); unpack8(rb[u], b2);
#pragma unroll
                for (int e = 0; e < 8; ++e) { v[e] = a[e] + b2[e]; ss += v[e] * v[e]; }
                const float rs = 1.0f / sqrtf(wave_sum(ss) * (1.f / 512.f) + NORM_EPS);
                u32x2 o; o.x = pk4_fp8(v[0] * rs, v[1] * rs, v[2] * rs, v[3] * rs); o.y = pk4_fp8(v[4] * rs, v[5] * rs, v[6] * rs, v[7] * rs);
                *(u32x2*)(a2 + (size_t)t * 2048 + c) = o; }
        }
        for (int i0 = 0; i0 < 16; i0 += 4) {
            const u32x4 zero = (u32x4){0u, 0u, 0u, 0u};
            u32x4 rp[4], rq[4], rn[4], rs_[4];
#pragma unroll
            for (int u = 0; u < 4; ++u) { const int t = tb + sub2 * 16 + i0 + u, tt = t & (SEQ - 1);
                rp[u] = tt >= 64 ? *(const u32x4*)(cu + (size_t)(t - 64) * 1024 + c2) : zero;
                rq[u] = *(const u32x4*)(cu + (size_t)t * 1024 + c2);
                rn[u] = tt + 64 < SEQ ? *(const u32x4*)(cu + (size_t)(t + 64) * 1024 + c2) : zero;
                rs_[u] = *(const u32x4*)(scb + (size_t)t * 1024 + c2); }
#pragma unroll
            for (int u = 0; u < 4; ++u) { const int t = tb + sub2 * 16 + i0 + u;
                float p[8], q[8], n[8], sb[8], o8[8]; unpack8(rp[u], p); unpack8(rq[u], q); unpack8(rn[u], n); unpack8(rs_[u], sb);
#pragma unroll
                for (int e = 0; e < 8; ++e) o8[e] = sb[e] * (k0[e] * p[e] + k1[e] * q[e] + k2[e] * n[e]);
                u32x2 o; o.x = pk4_fp8(o8[0], o8[1], o8[2], o8[3]); o.y = pk4_fp8(o8[4], o8[5], o8[6], o8[7]);
                *(u32x2*)(a2 + (size_t)t * 2048 + 1024 + c2) = o; }
        }
    }
}

__device__ __forceinline__ void route_token(const float (&acc)[32], int tl, int lane, int myexp, float mybias, LAS int* lcnt, LAS int* tinfo) {
            float r16[16], r8[8], r4[4], r2[2], r1;
            { const bool hi = (lane & 32) != 0;
#pragma unroll
              for (int e = 0; e < 16; ++e) { const float send = hi ? acc[e] : acc[e + 16]; const float recv = __shfl_xor(send, 32); r16[e] = (hi ? acc[e + 16] : acc[e]) + recv; } }
            { const bool hi = (lane & 16) != 0;
#pragma unroll
              for (int e = 0; e < 8; ++e) { const float send = hi ? r16[e] : r16[e + 8]; const float recv = __shfl_xor(send, 16); r8[e] = (hi ? r16[e + 8] : r16[e]) + recv; } }
            { const bool hi = (lane & 8) != 0;
#pragma unroll
              for (int e = 0; e < 4; ++e) { const float send = hi ? r8[e] : r8[e + 4]; const float recv = __shfl_xor(send, 8); r4[e] = (hi ? r8[e + 4] : r8[e]) + recv; } }
            { const bool hi = (lane & 4) != 0;
#pragma unroll
              for (int e = 0; e < 2; ++e) { const float send = hi ? r4[e] : r4[e + 2]; const float recv = __shfl_xor(send, 4); r2[e] = (hi ? r4[e + 2] : r4[e]) + recv; } }
            { const bool hi = (lane & 2) != 0; const float send = hi ? r2[0] : r2[1]; const float recv = __shfl_xor(send, 2); r1 = (hi ? r2[1] : r2[0]) + recv; }
            r1 += __shfl_xor(r1, 1);
            float val = r1 + mybias;
            int sel[4]; float sv[4];
#pragma unroll
            for (int kk = 0; kk < 4; ++kk) {
                float bv = val; int bi = myexp;
#pragma unroll
                for (int o = 1; o < 64; o <<= 1) { const float ov = __shfl_xor(bv, o); const int oi = __shfl_xor(bi, o); if (ov > bv || (ov == bv && oi < bi)) { bv = ov; bi = oi; } }
                sel[kk] = bi; sv[kk] = bv; if (myexp == bi) val = -3.0e38f;
            }
            const float p1 = __expf(sv[1] - sv[0]), p2 = __expf(sv[2] - sv[0]), p3 = __expf(sv[3] - sv[0]);
            const float inv = 1.0f / (1.0f + p1 + p2 + p3);
            const float gt[4] = {inv, p1 * inv, p2 * inv, p3 * inv};
            if (lane < 4) {
                const int e = lane == 0 ? sel[0] : lane == 1 ? sel[1] : lane == 2 ? sel[2] : sel[3];
                const float gg = lane == 0 ? gt[0] : lane == 1 ? gt[1] : lane == 2 ? gt[2] : gt[3];
                const int ls = atomicAdd((int*)&lcnt[e], 1);
                tinfo[(tl * 4 + lane) * 3 + 0] = e; tinfo[(tl * 4 + lane) * 3 + 1] = ls; tinfo[(tl * 4 + lane) * 3 + 2] = __float_as_int(gg);
            }
}
__device__ __forceinline__ void phase_router(Frame& F) {
    const float* mod = (const float*)(F.ws + WS_MOD); unsigned char* h2 = (unsigned char*)(F.ws + WS_HX);
    int* rowtok = (int*)(F.ws + WS_ROWTOK); int* tokes = (int*)(F.ws + WS_TOKES); float* tokg = (float*)(F.ws + WS_TOKG);
    LAS unsigned char* L = F.lds;
    LAS f32x4* WR = (LAS f32x4*)L;
    LAS float* mulv = (LAS float*)(L + 131072);
    LAS float* shv = (LAS float*)(L + 131072 + 4096);
    LAS int* tinfo = (LAS int*)(L + 131072 + 8192);
    LAS int* lcnt = (LAS int*)(L + 131072 + 8192 + 6144);
    LAS int* lbase = lcnt + 32;
    for (int i = F.tid; i < 8192; i += 512) { const int k = i >> 3, e4 = i & 7; WR[((k >> 6) * 8 + e4) * 64 + (k & 63)] = *(const f32x4*)(F.w_router + (size_t)k * 32 + e4 * 4); }
    if (F.tid < 32) lcnt[F.tid] = 0;
    const int lane = F.lane;
    const int myexp = ((lane >> 5) & 1) * 16 + ((lane >> 4) & 1) * 8 + ((lane >> 3) & 1) * 4 + ((lane >> 2) & 1) * 2 + ((lane >> 1) & 1);
    const float mybias = F.b_router[myexp];
    for (int blk = F.vcu; blk < TL / 128; blk += F.G) {
        const int bb = (blk * 128) >> 11;
        __syncthreads();
        for (int k = F.tid; k < 1024; k += 512) { mulv[k] = F.norm2_g[k] * (1.0f + mod[(size_t)bb * 6144 + 4 * 1024 + k]); shv[k] = mod[(size_t)bb * 6144 + 3 * 1024 + k]; }
        __syncthreads();
#pragma unroll 1
        for (int i = 0; i < 16; i += 2) {
            const int tl0 = F.wave * 16 + i, tq0 = blk * 128 + tl0;
            float hv[2][16], rsv[2];
#pragma unroll
            for (int u = 0; u < 2; ++u) { const bf16* xr = (const bf16*)(F.ws + WS_X1B) + (size_t)(tq0 + u) * 1024;
#pragma unroll
                for (int jj = 0; jj < 16; ++jj) hv[u][jj] = bf2f(xr[lane + 64 * jj]); }
#pragma unroll
            for (int u = 0; u < 2; ++u) { float ss = 0.f;
#pragma unroll
                for (int jj = 0; jj < 16; ++jj) ss += hv[u][jj] * hv[u][jj];
                rsv[u] = 1.0f / sqrtf(wave_sum(ss) * (1.f / 1024.f) + NORM_EPS); }
            f32x2 acc[2][16];
#pragma unroll
            for (int u = 0; u < 2; ++u)
#pragma unroll
                for (int e = 0; e < 16; ++e) acc[u][e] = (f32x2){0.f, 0.f};
            const LAS f32x4* wlo = WR + lane; const LAS f32x4* whi = WR + 4096 + lane;
            asm volatile("" : "+v"(wlo), "+v"(whi));
#pragma unroll
            for (int jj = 0; jj < 16; ++jj) { const int k = lane + 64 * jj;
                const float mk = (mulv + lane)[64 * jj], sk = (shv + lane)[64 * jj];
                const float h0 = hv[0][jj] * rsv[0] * mk + sk, h1 = hv[1][jj] * rsv[1] * mk + sk;
                { const unsigned hb = (unsigned)__builtin_amdgcn_cvt_pk_fp8_f32(h0, h1, 0, false); h2[(size_t)tq0 * 1024 + k] = (unsigned char)(hb & 0xffu); h2[(size_t)(tq0 + 1) * 1024 + k] = (unsigned char)((hb >> 8) & 0xffu); }
                const f32x2 h0v = (f32x2){h0, h0}, h1v = (f32x2){h1, h1};
#pragma unroll
                for (int e4 = 0; e4 < 8; ++e4) { const f32x4 wq = (jj < 8 ? wlo : whi)[((jj & 7) * 8 + e4) * 64];
                    acc[0][2 * e4] += h0v * wq.xy; acc[0][2 * e4 + 1] += h0v * wq.zw; acc[1][2 * e4] += h1v * wq.xy; acc[1][2 * e4 + 1] += h1v * wq.zw; }
                asm volatile("" ::: "memory"); }
#pragma unroll 1
            for (int u = 0; u < 2; ++u) {
                float au[32];
#pragma unroll
                for (int e = 0; e < 16; ++e) { const f32x2 a2 = u ? acc[1][e] : acc[0][e]; au[2 * e] = a2[0]; au[2 * e + 1] = a2[1]; }
                route_token(au, tl0 + u, lane, myexp, mybias, lcnt, tinfo);
            }
        }
        __syncthreads();
        if (F.tid < 32) { const int n = lcnt[F.tid]; lbase[F.tid] = (int)__hip_atomic_fetch_add((unsigned*)(F.ctl + CW_ECNT + F.tid), (unsigned)n, RLX_AGENT); }
        __syncthreads();
        { const int tl = F.tid >> 2, kk = F.tid & 3, t = blk * 128 + tl;
          const int e = tinfo[(tl * 4 + kk) * 3 + 0], ls = tinfo[(tl * 4 + kk) * 3 + 1]; const float gg = __int_as_float(tinfo[(tl * 4 + kk) * 3 + 2]);
          const int slot = lbase[e] + ls;
          rowtok[(size_t)e * CAP + slot] = t; tokes[t * 4 + kk] = e * CAP + slot; tokg[t * 4 + kk] = gg; }
        __syncthreads();
        if (F.tid < 32) lcnt[F.tid] = 0;
    }
    __syncthreads();
}

__device__ __forceinline__ void build_mt_table(Frame& F) {
    __syncthreads();
    if (F.tid < 64) {
        const int lane = F.lane, e = lane & 31;
        const int c = (int)__hip_atomic_load(F.ctl + CW_ECNT + e, RLX_AGENT);
        const int mtc = (c + 255) >> 8;
        int incl = mtc;
#pragma unroll
        for (int o = 1; o < 32; o <<= 1) { const int t = __shfl_up(incl, o); incl += (lane >= o && lane < 32) ? t : 0; }
        if (lane < 32) { F.cl[LW_CNT + e] = (unsigned)c; F.cl[LW_MTS + e] = (unsigned)(incl - mtc); }
        if (lane == 31) F.cl[LW_MTS + 32] = (unsigned)incl;
    }
    __syncthreads();
}

__device__ __forceinline__ void phase_final(Frame& F) {
    const float* mod = (const float*)(F.ws + WS_MOD); const unsigned char* yrows = (const unsigned char*)(F.ws + WS_YROWS);
    const int* tokes = (const int*)(F.ws + WS_TOKES); const float* tokg = (const float*)(F.ws + WS_TOKG);
    const int gw = F.vcu * NWAVES + F.wave, NGW = F.G * NWAVES, lane = F.lane;
    const bf16* x1b = (const bf16*)(F.ws + WS_X1B);
    constexpr int FT = 4;
    for (int t0 = gw; t0 < TL; t0 += FT * NGW) {
        u32x2 yr[FT][4][2]; u32x4 xr[FT][2]; float gk[FT][4];
#pragma unroll
        for (int u = 0; u < FT; ++u) { const int t = t0 + u * NGW; if (t < TL) {
#pragma unroll
            for (int kk = 0; kk < 4; ++kk) { const int es = tokes[t * 4 + kk]; gk[u][kk] = tokg[t * 4 + kk];
                const int e = es >> 15, slot = es & (CAP - 1);
                const size_t pos = (size_t)F.cl[LW_MTS + e] * 256 + slot;
                yr[u][kk][0] = *(const u32x2*)(yrows + pos * 1024 + lane * 8); yr[u][kk][1] = *(const u32x2*)(yrows + pos * 1024 + 512 + lane * 8); }
            xr[u][0] = *(const u32x4*)(x1b + (size_t)t * 1024 + lane * 8); xr[u][1] = *(const u32x4*)(x1b + (size_t)t * 1024 + 512 + lane * 8); } }
#pragma unroll
        for (int u = 0; u < FT; ++u) { const int t = t0 + u * NGW; if (t < TL) {
            const int b = t >> 11;
            float m[16];
#pragma unroll
            for (int e = 0; e < 16; ++e) m[e] = 0.f;
#pragma unroll
            for (int kk = 0; kk < 4; ++kk) { float y0[8], y1[8]; unpack8_fp8(yr[u][kk][0], y0); unpack8_fp8(yr[u][kk][1], y1);
#pragma unroll
                for (int q = 0; q < 8; ++q) { m[q] += gk[u][kk] * y0[q]; m[8 + q] += gk[u][kk] * y1[q]; } }
            float x2[16]; float ss = 0.f;
#pragma unroll
            for (int hf = 0; hf < 2; ++hf) { const int c = hf * 512 + lane * 8;
                float xv[8]; unpack8(xr[u][hf], xv);
                const f32x4 g0 = *(const f32x4*)(mod + (size_t)b * 6144 + 5 * 1024 + c), g1 = *(const f32x4*)(mod + (size_t)b * 6144 + 5 * 1024 + c + 4);
#pragma unroll
                for (int j = 0; j < 4; ++j) { const float v0 = xv[j] + g0[j] * m[hf * 8 + j], v1 = xv[4 + j] + g1[j] * m[hf * 8 + 4 + j];
                    x2[hf * 8 + j] = v0; x2[hf * 8 + 4 + j] = v1; ss += v0 * v0 + v1 * v1; } }
            const float rs = 1.0f / sqrtf(wave_sum(ss) * (1.f / 1024.f) + NORM_EPS);
#pragma unroll
            for (int hf = 0; hf < 2; ++hf)
#pragma unroll
                for (int q4 = 0; q4 < 2; ++q4) { const int c = hf * 512 + lane * 8 + q4 * 4;
                    const f32x4 fg = *(const f32x4*)(F.final_g + c); f32x4 o;
#pragma unroll
                    for (int j = 0; j < 4; ++j) o[j] = x2[hf * 8 + q4 * 4 + j] * rs * fg[j];
                    *(f32x4*)(F.out + (size_t)t * 1024 + c) = o; } } }
    }
}

constexpr int NPHASE = 11;
__global__ void __launch_bounds__(NWAVES * 64, 2) mk_fwd(Args args) {
    extern __shared__ __attribute__((aligned(16))) unsigned char lds_raw[];
    Frame F;
    F.lds = (LAS unsigned char*)lds_raw;
    F.cl = (volatile LAS unsigned*)(F.lds + CTLDS_OFF);
    F.tid = threadIdx.x; F.lane = F.tid & 63; F.wave = __builtin_amdgcn_readfirstlane(F.tid >> 6);
    F.G = gridDim.x; { const int bx = blockIdx.x; F.vcu = (F.G % 8 == 0) ? (bx % 8) * (F.G / 8) + bx / 8 : bx; }
    F.ws = args.ws; F.ctl = (gu32*)(args.ws + WS_CTL); F.out = args.out;
    F.x = args.in[0]; F.c = args.in[1]; F.ctx = args.in[2]; F.c_ctx = args.in[3]; F.w_mod = args.in[4]; F.b_mod = args.in[5]; F.norm1_g = args.in[6]; F.w_in = args.in[7];
    F.conv_w = args.in[8]; F.conv_b = args.in[9]; F.dt_bias = args.in[10]; F.a_log = args.in[11]; F.ssd_d = args.in[12]; F.ssd_norm_g = args.in[13]; F.sc_conv_w = args.in[14];
    F.w_out = args.in[15]; F.norm2_g = args.in[16]; F.w_router = args.in[17]; F.b_router = args.in[18]; F.w_gu = args.in[19]; F.b_gu = args.in[20]; F.w_dn = args.in[21]; F.b_dn = args.in[22]; F.final_g = args.in[23];
    for (int u = F.tid; u < (LDS_BYTES - CTLDS_OFF) / 4; u += NWAVES * 64) ((LAS unsigned*)(F.lds + CTLDS_OFF))[u] = 0u;
    __syncthreads();
    const int lo = args.ph_lo, hi = args.ph_hi;
    XcdBarrier bar; bar.bar = (unsigned*)(F.ctl + CW_BAR); bar.x = 0; bar.st = nullptr;
    if (hi - lo > 1) bar = xcd_barrier_post((unsigned*)(F.ctl + CW_BAR), F.cl + LW_BARST);
#define IN(k) (lo <= (k) && (k) < hi)
#define SEAM(k) do { if (IN(k) && IN((k) + 1)) xcd_barrier(bar); } while (0)

#define RUNPH(k, body) do { if (IN(k)) { body; if ((PROBE_DOUBLE >> (k)) & 1) { xcd_barrier(bar); body; } SEAM(k); } } while (0)
    RUNPH(0, phase0(F));
    RUNPH(1, phase1(F));
#define BODY2 { SchedIn S{F.G, F.vcu, 1024, (const bf16*)(F.ws + WS_WIN)}; \
        EpiIn E{(bf16*)(F.ws + WS_XRAW), (float*)(F.ws + WS_DT), (bf16*)(F.ws + WS_SZ), (bf16*)(F.ws + WS_SCB), (bf16*)(F.ws + WS_CU), F.dt_bias}; \
        pg8::gemm_phase<EpiIn, SchedIn>(F.lds, (const bf16*)(F.ws + WS_HX), 1024, S, E); }
    RUNPH(2, BODY2);
    RUNPH(3, phase_conv(F));
    RUNPH(4, phase_ssd(F));
    RUNPH(5, phase_combine(F));
#define BODY6 { SchedPlain S{F.G, F.vcu, 2048, 4, 512, (const bf16*)(F.ws + WS_WOUT)}; \
        EpiOut E{F.x, (bf16*)(F.ws + WS_X1B), (const float*)(F.ws + WS_MOD)}; \
        pg8::gemm_phase<EpiOut, SchedPlain>(F.lds, (const bf16*)(F.ws + WS_A2), 2048, S, E); }
    RUNPH(6, BODY6);
    if (IN(7)) { phase_router(F); SEAM(7); }
#define BODY8 { build_mt_table(F); \
        SchedMoe<true> S{F.G, F.vcu, 1024, 8, (const bf16*)(F.ws + WS_WGU), F.cl, (const int*)(F.ws + WS_ROWTOK), (const LAS unsigned short*)(F.lds + LDS_IDX_OFF)}; \
        preload_row_indices(F, S); \
        EpiGU E{(unsigned char*)(F.ws + WS_ACT), F.b_gu}; \
        pg8::gemm_phase<EpiGU, SchedMoe<true>>(F.lds, (const bf16*)(F.ws + WS_HX), 1024, S, E); }
    RUNPH(8, BODY8);
#define BODY9 { build_mt_table(F); \
        SchedMoe<false> S{F.G, F.vcu, 1024, 4, (const bf16*)(F.ws + WS_WDN), F.cl, nullptr, nullptr}; \
        EpiDown E{(unsigned char*)(F.ws + WS_YROWS), F.b_dn}; \
        pg8::gemm_phase<EpiDown, SchedMoe<false>>(F.lds, (const bf16*)(F.ws + WS_ACT), 1024, S, E); }
    RUNPH(9, BODY9);
    if (IN(10)) { build_mt_table(F); phase_final(F); }
#undef IN
#undef SEAM
}

extern "C" void kernel_launch(void* const* d_in, const int* in_sizes, int n_in, void* d_out, int out_size, void* d_ws, size_t ws_size, hipStream_t stream) {
    static int grid = 0;
    if (grid == 0) {
        if (n_in != 24 || out_size != TL * D || ws_size < WS_END) { fprintf(stderr, "kernel_launch: unexpected shapes (n_in %d out %d ws %zu); nothing launched\n", n_in, out_size, ws_size); grid = -1; return; }
        int dev = 0, cus = 0;
        if (hipGetDevice(&dev) != hipSuccess || hipDeviceGetAttribute(&cus, hipDeviceAttributeMultiprocessorCount, dev) != hipSuccess) { grid = -1; return; }
        if (hipFuncSetAttribute((const void*)mk_fwd, hipFuncAttributeMaxDynamicSharedMemorySize, LDS_BYTES) != hipSuccess) { fprintf(stderr, "kernel_launch: hipFuncSetAttribute failed\n"); grid = -1; return; }
        int per_cu = 0;
        if (hipOccupancyMaxActiveBlocksPerMultiprocessor(&per_cu, (const void*)mk_fwd, NWAVES * 64, LDS_BYTES) != hipSuccess || per_cu < 1) fprintf(stderr, "kernel_launch: occupancy query says %d\n", per_cu);
        (void)hipGetLastError();
        grid = cus;
    }
    if (grid < 0) return;
    (void)hipMemsetAsync((char*)d_ws + WS_CTL, 0, CTL_ZERO_BYTES, stream);
    Args a{};
    for (int i = 0; i < 24; ++i) a.in[i] = (const float*)d_in[i];
    a.out = (float*)d_out; a.ws = (unsigned char*)d_ws;
#if MK_ONE_LAUNCH
    a.ph_lo = 0; a.ph_hi = NPHASE;
    hipLaunchKernelGGL(mk_fwd, dim3(grid), dim3(NWAVES * 64), LDS_BYTES, stream, a);
#else
    for (int p = 0; p < NPHASE; ++p) { a.ph_lo = p; a.ph_hi = p + 1; hipLaunchKernelGGL(mk_fwd, dim3(grid), dim3(NWAVES * 64), LDS_BYTES, stream, a); }
#endif
}
```

```cpp
#include <hip/hip_runtime.h>
#include <cstdio>
#include <cstdint>

#ifndef MK_ONE_LAUNCH
#define MK_ONE_LAUNCH 1
#endif
#ifndef PROBE_DOUBLE
#define PROBE_DOUBLE 0
#endif
#ifndef PROBE_EPI2
#define PROBE_EPI2 0
#endif
#ifndef PROBE_KREP
#define PROBE_KREP 1
#endif
#ifndef GEMM_ALIGN_EPI
#define GEMM_ALIGN_EPI 1
#endif
#ifndef GEMM_STAGGER_TICKS
#define GEMM_STAGGER_TICKS 0
#endif

#define LAS __attribute__((address_space(3)))
#define GAS __attribute__((address_space(1)))
typedef unsigned short bf16;
typedef short bf16x8 __attribute__((ext_vector_type(8)));
typedef float f32x4 __attribute__((ext_vector_type(4)));
typedef float f32x2 __attribute__((ext_vector_type(2)));
typedef unsigned u32x4 __attribute__((ext_vector_type(4)));
typedef unsigned u32x2 __attribute__((ext_vector_type(2)));
typedef int i32x4 __attribute__((ext_vector_type(4)));
typedef int i32x8 __attribute__((ext_vector_type(8)));
typedef GAS unsigned gu32;

constexpr int D = 1024, NB = 16, SEQ = 2048, CTXL = 256;
constexpr int TL = NB * SEQ;
constexpr int TC = NB * CTXL;
constexpr int TT = TL + TC;
constexpr int IN_W = 5664, X0 = 1024, B0 = 2048, C0 = 2304, DT0 = 2560, SC0 = 2592;
constexpr int NE = 32, TOPK = 4, DFF = 1024;
constexpr int XBCW = 1536;
constexpr int NT_IN = 23;
constexpr int CAP = TL;
constexpr int ACT_ROWS = TL * TOPK + NE * 256;
constexpr float NORM_EPS = 1e-6f;

constexpr size_t MiB = 1u << 20;
constexpr size_t WS_CTL = 0, CTL_ZERO_BYTES = 1 * MiB;
constexpr size_t WS_MOD = 1 * MiB;
constexpr size_t WS_TOKES = 2 * MiB;
constexpr size_t WS_TOKG = 2 * MiB + 512 * 1024;
constexpr size_t WS_ROWTOK = 3 * MiB;
constexpr size_t WS_WIN = 7 * MiB;
constexpr size_t WS_WOUT = 19 * MiB;
constexpr size_t WS_WGU = 23 * MiB;
constexpr size_t WS_WDN = 151 * MiB;
constexpr size_t WS_HX = 215 * MiB;
constexpr size_t WS_XRAW = 287 * MiB;
constexpr size_t WS_XBC = 395 * MiB;
constexpr size_t WS_DT = 503 * MiB;
constexpr size_t WS_SZ = 508 * MiB;
constexpr size_t WS_SCB = 572 * MiB;
constexpr size_t WS_CU = 636 * MiB;
constexpr size_t WS_YF = 700 * MiB;
constexpr size_t WS_YB = 764 * MiB;
constexpr size_t WS_A2 = 828 * MiB;
constexpr size_t WS_ACT = 287 * MiB;
constexpr size_t WS_YROWS = 572 * MiB;
constexpr size_t WS_X1B = 956 * MiB;
constexpr size_t WS_END = 1020 * MiB;
constexpr int CW_ECNT = 64;
constexpr int CW_BAR = 4096;

constexpr int LDS_BYTES = 147456;
constexpr int CTLDS_OFF = 146432;
constexpr int LW_BARST = 0;
constexpr int LW_UT = 128, MOE_UT_UNITS = 30;
constexpr int LDS_IDX_OFF = 131072, MOE_LIDX_UNITS = 30;
constexpr int LW_MTS = 16;
constexpr int LW_CNT = 64;

constexpr int NWAVES = 8;

#define LDS_WAIT() asm volatile("s_waitcnt lgkmcnt(0)" ::: "memory")
#define VM_WAIT() asm volatile("s_waitcnt vmcnt(0)" ::: "memory")
#define RLX_AGENT __ATOMIC_RELAXED, __HIP_MEMORY_SCOPE_AGENT

__device__ __forceinline__ unsigned f2bf(float f) { unsigned u = __builtin_bit_cast(unsigned, f); return (u + 0x7fffu + ((u >> 16) & 1u)) >> 16; }
typedef __bf16 hwbf16x2 __attribute__((ext_vector_type(2)));
__device__ __forceinline__ unsigned pk2(float lo, float hi) { const f32x2 v = {lo, hi}; const hwbf16x2 b = __builtin_convertvector(v, hwbf16x2); return __builtin_bit_cast(unsigned, b); }
__device__ __forceinline__ unsigned pk4_fp8(float a, float b, float c, float d) { int v = __builtin_amdgcn_cvt_pk_fp8_f32(a, b, 0, false); v = __builtin_amdgcn_cvt_pk_fp8_f32(c, d, v, true); return (unsigned)v; }
__device__ __forceinline__ void unpack8_fp8(const u32x2 w, float (&f)[8]) {
    const f32x2 a = __builtin_amdgcn_cvt_pk_f32_fp8((int)w.x, false), b = __builtin_amdgcn_cvt_pk_f32_fp8((int)w.x, true), c = __builtin_amdgcn_cvt_pk_f32_fp8((int)w.y, false), d = __builtin_amdgcn_cvt_pk_f32_fp8((int)w.y, true);
    f[0] = a[0]; f[1] = a[1]; f[2] = b[0]; f[3] = b[1]; f[4] = c[0]; f[5] = c[1]; f[6] = d[0]; f[7] = d[1]; }
constexpr float W8_SCALE = 64.0f, W8_INV = 1.0f / 64.0f;
__device__ __forceinline__ float bf2f(unsigned b) { return __builtin_bit_cast(float, b << 16); }
__device__ __forceinline__ float bflo(unsigned w) { return __builtin_bit_cast(float, w << 16); }
__device__ __forceinline__ float bfhi(unsigned w) { return __builtin_bit_cast(float, w & 0xffff0000u); }
__device__ __forceinline__ float fsilu(float x) { return x * __builtin_amdgcn_rcpf(1.0f + __expf(-x)); }
__device__ __forceinline__ float wave_sum(float v) {
#pragma unroll
    for (int o = 1; o < 64; o <<= 1) v += __shfl_xor(v, o);
    return v;
}

#define XB_TMO      128
#define XB_XCNT(j)  (256  + 64 * (j))
#define XB_XSUB(j)  (1280 + 64 * (j))
#define XB_XGEN(j)  (2304 + 64 * (j))
#define XB_TOP      3328
#define XB_TOPGEN   3392
#define XCD_BAR_WORDS 3456
#define XB_SPIN_CAP (1u << 18)
__device__ __forceinline__ unsigned xb_ld(unsigned* p)              { return __hip_atomic_load(p, __ATOMIC_RELAXED, __HIP_MEMORY_SCOPE_AGENT); }
__device__ __forceinline__ unsigned xb_add(unsigned* p, unsigned v) { return __hip_atomic_fetch_add(p, v, __ATOMIC_RELAXED, __HIP_MEMORY_SCOPE_AGENT); }
__device__ __forceinline__ unsigned xb_xcc_id() { return (unsigned)__builtin_amdgcn_s_getreg((3 << 11) | 20) & 0xFu; }
#define XB_SPIN(cond, bar) do { unsigned _sp = 0; while (cond) { __builtin_amdgcn_s_sleep(1); \
    if ((++_sp & 255u) == 0u) { if (xb_ld(&(bar)[XB_TMO])) break; if (_sp > XB_SPIN_CAP) { atomicAdd(&(bar)[XB_TMO], 1u); break; } } } } while (0)
struct XcdBarrier { unsigned* bar; unsigned x; volatile LAS unsigned* st; };
__device__ __forceinline__ XcdBarrier xcd_barrier_post(unsigned* bar, volatile LAS unsigned* st) {
    XcdBarrier b; b.bar = bar; b.x = xb_xcc_id(); b.st = st;
    if (threadIdx.x == 0) (void)xb_add(&bar[XB_XCNT(b.x)], 1u);
    return b;
}
__device__ __forceinline__ void xcd_barrier_complete(unsigned* bar, unsigned x, unsigned& nloc, unsigned& nx) {
    const unsigned G = gridDim.x * gridDim.y * gridDim.z;
    unsigned sum, cnt, mine, sp = 0u;
    for (;;) {
        sum = 0u; cnt = 0u; mine = 0u;
#pragma unroll
        for (unsigned j = 0; j < 16; ++j) { const unsigned c = xb_ld(&bar[XB_XCNT(j)]); sum += c; cnt += (c > 0u) ? 1u : 0u; mine = (j == x) ? c : mine; }
        if (sum == G) break;
        __builtin_amdgcn_s_sleep(1);
        if ((++sp & 255u) == 0u) { if (xb_ld(&bar[XB_TMO])) break; if (sp > XB_SPIN_CAP) { atomicAdd(&bar[XB_TMO], 1u); break; } }
    }
    nloc = mine > 0u ? mine : 1u; nx = cnt > 0u ? cnt : 1u;
}
__device__ __forceinline__ void xcd_barrier(const XcdBarrier& b) {
    asm volatile("s_waitcnt vmcnt(0)" ::: "memory");
    __syncthreads();
    if (threadIdx.x == 0) {
        unsigned* bar = b.bar;
        __builtin_amdgcn_s_waitcnt(0);
        unsigned nloc = b.st[0], nx = b.st[1];
        if (nloc == 0u) { xcd_barrier_complete(bar, b.x, nloc, nx); b.st[0] = nloc; b.st[1] = nx; }
        const unsigned old = xb_add(&bar[XB_XSUB(b.x)], 1u);
        const unsigned gen = old / nloc;
        if (old + 1u == (gen + 1u) * nloc) {
            __builtin_amdgcn_fence(__ATOMIC_RELEASE, "agent");
            asm volatile("s_waitcnt vmcnt(0)" ::: "memory");
            const unsigned og = xb_add(&bar[XB_TOP], 1u);
            const unsigned tg = og / nx;
            if (og + 1u == (tg + 1u) * nx) xb_add(&bar[XB_TOPGEN], 1u);
            else XB_SPIN(xb_ld(&bar[XB_TOPGEN]) == tg, bar);
            __builtin_amdgcn_fence(__ATOMIC_ACQUIRE, "agent");
            xb_add(&bar[XB_XGEN(b.x)], 1u);
            asm volatile("s_waitcnt vmcnt(0)" ::: "memory");
        } else {
            XB_SPIN(xb_ld(&bar[XB_XGEN(b.x)]) == gen, bar);
            __builtin_amdgcn_fence(__ATOMIC_ACQUIRE, "agent");
            asm volatile("s_waitcnt vmcnt(0)" ::: "memory");
        }
    }
    __syncthreads();
}

__device__ __forceinline__ void xcd_barrier_arrive(const XcdBarrier& b, unsigned& role, unsigned& gen) {
    asm volatile("s_waitcnt vmcnt(0)" ::: "memory");
    __syncthreads();
    role = 0u; gen = 0u;
    if (threadIdx.x == 0) {
        unsigned* bar = b.bar;
        __builtin_amdgcn_s_waitcnt(0);
        unsigned nloc = b.st[0], nx = b.st[1];
        if (nloc == 0u) { xcd_barrier_complete(bar, b.x, nloc, nx); b.st[0] = nloc; b.st[1] = nx; }
        const unsigned old = xb_add(&bar[XB_XSUB(b.x)], 1u);
        gen = old / nloc; role = 1u;
        if (old + 1u == (gen + 1u) * nloc) {
            __builtin_amdgcn_fence(__ATOMIC_RELEASE, "agent");
            asm volatile("s_waitcnt vmcnt(0)" ::: "memory");
            const unsigned og = xb_add(&bar[XB_TOP], 1u);
            const unsigned tg = og / nx;
            if (og + 1u == (tg + 1u) * nx) { xb_add(&bar[XB_TOPGEN], 1u); role = 3u; }
            else { role = 2u; gen = tg; }
        }
    }
}
__device__ __forceinline__ void xcd_barrier_wait(const XcdBarrier& b, unsigned role, unsigned gen) {
    asm volatile("s_waitcnt vmcnt(0)" ::: "memory");
    __syncthreads();
    if (threadIdx.x == 0) {
        unsigned* bar = b.bar;
        if (role >= 2u) {
            if (role == 2u) XB_SPIN(xb_ld(&bar[XB_TOPGEN]) == gen, bar);
            __builtin_amdgcn_fence(__ATOMIC_ACQUIRE, "agent");
            xb_add(&bar[XB_XGEN(b.x)], 1u);
            asm volatile("s_waitcnt vmcnt(0)" ::: "memory");
        } else {
            XB_SPIN(xb_ld(&bar[XB_XGEN(b.x)]) == gen, bar);
            __builtin_amdgcn_fence(__ATOMIC_ACQUIRE, "agent");
            asm volatile("s_waitcnt vmcnt(0)" ::: "memory");
        }
    }
    __syncthreads();
}

__device__ __forceinline__ void xcd_barrier_wait_t0(const XcdBarrier& b, unsigned role, unsigned gen) {
    if (threadIdx.x == 0) {
        unsigned* bar = b.bar;
        if (role >= 2u) {
            if (role == 2u) XB_SPIN(xb_ld(&bar[XB_TOPGEN]) == gen, bar);
            __builtin_amdgcn_fence(__ATOMIC_ACQUIRE, "agent");
            xb_add(&bar[XB_XGEN(b.x)], 1u);
        } else {
            XB_SPIN(xb_ld(&bar[XB_XGEN(b.x)]) == gen, bar);
            __builtin_amdgcn_fence(__ATOMIC_ACQUIRE, "agent");
        }
    }
}

struct Args { const float* in[24]; float* out; unsigned char* ws; int ph_lo, ph_hi; };
struct Frame {
    LAS unsigned char* lds;
    volatile LAS unsigned* cl;
    unsigned char* ws;
    gu32* ctl;
    int tid, lane, wave, vcu, G;
    const float *x, *c, *ctx, *c_ctx, *w_mod, *b_mod, *norm1_g, *w_in, *conv_w, *conv_b, *dt_bias, *a_log, *ssd_d, *ssd_norm_g, *sc_conv_w, *w_out, *norm2_g, *w_router, *b_router, *w_gu, *b_gu, *w_dn, *b_dn, *final_g;
    float* out;
};

namespace pg8 {
constexpr int BM = 256, BK = 64, HALF = 128, HTB = HALF * BK * 2, STAGE_BYTES = 8 * HTB;
__device__ __forceinline__ int lds_byte(int r, int c) { const int st = (r >> 4) * 2 + (c >> 5), rr = r & 15, cc = c & 31, ob = rr * 64 + cc * 2; return st * 1024 + (ob ^ (((ob >> 9) & 1) << 5)); }
__device__ __forceinline__ void stage_rc(int b, int& R, int& C) { const int st = b / 1024, sb = b % 1024, swz = sb ^ (((sb >> 9) & 1) << 5); R = (st >> 1) * 16 + swz / 64; C = (st & 1) * 32 + (swz % 64) / 2; }
__device__ __forceinline__ int perm32(int rho) { const int n = rho >> 4, i = rho & 15; return 8 * (i >> 2) + 4 * n + (i & 3); }
__device__ __forceinline__ i32x8 cat8(bf16x8 a, bf16x8 b) { const i32x4 x = __builtin_bit_cast(i32x4, a), y = __builtin_bit_cast(i32x4, b); return __builtin_shufflevector(x, y, 0, 1, 2, 3, 4, 5, 6, 7); }
__device__ __forceinline__ unsigned cvt_pk_bf16(float lo, float hi) { unsigned r; asm volatile("v_cvt_pk_bf16_f32 %0, %1, %2" : "=v"(r) : "v"(lo), "v"(hi)); return r; }

struct Unit { int pm, pn, e, idx, q; };

template <class Epi, class Sched>
__device__ __forceinline__ void gemm_phase(LAS unsigned char* lds, const bf16* Aptr, const int K, const Sched& S, const Epi& E, const int arrive_at, const XcdBarrier& xb, unsigned& xrole, unsigned& xgen, const int rot = 0, const int wait_t = -1) {
    const size_t krot = (size_t)rot * (size_t)(BK * 2);
    const int tid = threadIdx.x, wid = __builtin_amdgcn_readfirstlane(tid >> 6), lane = tid & 63, wr = wid >> 2, wc = wid & 3, fr = lane & 15, fq = lane >> 4;
    constexpr bool F8 = Epi::F8;
    const int nt = F8 ? K / 128 : K / BK;
    unsigned voffB[2];
#pragma unroll
    for (int i = 0; i < 2; ++i) { int R, C; stage_rc(tid * 16 + i * 8192, R, C); const int p32 = perm32(R & 31); const int Rb = Epi::PERM ? (Epi::BJ8 ? ((R >> 5) * 64 + (p32 >> 3) * 16 + (p32 & 7)) : ((R & ~31) + p32)) : R;
        voffB[i] = F8 ? (unsigned)(Rb * K + C * 2) : (unsigned)(Rb * K + C) * 2u; }
    const size_t kstep = (size_t)(BK * 2);
    const size_t hstep = (size_t)(Epi::BJ8 ? 8 : HALF) * K * (F8 ? 1 : 2);
    const unsigned ldsw = (unsigned)wid * 1024u;
    const int aoff = lds_byte(wr * 64 + fr, fq * 8), boff = lds_byte(wc * 32 + fr, fq * 8);
    const char* const Abase = (const char*)Aptr;
#define PG8_SA(b, h) (((b) * 2 + (h)) * HTB)
#define PG8_SB(b, h) ((4 + (b) * 2 + (h)) * HTB)
#define PG8_STAGE(bufoff, gbase, voff) do { _Pragma("unroll") for (int _i = 0; _i < 2; ++_i) \
        __builtin_amdgcn_global_load_lds((const unsigned*)((const char*)(gbase) + (voff)[_i]), (LAS unsigned*)(lds + (bufoff) + ldsw + _i * 8192), 16, 0, 0); } while (0)
#define PG8_LDA(dst, b, h) do { _Pragma("unroll") for (int m = 0; m < 4; ++m) _Pragma("unroll") for (int k = 0; k < 2; ++k) dst[m][k] = *(const LAS bf16x8*)(lds + PG8_SA(b, h) + aoff + m * 2048 + k * 1024); } while (0)
#define PG8_LDB(dst, b, h) do { _Pragma("unroll") for (int n = 0; n < 2; ++n) _Pragma("unroll") for (int k = 0; k < 2; ++k) dst[n][k] = *(const LAS bf16x8*)(lds + PG8_SB(b, h) + boff + n * 2048 + k * 1024); } while (0)
#define PG8_MMA(ai, bj, At, Bt) do { __builtin_amdgcn_s_setprio(1); \
        if constexpr (F8) { _Pragma("unroll") for (int m = 0; m < 4; ++m) _Pragma("unroll") for (int n = 0; n < 2; ++n) \
            acc[ai][bj][m][n] = __builtin_amdgcn_mfma_scale_f32_16x16x128_f8f6f4(cat8(Bt[n][0], Bt[n][1]), cat8(At[m][0], At[m][1]), acc[ai][bj][m][n], 0, 0, 0, 0x7f7f7f7f, 0, 0x7f7f7f7f); } \
        else { _Pragma("unroll") for (int m = 0; m < 4; ++m) _Pragma("unroll") for (int n = 0; n < 2; ++n) _Pragma("unroll") for (int k = 0; k < 2; ++k) \
            acc[ai][bj][m][n] = __builtin_amdgcn_mfma_f32_16x16x32_bf16(Bt[n][k], At[m][k], acc[ai][bj][m][n], 0, 0, 0); } \
        __builtin_amdgcn_s_setprio(0); } while (0)
#define PG8_WAIT_V(n) asm volatile("s_waitcnt vmcnt(" #n ")" ::: "memory")
#define PG8_WAIT_L(n) asm volatile("s_waitcnt lgkmcnt(" #n ")" ::: "memory")
#define PG8_BAR __builtin_amdgcn_s_barrier()
#define PG8_SCHED __builtin_amdgcn_sched_barrier(0)
    Unit cur, nxt; int ui = 0;
    if (!S.next(0, cur)) return;
#if GEMM_STAGGER_TICKS > 0
    if (S.v & 1) { const unsigned long long t0 = __builtin_amdgcn_s_memrealtime(); while (__builtin_amdgcn_s_memrealtime() - t0 < (unsigned long long)GEMM_STAGGER_TICKS) __builtin_amdgcn_s_sleep(8); }
#endif
    f32x4 acc[2][2][4][2];
#pragma unroll
    for (int a = 0; a < 2; ++a)
#pragma unroll
        for (int b = 0; b < 2; ++b)
#pragma unroll
            for (int m = 0; m < 4; ++m)
#pragma unroll
                for (int n = 0; n < 2; ++n) acc[a][b][m][n] = (f32x4){0.f, 0.f, 0.f, 0.f};
    bf16x8 At[4][2], B0[2][2], B1[2][2];
    unsigned va0[2], va1[2];
    { int sR[2], sC[2];
#pragma unroll
      for (int i = 0; i < 2; ++i) stage_rc(tid * 16 + i * 8192, sR[i], sC[i]);
      S.aoff(cur, sR, sC, va0, va1); }
    const char* cB = S.bbase(cur);
    PG8_STAGE(PG8_SB(0, 0), cB + krot, voffB); PG8_STAGE(PG8_SB(0, 1), cB + hstep + krot, voffB); PG8_STAGE(PG8_SA(0, 0), Abase + krot, va0); PG8_STAGE(PG8_SA(0, 1), Abase + krot, va1);
    if (wr == 1) PG8_BAR;
    PG8_WAIT_V(2); PG8_BAR;
    PG8_STAGE(PG8_SB(1, 0), cB + kstep + krot, voffB); PG8_STAGE(PG8_SA(1, 0), Abase + kstep + krot, va0); PG8_STAGE(PG8_SB(1, 1), cB + hstep + kstep + krot, voffB);
    PG8_WAIT_V(6); PG8_BAR;
    for (;;) {
        nxt = cur;
        const bool has_next = S.next(ui + 1, nxt);
        const char* nB = has_next ? S.bbase(nxt) : cB;
#pragma unroll 1
        for (int t = 0; t < nt * PROBE_KREP; t += 2) {
            const bool last = (t == nt * PROBE_KREP - 2);
            if (wait_t >= 0 && ui == 0 && t == wait_t) xcd_barrier_wait_t0(xb, xrole, xgen);
            const char* a1 = Abase + (size_t)((t + 1 + rot) % nt) * kstep;
            const char* a2 = last ? Abase + krot : Abase + (size_t)((t + 2 + rot) % nt) * kstep; const char* b2 = last ? nB + krot : cB + (size_t)((t + 2 + rot) % nt) * kstep;
            const char* a3 = a2 + kstep; const char* b3 = b2 + kstep;
            unsigned nva0[2], nva1[2];
            nva0[0] = va0[0]; nva0[1] = va0[1]; nva1[0] = va1[0]; nva1[1] = va1[1];
            if (last && has_next) {
                int tq = tid; asm volatile("" : "+v"(tq));
                int sR[2], sC[2];
#pragma unroll
                for (int i = 0; i < 2; ++i) stage_rc(tq * 16 + i * 8192, sR[i], sC[i]);
                S.aoff(nxt, sR, sC, nva0, nva1);
            }
            PG8_LDB(B0, 0, 0); PG8_LDB(B1, 0, 1); PG8_SCHED; PG8_LDA(At, 0, 0); PG8_STAGE(PG8_SA(1, 1), a1, va1);
            if constexpr (Epi::NSTORES == 16) { if (t == 0 && ui > 0) PG8_WAIT_V(24); else PG8_WAIT_V(8); }
            else if constexpr (Epi::NSTORES == 8) { if (t == 0 && ui > 0) PG8_WAIT_V(16); else PG8_WAIT_V(8); }
            else PG8_WAIT_V(8);
            PG8_WAIT_L(0); PG8_BAR; if (cur.q & 1) PG8_MMA(0, 0, At, B0); if (cur.q & 2) PG8_MMA(0, 1, At, B1); PG8_BAR; PG8_SCHED;
            if (last) { va0[0] = nva0[0]; va0[1] = nva0[1]; va1[0] = nva1[0]; va1[1] = nva1[1]; }
            PG8_LDA(At, 0, 1); PG8_STAGE(PG8_SB(0, 0), b2, voffB); PG8_STAGE(PG8_SB(0, 1), b2 + hstep, voffB); PG8_STAGE(PG8_SA(0, 0), a2, va0);
            if constexpr (Epi::NSTORES == 16) { if (t == 0 && ui > 0) PG8_WAIT_V(24); else PG8_WAIT_V(8); }
            else if constexpr (Epi::NSTORES == 8) { if (t == 0 && ui > 0) PG8_WAIT_V(16); else PG8_WAIT_V(8); }
            else PG8_WAIT_V(8);
            PG8_WAIT_L(0); PG8_BAR; if (cur.q & 4) PG8_MMA(1, 0, At, B0); if (cur.q & 8) PG8_MMA(1, 1, At, B1); PG8_BAR; PG8_SCHED;
            PG8_LDB(B0, 1, 0); PG8_LDB(B1, 1, 1); PG8_SCHED; PG8_LDA(At, 1, 0); PG8_STAGE(PG8_SA(0, 1), a2, va1);
            PG8_WAIT_V(8); PG8_WAIT_L(0); PG8_BAR; if (cur.q & 1) PG8_MMA(0, 0, At, B0); if (cur.q & 2) PG8_MMA(0, 1, At, B1); PG8_BAR; PG8_SCHED;
            PG8_LDA(At, 1, 1); PG8_STAGE(PG8_SB(1, 0), b3, voffB); PG8_STAGE(PG8_SB(1, 1), b3 + hstep, voffB); PG8_STAGE(PG8_SA(1, 0), a3, va0);
            PG8_WAIT_V(8); PG8_WAIT_L(0); PG8_BAR; if (cur.q & 4) PG8_MMA(1, 0, At, B0); if (cur.q & 8) PG8_MMA(1, 1, At, B1); PG8_BAR; PG8_SCHED;
        }
#if GEMM_ALIGN_EPI
        if (wr == 0) PG8_BAR;
#endif
#if PROBE_KREP > 1
#pragma unroll
        for (int a = 0; a < 2; ++a)
#pragma unroll
            for (int b = 0; b < 2; ++b)
#pragma unroll
                for (int m = 0; m < 4; ++m)
#pragma unroll
                    for (int n = 0; n < 2; ++n) acc[a][b][m][n] = acc[a][b][m][n] * (1.0f / PROBE_KREP);
#endif
        { int tq = tid; asm volatile("" : "+v"(tq));
          (void)E(acc, cur, wr, wc, tq & 15, (tq & 63) >> 4); }
        if (ui == arrive_at) xcd_barrier_arrive(xb, xrole, xgen);
        if (!has_next) break;
#pragma unroll
        for (int a = 0; a < 2; ++a)
#pragma unroll
            for (int b = 0; b < 2; ++b)
#pragma unroll
                for (int m = 0; m < 4; ++m)
#pragma unroll
                    for (int n = 0; n < 2; ++n) acc[a][b][m][n] = (f32x4){0.f, 0.f, 0.f, 0.f};
        cur = nxt; cB = nB; ++ui;
#if GEMM_ALIGN_EPI
        if (wr == 1) PG8_BAR;
#endif
    }
    PG8_WAIT_V(0);
#if !GEMM_ALIGN_EPI
    if (wr == 0) PG8_BAR;
#endif
    PG8_BAR;
#undef PG8_SA
#undef PG8_SB
#undef PG8_STAGE
#undef PG8_LDA
#undef PG8_LDB
#undef PG8_MMA
#undef PG8_WAIT_V
#undef PG8_WAIT_L
#undef PG8_BAR
#undef PG8_SCHED
}
}

using pg8::Unit;
struct SchedIn {
    static constexpr bool GATHER = false;
    int G, v, K; const bf16* Bt;
    __device__ __forceinline__ bool next(int i, Unit& u) const {
        int L = i * G + v; if (L >= 3040) return false;
        if (L < 768) { const int gid = L / 48, l = L % 48, t = l >> 3; u.pm = gid * 8 + (l & 7); u.pn = t < 5 ? t : 6; }
        else if (L < 848) { L -= 768; const int gid = L / 40, l = L % 40; u.pm = 128 + gid * 8 + (l & 7); u.pn = l >> 3; }
        else if (L < 2384) { L -= 848; const int gid = L / 96, l = L % 96; u.pm = gid * 8 + (l & 7); u.pn = 11 + (l >> 3); }
        else if (L < 3024) { L -= 2384; const int gid = L / 40, l = L % 40, t = l >> 3; u.pm = gid * 8 + (l & 7); u.pn = t == 0 ? 5 : t + 6; }
        else { u.pm = 128 + (L - 3024); u.pn = 5; }
        u.e = 0; u.idx = i; u.q = 15; return true;
    }
    __device__ __forceinline__ const char* bbase(const Unit& u) const { return (const char*)Bt + (size_t)u.pn * ((size_t)256 * K * 2); }
    __device__ __forceinline__ void aoff(const Unit& u, const int (&R)[2], const int (&C)[2], unsigned (&v0)[2], unsigned (&v1)[2]) const {
#pragma unroll
        for (int i = 0; i < 2; ++i) { v0[i] = (unsigned)(((u.pm * 256 + R[i]) * K + C[i]) * 2); v1[i] = (unsigned)(((u.pm * 256 + 128 + R[i]) * K + C[i]) * 2); }
    }
};
struct SchedPlain {
    static constexpr bool GATHER = false;
    int G, v, K, nN, nwg; const bf16* Bt;
    __device__ __forceinline__ bool next(int i, Unit& u) const {
        const int L = i * G + v; if (L >= nwg) return false;
        const int per = 8 * nN, gid = L / per, l = L % per; u.pm = gid * 8 + (l & 7); u.pn = l >> 3; u.e = 0; u.idx = i; u.q = 15; return true;
    }
    __device__ __forceinline__ const char* bbase(const Unit& u) const { return (const char*)Bt + (size_t)u.pn * ((size_t)256 * K); }
    __device__ __forceinline__ void aoff(const Unit& u, const int (&R)[2], const int (&C)[2], unsigned (&v0)[2], unsigned (&v1)[2]) const {
#pragma unroll
        for (int i = 0; i < 2; ++i) { v0[i] = (unsigned)((u.pm * 256 + R[i]) * K + C[i] * 2); v1[i] = (unsigned)((u.pm * 256 + 128 + R[i]) * K + C[i] * 2); }
    }
};
template <bool GATH> struct SchedMoe {
    static constexpr bool GATHER = GATH;
    int G, v, K, NT; const bf16* Bt; const volatile LAS unsigned* cl; const int* rowtok; const LAS unsigned short* lidx;
    __device__ __forceinline__ bool next(int i, Unit& u) const {
        int pm, pn, e, q; bool ok;
        if (i < MOE_UT_UNITS) { const volatile LAS unsigned* ut = cl + LW_UT; const unsigned w0 = ut[2 * i], w1 = ut[2 * i + 1];
            ok = (w1 >> 31) != 0u; pm = (int)w0; pn = (int)(w1 & 0xffu); q = (int)((w1 >> 8) & 0xfu); e = (int)((w1 >> 16) & 0xffu); }
        else { Unit t; t.pm = 0; t.pn = 0; t.q = 0; t.idx = 0; t.e = u.e; ok = next_walk(i, t, i > 0); pm = t.pm; pn = t.pn; e = t.e; q = t.q; }
        if (!ok) return false;
        u.pm = pm; u.pn = pn; u.e = e; u.q = q; u.idx = i; return true;
    }
    __device__ __forceinline__ bool next_walk(int i, Unit& u, bool resume) const {
        const int tot = (int)cl[LW_MTS + 32], U = tot * NT, full = (U / G) * G, R = U - full;
        int L = i * G + v, q = 15;
        if (L >= full) {
            const int t = L - full, s = (!GATH && R * 4 <= G) ? 4 : (R * 2 <= G) ? 2 : 1, un = t / s, qq = t - un * s;
            if (un >= R) return false;
            L = full + un; q = s == 1 ? 15 : s == 2 ? (3 << (2 * qq)) : (1 << qq); }
        int mt = L / NT;
        const int pn = L - mt * NT;
        int e;
        if (GATH) { e = resume ? u.e : 0;
            while (e < 31 && (int)cl[LW_MTS + e + 1] <= mt) ++e; }
        else { mt = tot - 1 - mt;
            e = resume ? u.e : 31;
            while (e > 0 && (int)cl[LW_MTS + e] > mt) --e; }
        u.pm = mt; u.pn = pn; u.e = e; u.idx = i; u.q = q; return true;
    }
    __device__ __forceinline__ const char* bbase(const Unit& u) const { return (const char*)Bt + ((size_t)u.e * NT + u.pn) * ((size_t)256 * K); }
    __device__ __forceinline__ void aoff(const Unit& u, const int (&R)[2], const int (&C)[2], unsigned (&v0)[2], unsigned (&v1)[2]) const {
        if (GATH) {
            if (u.idx < MOE_LIDX_UNITS) {
#pragma unroll
                for (int i = 0; i < 2; ++i) { const int t0 = lidx[u.idx * 256 + R[i]], t1 = lidx[u.idx * 256 + 128 + R[i]];
                    v0[i] = (unsigned)(t0 * K + C[i] * 2); v1[i] = (unsigned)(t1 * K + C[i] * 2); }
            } else {
                const int i0 = (u.pm - (int)cl[LW_MTS + u.e]) * 256, cnt = (int)cl[LW_CNT + u.e];
                const int* rt = rowtok + (size_t)u.e * CAP;
#pragma unroll
                for (int i = 0; i < 2; ++i) {
                    int s0 = i0 + R[i], s1 = i0 + 128 + R[i]; s0 = s0 < cnt ? s0 : 0; s1 = s1 < cnt ? s1 : 0;
                    const int t0 = rt[s0], t1 = rt[s1];
                    v0[i] = (unsigned)(t0 * K + C[i] * 2); v1[i] = (unsigned)(t1 * K + C[i] * 2);
                }
                asm volatile("s_waitcnt vmcnt(0)" ::: "memory");
                asm volatile("" : "+v"(v0[0]), "+v"(v0[1]), "+v"(v1[0]), "+v"(v1[1]));
            }
        } else {
#pragma unroll
            for (int i = 0; i < 2; ++i) { v0[i] = (unsigned)((u.pm * 256 + R[i]) * K + C[i] * 2); v1[i] = (unsigned)((u.pm * 256 + 128 + R[i]) * K + C[i] * 2); }
        }
    }
};

__device__ __forceinline__ float softplusf(float x) { return x > 20.f ? x : log1pf(__expf(x)); }

struct EpiIn {
    static constexpr bool PERM = true, F8 = false, BJ8 = false; static constexpr int NSTORES = 0;
    bf16* xraw; float* dt; bf16* sz; bf16* scb; bf16* cu; const float* dt_bias;
    __device__ __forceinline__ int operator()(const f32x4 (&acc)[2][2][4][2], const Unit& u, int wr, int wc, int fr, int fq) const {
        const int row0 = u.pm * 256 + wr * 64 + fr, pn = u.pn, cl = wc * 32 + 8 * fq;
        if (pn <= 4 || pn == 6 || (pn >= 11 && pn <= 14)) {
            bf16* base; int ld;
            if (pn <= 4) { base = xraw + pn * 256; ld = XBCW; } else if (pn == 6) { base = xraw + 1280; ld = XBCW; } else { base = scb + (pn - 11) * 256; ld = 1024; }
#pragma unroll
            for (int ai = 0; ai < 2; ++ai)
#pragma unroll
                for (int m = 0; m < 4; ++m) { bf16* rowp = base + (size_t)(row0 + ai * 128 + m * 16) * ld + cl;
#pragma unroll
                    for (int bj = 0; bj < 2; ++bj) { const f32x4 v0 = acc[ai][bj][m][0], v1 = acc[ai][bj][m][1];
                        u32x4 w; w.x = pk2(v0[0], v0[1]); w.y = pk2(v0[2], v0[3]); w.z = pk2(v1[0], v1[1]); w.w = pk2(v1[2], v1[3]);
                        *(u32x4*)(rowp + bj * 128) = w; } }
            return 16;
        } else if (pn == 5) {
            if (wc == 0) {
                const f32x4 b0 = *(const f32x4*)(dt_bias + 8 * fq), b1 = *(const f32x4*)(dt_bias + 8 * fq + 4);
#pragma unroll
                for (int ai = 0; ai < 2; ++ai)
#pragma unroll
                    for (int m = 0; m < 4; ++m) { float* rowp = dt + (size_t)(row0 + ai * 128 + m * 16) * 32 + 8 * fq;
                        const f32x4 v0 = acc[ai][0][m][0] + b0, v1 = acc[ai][0][m][1] + b1; f32x4 o0, o1;
#pragma unroll
                        for (int j = 0; j < 4; ++j) { o0[j] = softplusf(v0[j]); o1[j] = softplusf(v1[j]); }
                        *(f32x4*)rowp = o0; *(f32x4*)(rowp + 4) = o1; }
                return 16;
            }
            return 0;
        } else if (pn <= 10) {
            bf16* base = sz + (pn - 7) * 256;
#pragma unroll
            for (int ai = 0; ai < 2; ++ai)
#pragma unroll
                for (int m = 0; m < 4; ++m) { bf16* rowp = base + (size_t)(row0 + ai * 128 + m * 16) * 1024 + cl;
#pragma unroll
                    for (int bj = 0; bj < 2; ++bj) { f32x4 v0 = acc[ai][bj][m][0], v1 = acc[ai][bj][m][1];
#pragma unroll
                        for (int j = 0; j < 4; ++j) { v0[j] = fsilu(v0[j]); v1[j] = fsilu(v1[j]); }
                        u32x4 w; w.x = pk2(v0[0], v0[1]); w.y = pk2(v0[2], v0[3]); w.z = pk2(v1[0], v1[1]); w.w = pk2(v1[2], v1[3]);
                        *(u32x4*)(rowp + bj * 128) = w; } }
            return 16;
        } else {
            bf16* base = cu + (pn - 15) * 128;
#pragma unroll
            for (int ai = 0; ai < 2; ++ai)
#pragma unroll
                for (int m = 0; m < 4; ++m) { bf16* rowp = base + (size_t)(row0 + ai * 128 + m * 16) * 1024 + cl;
                    const f32x4 v0 = acc[ai][0][m][0] * acc[ai][1][m][0], v1 = acc[ai][0][m][1] * acc[ai][1][m][1];
                    u32x4 w; w.x = pk2(v0[0], v0[1]); w.y = pk2(v0[2], v0[3]); w.z = pk2(v1[0], v1[1]); w.w = pk2(v1[2], v1[3]);
                    *(u32x4*)rowp = w; }
            return 8;
        }
    }
};
struct EpiOut {
    static constexpr bool PERM = true, F8 = true, BJ8 = false; static constexpr int NSTORES = 0;
    const float* x; bf16* x1b; const float* mod;
    __device__ __forceinline__ int operator()(const f32x4 (&acc)[2][2][4][2], const Unit& u, int wr, int wc, int fr, int fq) const {
        const int row0 = u.pm * 256 + wr * 64 + fr, col0 = u.pn * 256 + wc * 32 + 8 * fq, b = u.pm >> 3;
        f32x4 gv[2][2];
#pragma unroll
        for (int bj = 0; bj < 2; ++bj)
#pragma unroll
            for (int n = 0; n < 2; ++n) gv[bj][n] = *(const f32x4*)(mod + (size_t)b * 6144 + 2048 + col0 + bj * 128 + n * 4) * W8_INV;
#pragma unroll
        for (int ai = 0; ai < 2; ++ai)
#pragma unroll
            for (int m = 0; m < 4; ++m) { const size_t off = (size_t)(row0 + ai * 128 + m * 16) * 1024 + col0;
#pragma unroll
                for (int bj = 0; bj < 2; ++bj) { const f32x4 x0 = *(const f32x4*)(x + off + bj * 128), x1 = *(const f32x4*)(x + off + bj * 128 + 4);
                    const f32x4 v0 = x0 + gv[bj][0] * acc[ai][bj][m][0], v1 = x1 + gv[bj][1] * acc[ai][bj][m][1];
                    u32x4 w; w.x = pk2(v0[0], v0[1]); w.y = pk2(v0[2], v0[3]); w.z = pk2(v1[0], v1[1]); w.w = pk2(v1[2], v1[3]);
                    *(u32x4*)(x1b + off + bj * 128) = w; }
                if (m & 1) asm volatile("" ::: "memory"); }
        return 16;
    }
};
struct EpiGU {
    static constexpr bool PERM = true, F8 = true, BJ8 = false; static constexpr int NSTORES = 8;
    unsigned char* act; const float* bgu;
    static __device__ __forceinline__ f32x2 swiglu2(const f32x2 g, const f32x2 l) {
        f32x2 ga, la; ga[0] = fminf(g[0], 7.f); ga[1] = fminf(g[1], 7.f);
        la[0] = __builtin_amdgcn_fmed3f(l[0], -7.f, 7.f); la[1] = __builtin_amdgcn_fmed3f(l[1], -7.f, 7.f);
        const f32x2 tt = ga * (-1.702f * 1.4426950408889634f);
        f32x2 d; d[0] = __builtin_amdgcn_exp2f(tt[0]); d[1] = __builtin_amdgcn_exp2f(tt[1]);
        d = d + 1.0f;
        f32x2 r; r[0] = __builtin_amdgcn_rcpf(d[0]); r[1] = __builtin_amdgcn_rcpf(d[1]);
        return ga * r * (la + 1.0f);
    }
    __device__ __forceinline__ int operator()(const f32x4 (&acc)[2][2][4][2], const Unit& u, int wr, int wc, int fr, int fq) const {
        const int row0 = u.pm * 256 + wr * 64 + fr, cl = wc * 32 + 8 * fq, ch0 = u.pn * 128 + cl;
        const float* bp = bgu + (size_t)u.e * 2048 + ch0;
        const f32x4 bg0 = *(const f32x4*)bp, bg1 = *(const f32x4*)(bp + 4), bl0 = *(const f32x4*)(bp + 1024), bl1 = *(const f32x4*)(bp + 1028);
#pragma unroll
        for (int ai = 0; ai < 2; ++ai) { if (!((u.q >> (2 * ai)) & 1)) continue;
#pragma unroll
            for (int m = 0; m < 4; ++m) { unsigned char* rowp = act + (size_t)(row0 + ai * 128 + m * 16) * 1024 + ch0;
                const f32x4 g0 = acc[ai][0][m][0] * W8_INV + bg0, g1 = acc[ai][0][m][1] * W8_INV + bg1, l0 = acc[ai][1][m][0] * W8_INV + bl0, l1 = acc[ai][1][m][1] * W8_INV + bl1;
                const f32x2 oa = swiglu2(g0.xy, l0.xy), ob = swiglu2(g0.zw, l0.zw), oc = swiglu2(g1.xy, l1.xy), od = swiglu2(g1.zw, l1.zw);
                u32x2 w; w.x = pk4_fp8(oa[0], oa[1], ob[0], ob[1]); w.y = pk4_fp8(oc[0], oc[1], od[0], od[1]);
                *(u32x2*)rowp = w; } }
        return 8;
    }
};
struct EpiDown {
    static constexpr bool PERM = true, F8 = true, BJ8 = true; static constexpr int NSTORES = 8;
    unsigned char* y; const float* bdn;
    __device__ __forceinline__ int operator()(const f32x4 (&acc)[2][2][4][2], const Unit& u, int wr, int wc, int fr, int fq) const {
        const int row0 = u.pm * 256 + wr * 64 + fr, col0 = u.pn * 256 + wc * 64 + 16 * fq;
        const float* bp = bdn + (size_t)u.e * 1024 + col0;
        const f32x4 b00 = *(const f32x4*)bp, b01 = *(const f32x4*)(bp + 4), b10 = *(const f32x4*)(bp + 8), b11 = *(const f32x4*)(bp + 12);
#pragma unroll
        for (int ai = 0; ai < 2; ++ai) { const int qa = (u.q >> (2 * ai)) & 3; if (!qa) continue;
#pragma unroll
            for (int m = 0; m < 4; ++m) { unsigned char* rowp = y + (size_t)(row0 + ai * 128 + m * 16) * 1024 + col0;
                const f32x4 v00 = acc[ai][0][m][0] * W8_INV + b00, v01 = acc[ai][0][m][1] * W8_INV + b01, v10 = acc[ai][1][m][0] * W8_INV + b10, v11 = acc[ai][1][m][1] * W8_INV + b11;
                u32x4 w; w.x = pk4_fp8(v00[0], v00[1], v00[2], v00[3]); w.y = pk4_fp8(v01[0], v01[1], v01[2], v01[3]); w.z = pk4_fp8(v10[0], v10[1], v10[2], v10[3]); w.w = pk4_fp8(v11[0], v11[1], v11[2], v11[3]);
                if (qa == 3) *(u32x4*)rowp = w;
                else if (qa == 1) *(u32x2*)rowp = (u32x2){w.x, w.y};
                else *(u32x2*)(rowp + 8) = (u32x2){w.z, w.w}; } }
        return 8;
    }
};

template <class Sched> __device__ __forceinline__ void build_unit_table(Frame& F, const Sched& S) {
    if (F.tid < MOE_UT_UNITS) { Unit u; u.pm = 0; u.pn = 0; u.e = 0; u.q = 0; u.idx = 0; const bool ok = S.next_walk(F.tid, u, false);
        F.cl[LW_UT + 2 * F.tid] = (unsigned)u.pm; F.cl[LW_UT + 2 * F.tid + 1] = (unsigned)u.pn | ((unsigned)u.q << 8) | ((unsigned)u.e << 16) | (ok ? 0x80000000u : 0u); }
    __syncthreads();
}
template <class Sched> __device__ __forceinline__ void preload_row_indices(Frame& F, const Sched& S) {
    LAS unsigned short* li = (LAS unsigned short*)(F.lds + LDS_IDX_OFF);
    const int lane = F.lane, w = F.wave;
    u32x4 v[4]; int cn[4]; bool ok[4];
#pragma unroll
    for (int j = 0; j < 4; ++j) { const int i = w + 8 * j; Unit u; u.e = 0; u.pm = 0; u.pn = 0; u.q = 0; u.idx = 0;
        ok[j] = (i < MOE_LIDX_UNITS) && S.next(i, u); cn[j] = 0; v[j] = (u32x4){0u, 0u, 0u, 0u};
        if (ok[j]) { const int i0 = (u.pm - (int)F.cl[LW_MTS + u.e]) * 256; cn[j] = (int)F.cl[LW_CNT + u.e] - i0 - 4 * lane;
            v[j] = *(const u32x4*)(S.rowtok + (size_t)u.e * CAP + i0 + 4 * lane); } }
#pragma unroll
    for (int j = 0; j < 4; ++j) if (ok[j]) { const int i = w + 8 * j;
        const unsigned t0 = cn[j] > 0 ? v[j].x : 0u, t1 = cn[j] > 1 ? v[j].y : 0u, t2 = cn[j] > 2 ? v[j].z : 0u, t3 = cn[j] > 3 ? v[j].w : 0u;
        u32x2 o; o.x = (t0 & 0xffffu) | (t1 << 16); o.y = (t2 & 0xffffu) | (t3 << 16);
        *(LAS u32x2*)(li + i * 256 + 4 * lane) = o; }
    __syncthreads();
}
__device__ __forceinline__ void p0_item(const float* W, int ldw, int K, int k0, int n0, bf16* WT, int drow0, const float* kscale, LAS float* scr, int lane) {
#pragma unroll 8
    for (int i = 0; i < 32; ++i) { const int kk = 2 * i + (lane >> 5); float w = W[(size_t)(k0 + kk) * ldw + n0 + (lane & 31)]; if (kscale) w *= kscale[k0 + kk]; scr[kk * 33 + (lane & 31)] = w; }
    LDS_WAIT(); asm volatile("" ::: "memory");
    const int c = lane & 7;
#pragma unroll
    for (int j = 0; j < 4; ++j) { const int n = (lane >> 3) + 8 * j; const LAS float* s = scr + (8 * c) * 33 + n;
        u32x4 o; o.x = pk2(s[0 * 33], s[1 * 33]); o.y = pk2(s[2 * 33], s[3 * 33]); o.z = pk2(s[4 * 33], s[5 * 33]); o.w = pk2(s[6 * 33], s[7 * 33]);
        *(u32x4*)(WT + (size_t)(drow0 + n) * K + k0 + 8 * c) = o; }
    LDS_WAIT(); asm volatile("" ::: "memory");
}
__device__ __forceinline__ int win_drow(int n) {
    if (n < X0) return (7 + (n >> 8)) * 256 + (n & 255);
    if (n < B0) return n - X0;
    if (n < C0) return 4 * 256 + (n - B0);
    if (n < DT0) return 6 * 256 + (n - C0);
    if (n < SC0) return 5 * 256 + (n - DT0);
    n -= SC0;
    if (n < 1024) return (11 + (n >> 8)) * 256 + (n & 255);
    if (n < 2048) { n -= 1024; return (15 + (n >> 7)) * 256 + (n & 127); }
    n -= 2048; return (15 + (n >> 7)) * 256 + 128 + (n & 127);
}
__device__ __forceinline__ void phase0(Frame& F) {
    float* mod = (float*)(F.ws + WS_MOD);
    for (int it = F.vcu; it < 192; it += F.G) {
        typedef float f32x16 __attribute__((ext_vector_type(16)));
        LAS float* sc = (LAS float*)F.lds;
        LAS float* red = (LAS float*)(F.lds + 69760);
        const int lane = F.lane, w = F.wave, n0 = it * 32, r = lane & 31, kh = lane >> 5;
        float cv[34];
#pragma unroll
        for (int q = 0; q < 34; ++q) { const int i = F.tid + 512 * q, rr = i >> 10, k = i & 1023; cv[q] = (rr < 16) ? F.c[rr * 1024 + k] : F.c_ctx[k]; }
        float wl[64];
        const float* wbase = F.w_mod + (size_t)(128 * w) * 6144 + n0; const int loff = kh * 6144 + r;
#pragma unroll
        for (int q = 0; q < 64; ++q) wl[q] = (wbase + (size_t)q * 12288)[loff];
#pragma unroll
        for (int q = 0; q < 34; ++q) { const int i = F.tid + 512 * q; sc[(i >> 10) * 1025 + (i & 1023)] = fsilu(cv[q]); }
        __syncthreads();
        f32x16 acc;
#pragma unroll
        for (int e = 0; e < 16; ++e) acc[e] = 0.f;
        const LAS float* ap = sc + (r < 17 ? r : 0) * 1025 + 128 * w + kh;
#pragma unroll
        for (int q = 0; q < 64; ++q) { const float av = r < 17 ? ap[2 * q] : 0.f; acc = __builtin_amdgcn_mfma_f32_32x32x2f32(av, wl[q], acc, 0, 0, 0); }
#pragma unroll
        for (int reg = 0; reg < 8; ++reg) red[(w * 17 + (reg & 3) + 8 * (reg >> 2) + 4 * kh) * 32 + r] = acc[reg];
        if (kh == 0) red[(w * 17 + 16) * 32 + r] = acc[8];
        __syncthreads();
        for (int o = F.tid; o < 17 * 32; o += 512) { const int rr = o >> 5, cc = o & 31; float sm = F.b_mod[n0 + cc];
            for (int g = 0; g < 8; ++g) sm += red[(g * 17 + rr) * 32 + cc];
            mod[(size_t)rr * 6144 + n0 + cc] = sm; }
        __syncthreads();
    }
}
__device__ __forceinline__ void phase0_copies(Frame& F, const int item_lo, const int item_hi) {
    const int gw = F.vcu * NWAVES + F.wave, NGW = F.G * NWAVES, lane = F.lane;
    constexpr int I_IN = 16 * 177, I_OUT = 32 * 32;
    bf16* win = (bf16*)(F.ws + WS_WIN); bf16* wout = (bf16*)(F.ws + WS_WOUT);
    for (int it = item_lo + gw; it < item_hi; it += NGW) {
        const float* src; int ldw, K; bf16* dst = nullptr; unsigned char* dst8 = nullptr; const float* ksc = nullptr;
        if (it < I_IN) { const int kb = it / 177, nb = it % 177; ldw = IN_W; K = 1024; src = F.w_in + (size_t)(kb * 64) * IN_W + nb * 32; dst = win + (size_t)win_drow(nb * 32) * 1024 + kb * 64; }
        else { const int r = it - I_IN, kb = r >> 5, nb = r & 31; ldw = 1024; K = 2048; src = F.w_out + (size_t)(kb * 64) * 1024 + nb * 32; dst8 = (unsigned char*)wout + (size_t)(nb * 32) * 2048 + kb * 64; if (kb < 16) ksc = F.ssd_norm_g + kb * 64; }
        const int lo = (lane >> 3) * 8 * ldw + (lane & 7) * 4;
        f32x4 wr_[8];
#pragma unroll
        for (int e = 0; e < 8; ++e) wr_[e] = *(const f32x4*)(src + (size_t)e * ldw + lo);
        if (ksc) {
#pragma unroll
            for (int e = 0; e < 8; ++e) wr_[e] = wr_[e] * ksc[(lane >> 3) * 8 + e]; }
        if (dst8) {
            unsigned char* dl = dst8 + (size_t)((lane & 7) * 4) * K + (lane >> 3) * 8;
#pragma unroll
            for (int c = 0; c < 4; ++c) { u32x2 o; o.x = pk4_fp8(wr_[0][c] * W8_SCALE, wr_[1][c] * W8_SCALE, wr_[2][c] * W8_SCALE, wr_[3][c] * W8_SCALE);
                o.y = pk4_fp8(wr_[4][c] * W8_SCALE, wr_[5][c] * W8_SCALE, wr_[6][c] * W8_SCALE, wr_[7][c] * W8_SCALE);
                *(u32x2*)(dl + (size_t)c * K) = o; }
        } else {
            bf16* dl = dst + (size_t)((lane & 7) * 4) * K + (lane >> 3) * 8;
#pragma unroll
            for (int c = 0; c < 4; ++c) { u32x4 o; o.x = pk2(wr_[0][c], wr_[1][c]); o.y = pk2(wr_[2][c], wr_[3][c]); o.z = pk2(wr_[4][c], wr_[5][c]); o.w = pk2(wr_[6][c], wr_[7][c]);
                *(u32x4*)(dl + (size_t)c * K) = o; }
        }
    }
}

__device__ __forceinline__ void phase1_range(const Frame& F, int& rbeg, int& rend) {
    const int gw = F.vcu * NWAVES + F.wave, NGW = F.G * NWAVES, per = (TT + NGW - 1) / NGW;
    rbeg = gw * per; rend = (rbeg + per < TT) ? rbeg + per : TT;
}
__device__ __forceinline__ void phase1_load(const Frame& F, int row0, int rend, f32x4 (&v)[3][4]) {
#pragma unroll
    for (int u = 0; u < 3; ++u) { const int row = row0 + u; if (row < rend) { const float* src = row < TL ? F.x + (size_t)row * 1024 : F.ctx + (size_t)(row - TL) * 1024;
#pragma unroll
        for (int j = 0; j < 4; ++j) v[u][j] = *(const f32x4*)(src + 4 * F.lane + 256 * j); } }
}
__device__ __forceinline__ void phase1(Frame& F, bool pre, f32x4 (&vpre)[3][4]) {
    const float* mod = (const float*)(F.ws + WS_MOD); bf16* hx = (bf16*)(F.ws + WS_HX);
    const int gw = F.vcu * NWAVES + F.wave, NGW = F.G * NWAVES, per = (TT + NGW - 1) / NGW;
    const int rbeg = gw * per, rend = (rbeg + per < TT) ? rbeg + per : TT;
    f32x4 mulv[4], shv[4]; int curb = -1;
    for (int row0 = rbeg; row0 < rend; row0 += 3) {
        f32x4 v[3][4];
        if (pre && row0 == rbeg) {
#pragma unroll
            for (int u = 0; u < 3; ++u)
#pragma unroll
                for (int j = 0; j < 4; ++j) v[u][j] = vpre[u][j];
        } else phase1_load(F, row0, rend, v);
#pragma unroll
        for (int u = 0; u < 3; ++u) { const int row = row0 + u; if (row < rend) {
            const int mb = row < TL ? (row >> 11) : 16;
            if (mb != curb) { curb = mb; const float* shift = mod + (size_t)mb * 6144, *scale = shift + 1024;
#pragma unroll
                for (int j = 0; j < 4; ++j) { const int c = 4 * F.lane + 256 * j; mulv[j] = *(const f32x4*)(F.norm1_g + c) * (*(const f32x4*)(scale + c) + 1.0f); shv[j] = *(const f32x4*)(shift + c); } }
            float s = 0.f;
#pragma unroll
            for (int j = 0; j < 4; ++j) s += (v[u][j][0] * v[u][j][0] + v[u][j][1] * v[u][j][1]) + (v[u][j][2] * v[u][j][2] + v[u][j][3] * v[u][j][3]);
            const float rs = 1.0f / sqrtf(wave_sum(s) * (1.f / 1024.f) + NORM_EPS);
#pragma unroll
            for (int j = 0; j < 4; ++j) { const int c = 4 * F.lane + 256 * j;
                const f32x4 o = v[u][j] * rs * mulv[j] + shv[j];
                u32x2 w; w.x = pk2(o[0], o[1]); w.y = pk2(o[2], o[3]);
                *(u32x2*)(hx + (size_t)row * 1024 + c) = w; } } }
    }
}

__device__ __forceinline__ void unpack8(const u32x4 w, float (&f)[8]) { f[0] = bflo(w.x); f[1] = bfhi(w.x); f[2] = bflo(w.y); f[3] = bfhi(w.y); f[4] = bflo(w.z); f[5] = bfhi(w.z); f[6] = bflo(w.w); f[7] = bfhi(w.w); }
__device__ __forceinline__ void conv_load_w(const Frame& F, float (&w0)[8], float (&w1)[8], float (&w2)[8], float (&bb)[8]) {
    const int c0 = ((F.tid < 384 ? F.tid : 0) % 192) * 8;
#pragma unroll
    for (int e = 0; e < 8; ++e) { w0[e] = F.conv_w[c0 + e]; w1[e] = F.conv_w[XBCW + c0 + e]; w2[e] = F.conv_w[2 * XBCW + c0 + e]; bb[e] = F.conv_b[c0 + e]; }
}
__device__ __forceinline__ void phase_conv(Frame& F, const float (&w0)[8], const float (&w1)[8], const float (&w2)[8], const float (&bb)[8]) {
    const bf16* xraw = (const bf16*)(F.ws + WS_XRAW); bf16* xbc = (bf16*)(F.ws + WS_XBC);
    if (F.tid >= 384) return;
    const int cp = F.tid % 192, rs = F.tid / 192, c0 = cp * 8;
    const bool rebal = F.G == 256;
    const int nit = rebal ? (F.vcu < 224 ? 4 : 8) : (TT / 32 - F.vcu + F.G - 1) / F.G;
    for (int jt = 0; jt < nit; ++jt) {
        const int it = rebal ? (F.vcu < 224 ? F.vcu + 224 * jt : 896 + (F.vcu - 224) * 8 + jt) : F.vcu + jt * F.G;
        const int r0 = it * 32 + rs * 16;
        const bool isctx = r0 >= TL;
        if (isctx && c0 >= 1280) continue;
        const int L = isctx ? CTXL : SEQ, t0 = isctx ? ((r0 - TL) & (CTXL - 1)) : (r0 & (SEQ - 1));
        const u32x4 zero = (u32x4){0u, 0u, 0u, 0u};
        u32x4 rw[18];
#pragma unroll
        for (int i = 0; i < 18; ++i) rw[i] = (t0 + i - 1 >= 0 && t0 + i - 1 < L) ? *(const u32x4*)(xraw + (size_t)(r0 + i - 1) * XBCW + c0) : zero;
#pragma unroll
        for (int i = 0; i < 16; ++i) {
            float a[8], b[8], c[8], o[8]; unpack8(rw[i], a); unpack8(rw[i + 1], b); unpack8(rw[i + 2], c);
#pragma unroll
            for (int e = 0; e < 8; ++e) o[e] = fsilu(w0[e] * a[e] + w1[e] * b[e] + w2[e] * c[e] + bb[e]);
            u32x4 w; w.x = pk2(o[0], o[1]); w.y = pk2(o[2], o[3]); w.z = pk2(o[4], o[5]); w.w = pk2(o[6], o[7]);
            *(u32x4*)(xbc + (size_t)(r0 + i) * XBCW + c0) = w;
        }
    }
}

namespace ssd {
constexpr int LDC = 136, LDJ = 72;
constexpr int S_CC = 0, S_BC = 17408, S_X = 34816, S_XW = 44032, S_G = 53248, S_HB = 62464, HS = 45056;
constexpr int S_SC = 124928, SCS = 2048;
__device__ __forceinline__ bf16x8 ldfrag(const LAS unsigned char* base, int row, int ld, int k) { return *(const LAS bf16x8*)(base + (size_t)(row * ld + k) * 2); }
typedef short v4i16_t __attribute__((ext_vector_type(4)));
__device__ __forceinline__ bf16x8 ldfrag_tr(const LAS unsigned char* base, int ld, int k0, int c0, int lane) {
    const int g = lane >> 4, q = (lane & 15) >> 2, p = lane & 3;
    const LAS unsigned char* a = base + (size_t)((k0 + 8 * g + q) * ld + c0 + 4 * p) * 2;
    const v4i16_t lo = __builtin_amdgcn_ds_read_tr16_b64_v4i16((LAS v4i16_t*)a);
    const v4i16_t hi = __builtin_amdgcn_ds_read_tr16_b64_v4i16((LAS v4i16_t*)(a + (size_t)4 * ld * 2));
    return __builtin_shufflevector(lo, hi, 0, 1, 2, 3, 4, 5, 6, 7);
}
}
__device__ __forceinline__ int ssd_rowbase(int b, int dir, int s) {
    return s < 4 ? TL + b * CTXL + (dir ? (3 - s) : s) * 64 : b * SEQ + (dir ? (35 - s) : (s - 4)) * 64;
}
#define SSD_LOADS(sidx) do { const int rb_ = ssd_rowbase(b, dir, (sidx)); const bool ctx_ = (sidx) < 4; \
    const char* rbp_ = (const char*)xbc + (size_t)rb_ * (XBCW * 2) + (size_t)((1024 + g * 128) * 2);        \
    _Pragma("unroll") for (int q2 = 0; q2 < 2; ++q2) { \
        bR[q2] = *(const u32x4*)(rbp_ + (bcoff + (unsigned)(q2 * 32 * XBCW * 2))); cR[q2] = ctx_ ? (u32x4){0u, 0u, 0u, 0u} : *(const u32x4*)(rbp_ + (bcoff + (unsigned)(q2 * 32 * XBCW * 2 + 512))); } \
    { const char* xp_ = (const char*)xbc + (size_t)rb_ * (XBCW * 2) + (size_t)(hA * 128); xR[0] = *(const u32x4*)(xp_ + xoff); xR[1] = *(const u32x4*)(xp_ + (xoff + 128u)); } \
    } while (0)
#define SSD_SCAN(dtj_, par_) do { const int j = dir ? (63 - lane) : lane; float v = (dtj_) * aw; \
    _Pragma("unroll") for (int o = 1; o < 64; o <<= 1) { const float t = __shfl_up(v, o); v += (lane >= o) ? t : 0.f; } \
    const float total = __shfl(v, 63); \
    scw[(par_) * 64 + j] = v; scw[128 + (par_) * 64 + j] = (dtj_); scw[256 + (par_) * 64 + j] = __expf(total - v) * (dtj_); if (lane == 0) scw[384 + (par_)] = total; } while (0)
constexpr int WC_TILES_GU = 32 * 16 * 64, WC_TILES = WC_TILES_GU + 32 * 16 * 32;
__device__ __forceinline__ void wc_tile_base(const Frame& F, int T, const float*& src, int& ldw, unsigned char*& dst) {
    if (T < WC_TILES_GU) { const int e = T >> 10, q = T & 1023, kb = q >> 6, nb = q & 63, n0 = nb * 32;
        const int drow0 = n0 < 1024 ? (n0 >> 7) * 256 + (n0 & 127) : ((n0 - 1024) >> 7) * 256 + 128 + ((n0 - 1024) & 127);
        ldw = 2048; src = F.w_gu + (size_t)e * 1024 * 2048 + (size_t)(kb * 64) * 2048 + n0;
        dst = (unsigned char*)(F.ws + WS_WGU) + (size_t)e * 2048 * 1024 + (size_t)drow0 * 1024 + kb * 64; }
    else { const int T2 = T - WC_TILES_GU, e = T2 >> 9, q = T2 & 511, kb = q >> 5, nb = q & 31, n0 = nb * 32;
        ldw = 1024; src = F.w_dn + (size_t)e * 1024 * 1024 + (size_t)(kb * 64) * 1024 + n0;
        dst = (unsigned char*)(F.ws + WS_WDN) + (size_t)e * 1024 * 1024 + (size_t)n0 * 1024 + kb * 64; }
}
#define WC_LOAD(T_) do { const float* src_; int ldw_; unsigned char* dst_; wc_tile_base(F, (T_), src_, ldw_, dst_); \
    const int lo_ = (lane >> 3) * 8 * ldw_ + (lane & 7) * 4; \
    _Pragma("unroll") for (int e = 0; e < 8; ++e) wR[e] = *(const f32x4*)((src_ + (size_t)e * ldw_) + lo_); } while (0)
#define WC_STORE(T_) do { const float* src_; int ldw_; unsigned char* dst_; wc_tile_base(F, (T_), src_, ldw_, dst_); \
    _Pragma("unroll") for (int e = 0; e < 8; ++e) asm volatile("" : "+v"(wR[e])); \
    unsigned char* dl_ = dst_ + ((lane & 7) * 4 * 1024 + (lane >> 3) * 8); \
    _Pragma("unroll") for (int c = 0; c < 4; ++c) { u32x2 o_; o_.x = pk4_fp8(wR[0][c] * W8_SCALE, wR[1][c] * W8_SCALE, wR[2][c] * W8_SCALE, wR[3][c] * W8_SCALE); \
        o_.y = pk4_fp8(wR[4][c] * W8_SCALE, wR[5][c] * W8_SCALE, wR[6][c] * W8_SCALE, wR[7][c] * W8_SCALE); \
        *(u32x2*)(dl_ + c * 1024) = o_; } } while (0)
#define WC_TILE_K(k_) __builtin_amdgcn_readfirstlane((((k_) * F.G + F.vcu) * 8 + w))
#define WC_TILE_OF(cs_) (((cs_) % 3) < 2 ? WC_TILE_K(((cs_) / 3) * 2 + (cs_) % 3) : 0x7fffffff)
__device__ __forceinline__ void phase_ssd(Frame& F) {
    using namespace ssd;
    const bf16* xbc = (const bf16*)(F.ws + WS_XBC); const float* dtb = (const float*)(F.ws + WS_DT); const bf16* szb = (const bf16*)(F.ws + WS_SZ);
    LAS unsigned char* const L0 = F.lds;
    const int tid = F.tid, lane = F.lane, w = F.wave, fr = lane & 15, fq = lane >> 4;
    LAS float* scw = (LAS float*)(L0 + S_SC + (w & 1) * SCS);
    f32x4 wR[8]; int cstep = 0;
    int Tpend = WC_TILE_OF(cstep);
    if (Tpend < WC_TILES) { WC_LOAD(Tpend); }
    for (int it = F.vcu; it < 256; it += F.G) {
        const int b = it >> 4, g = (it >> 3) & 1, hp = (it >> 1) & 3, dir = it & 1, hA = g * 8 + hp * 2;
        const float aw = -__expf(F.a_log[dir * 16 + hA + (w & 1)]);
        const int dtcolw = dir * 16 + hA + (w & 1);
        bf16* ydir = (bf16*)(F.ws + (dir ? WS_YB : WS_YF));
        f32x4 Hacc[2][4];
#pragma unroll
        for (int hd = 0; hd < 2; ++hd)
#pragma unroll
            for (int tp = 0; tp < 4; ++tp) Hacc[hd][tp] = (f32x4){0.f, 0.f, 0.f, 0.f};
        u32x4 cR[2], bR[2], xR[2];
        const unsigned bcoff = (unsigned)(((tid >> 4) * XBCW + (tid & 15) * 8) * 2), xoff = (unsigned)(((tid >> 3) * XBCW + (tid & 7) * 8) * 2);
        const float dsk0 = dir ? 0.f : F.ssd_d[hA], dsk1 = dir ? 0.f : F.ssd_d[hA + 1];
        if (w < 2) { const int j = dir ? (63 - lane) : lane; const float d0 = dtb[(size_t)(ssd_rowbase(b, dir, 0) + j) * 32 + dtcolw]; SSD_SCAN(d0, 0); }
        SSD_LOADS(0);
        __syncthreads();
        for (int s = 0; s < 36; ++s) {
            const bool isctx = s < 4; const int par = s & 1;
            const int rowbase = ssd_rowbase(b, dir, s);
            unsigned lb = 0u; asm volatile("" : "+s"(lb));
            LAS unsigned char* const L = L0 + lb;
#pragma unroll
            for (int q2 = 0; q2 < 2; ++q2) asm volatile("" : "+v"(bR[q2]), "+v"(cR[q2]));
            asm volatile("" : "+v"(xR[0]), "+v"(xR[1]));
            u32x2 zc00 = (u32x2){0u, 0u}, zc01 = zc00, zc10 = zc00, zc11 = zc00;
#pragma unroll
            for (int q2 = 0; q2 < 2; ++q2) { const int q = tid + 512 * q2, row = q >> 4, n8 = q & 15;
                *(LAS u32x4*)(L + S_BC + (size_t)(row * LDC + n8 * 8) * 2) = bR[q2];
                *(LAS u32x4*)(L + S_CC + (size_t)(row * LDC + n8 * 8) * 2) = cR[q2]; }
#pragma unroll
            for (int hd = 0; hd < 2; ++hd) { const int row = tid >> 3, p8 = tid & 7;
                *(LAS u32x4*)(L + hd * HS + S_X + (size_t)(row * LDJ + p8 * 8) * 2) = xR[hd];
                float f[8]; unpack8(xR[hd], f); const float wj = ((const LAS float*)(L + S_SC + hd * SCS))[256 + par * 64 + row];
                u32x4 o; o.x = pk2(f[0] * wj, f[1] * wj); o.y = pk2(f[2] * wj, f[3] * wj); o.z = pk2(f[4] * wj, f[5] * wj); o.w = pk2(f[6] * wj, f[7] * wj);
                *(LAS u32x4*)(L + hd * HS + S_XW + (size_t)(row * LDJ + p8 * 8) * 2) = o; }
            __syncthreads();
            if (Tpend < WC_TILES) { WC_STORE(Tpend); }
            float dnext = 0.f;
            if (s + 1 < 36) {
                if (w < 2) { const int j = dir ? (63 - lane) : lane; dnext = dtb[(size_t)(ssd_rowbase(b, dir, s + 1) + j) * 32 + dtcolw]; }
                SSD_LOADS(s + 1);
            }
            ++cstep; Tpend = WC_TILE_OF(cstep);
            if (Tpend < WC_TILES) { WC_LOAD(Tpend); }
            if (!isctx) {
                {
                    const int ti = w & 3, tj0 = w >> 2, tj1 = tj0 + 2;
                    const bool need0 = dir ? (tj0 >= ti) : (tj0 <= ti), need1 = dir ? (tj1 >= ti) : (tj1 <= ti);
                    bf16x8 cf[4], bf0[4], bf1[4];
#pragma unroll
                    for (int k = 0; k < 4; ++k) cf[k] = ldfrag(L + S_CC, 16 * ti + fr, LDC, 32 * k + 8 * fq);
                    if (need0) {
#pragma unroll
                        for (int k = 0; k < 4; ++k) bf0[k] = ldfrag(L + S_BC, 16 * tj0 + fr, LDC, 32 * k + 8 * fq); }
                    if (need1) {
#pragma unroll
                        for (int k = 0; k < 4; ++k) bf1[k] = ldfrag(L + S_BC, 16 * tj1 + fr, LDC, 32 * k + 8 * fq); }
                    f32x4 a0 = (f32x4){0.f, 0.f, 0.f, 0.f}, a1 = (f32x4){0.f, 0.f, 0.f, 0.f};
                    if (need0) {
#pragma unroll
                        for (int k = 0; k < 4; ++k) a0 = __builtin_amdgcn_mfma_f32_16x16x32_bf16(bf0[k], cf[k], a0, 0, 0, 0); }
                    if (need1) {
#pragma unroll
                        for (int k = 0; k < 4; ++k) a1 = __builtin_amdgcn_mfma_f32_16x16x32_bf16(bf1[k], cf[k], a1, 0, 0, 0); }
                    const int i = 16 * ti + fr;
#pragma unroll
                    for (int hd = 0; hd < 2; ++hd) {
                        const LAS float* sc = (const LAS float*)(L + S_SC + hd * SCS);
                        const float csi = sc[par * 64 + i];
                        const f32x4 csj0 = *(const LAS f32x4*)(sc + par * 64 + 16 * tj0 + 4 * fq), csj1 = *(const LAS f32x4*)(sc + par * 64 + 16 * tj1 + 4 * fq);
                        const f32x4 dtj0 = *(const LAS f32x4*)(sc + 128 + par * 64 + 16 * tj0 + 4 * fq), dtj1 = *(const LAS f32x4*)(sc + 128 + par * 64 + 16 * tj1 + 4 * fq);
                        float g0[4], g1[4];
#pragma unroll
                        for (int r = 0; r < 4; ++r) {
                            const int j0 = 16 * tj0 + 4 * fq + r, j1 = 16 * tj1 + 4 * fq + r;
                            const bool ok0 = dir ? (j0 >= i) : (j0 <= i), ok1 = dir ? (j1 >= i) : (j1 <= i);
                            g0[r] = ok0 ? a0[r] * __expf(csi - csj0[r]) * dtj0[r] : 0.f;
                            g1[r] = ok1 ? a1[r] * __expf(csi - csj1[r]) * dtj1[r] : 0.f; }
                        u32x2 o0, o1; o0.x = pk2(g0[0], g0[1]); o0.y = pk2(g0[2], g0[3]); o1.x = pk2(g1[0], g1[1]); o1.y = pk2(g1[2], g1[3]);
                        *(LAS u32x2*)(L + hd * HS + S_G + (size_t)(i * LDJ + 16 * tj0 + 4 * fq) * 2) = o0;
                        *(LAS u32x2*)(L + hd * HS + S_G + (size_t)(i * LDJ + 16 * tj1 + 4 * fq) * 2) = o1;
                    }
                }
                __syncthreads();
                { const char* zp_ = (const char*)szb + (size_t)rowbase * 2048 + (size_t)(hA * 128);
                    const unsigned zoff = (unsigned)(((16 * (w & 3) + fr) * 1024 + 4 * fq + 16 * (w >> 2)) * 2);
                    zc00 = *(const u32x2*)(zp_ + zoff); zc01 = *(const u32x2*)(zp_ + (zoff + 64u)); zc10 = *(const u32x2*)(zp_ + (zoff + 128u)); zc11 = *(const u32x2*)(zp_ + (zoff + 192u)); }
            }
            if (w < 2 && s + 1 < 36) { SSD_SCAN(dnext, par ^ 1); }
            {
                bf16x8 af[2];
#pragma unroll
                for (int k = 0; k < 2; ++k) af[k] = ldfrag_tr(L + S_BC, LDC, 32 * k, 16 * w, lane);
#pragma unroll
                for (int hd = 0; hd < 2; ++hd) {
                    bf16x8 xwf[4][2];
#pragma unroll
                    for (int k = 0; k < 2; ++k)
#pragma unroll
                        for (int tp = 0; tp < 4; ++tp) xwf[tp][k] = ldfrag_tr(L + hd * HS + S_XW, LDJ, 32 * k, 16 * tp, lane);
                    const float dec = __expf(((const LAS float*)(L + S_SC + hd * SCS))[384 + par]);
#pragma unroll
                    for (int tp = 0; tp < 4; ++tp) { Hacc[hd][tp] = Hacc[hd][tp] * dec;
#pragma unroll
                        for (int k = 0; k < 2; ++k) Hacc[hd][tp] = __builtin_amdgcn_mfma_f32_16x16x32_bf16(af[k], xwf[tp][k], Hacc[hd][tp], 0, 0, 0); }

                }
            }
            if (!isctx) {
                const int ti = w & 3, tp0 = w >> 2, tp1 = tp0 + 2;
                bf16x8 cf[4];
#pragma unroll
                for (int k = 0; k < 4; ++k) cf[k] = ldfrag(L + S_CC, 16 * ti + fr, LDC, 32 * k + 8 * fq);
                const int i = 16 * ti + fr;
#pragma unroll
                for (int hd = 0; hd < 2; ++hd) {
                    const LAS unsigned char* Lh = L + hd * HS;
                    bf16x8 gf[2], h0[4], h1[4];
#pragma unroll
                    for (int k = 0; k < 2; ++k) gf[k] = ldfrag(Lh + S_G, 16 * ti + fr, LDJ, 32 * k + 8 * fq);
#pragma unroll
                    for (int k = 0; k < 4; ++k) { h0[k] = ldfrag(Lh + S_HB, 16 * tp0 + fr, LDC, 32 * k + 8 * fq); h1[k] = ldfrag(Lh + S_HB, 16 * tp1 + fr, LDC, 32 * k + 8 * fq); }
                    const float ei = __expf(((const LAS float*)(L + S_SC + hd * SCS))[par * 64 + i]);
                    f32x4 yd0 = (f32x4){0.f, 0.f, 0.f, 0.f}, yd1 = yd0, yo0 = yd0, yo1 = yd0;
#pragma unroll
                    for (int k = 0; k < 2; ++k) { const bf16x8 xa = ldfrag_tr(Lh + S_X, LDJ, 32 * k, 16 * tp0, lane), xb = ldfrag_tr(Lh + S_X, LDJ, 32 * k, 16 * tp1, lane);
                        yd0 = __builtin_amdgcn_mfma_f32_16x16x32_bf16(xa, gf[k], yd0, 0, 0, 0); yd1 = __builtin_amdgcn_mfma_f32_16x16x32_bf16(xb, gf[k], yd1, 0, 0, 0); }
#pragma unroll
                    for (int k = 0; k < 4; ++k) { yo0 = __builtin_amdgcn_mfma_f32_16x16x32_bf16(h0[k], cf[k], yo0, 0, 0, 0); yo1 = __builtin_amdgcn_mfma_f32_16x16x32_bf16(h1[k], cf[k], yo1, 0, 0, 0); }
                    const u32x2 xq0 = *(const LAS u32x2*)(Lh + S_X + (size_t)(i * LDJ + 16 * tp0 + 4 * fq) * 2), xq1 = *(const LAS u32x2*)(Lh + S_X + (size_t)(i * LDJ + 16 * tp1 + 4 * fq) * 2);
                    const f32x4 xa = (f32x4){bflo(xq0.x), bfhi(xq0.x), bflo(xq0.y), bfhi(xq0.y)}, xb = (f32x4){bflo(xq1.x), bfhi(xq1.x), bflo(xq1.y), bfhi(xq1.y)};
                    const u32x2 zc0 = hd ? zc10 : zc00, zc1 = hd ? zc11 : zc01;
                    const float dsk = hd ? dsk1 : dsk0;
                    const f32x4 za = (f32x4){bflo(zc0.x), bfhi(zc0.x), bflo(zc0.y), bfhi(zc0.y)}, zb = (f32x4){bflo(zc1.x), bfhi(zc1.x), bflo(zc1.y), bfhi(zc1.y)};
                    const f32x4 y0 = (yd0 + yo0 * ei + xa * dsk) * za, y1 = (yd1 + yo1 * ei + xb * dsk) * zb;
                    u32x2 o0, o1; o0.x = pk2(y0[0], y0[1]); o0.y = pk2(y0[2], y0[3]); o1.x = pk2(y1[0], y1[1]); o1.y = pk2(y1[2], y1[3]);
                    char* yp = (char*)ydir + (size_t)rowbase * 2048 + (size_t)((hA + hd) * 128);
                    const unsigned yoff = (unsigned)((i * 1024 + 4 * fq + 16 * tp0) * 2);
                    *(u32x2*)(yp + yoff) = o0; *(u32x2*)(yp + (yoff + 64u)) = o1;
                    asm volatile("" ::: "memory");
                }
            }
            __syncthreads();
#pragma unroll
            for (int hd = 0; hd < 2; ++hd)
#pragma unroll
                for (int tp = 0; tp < 4; ++tp) { u32x2 o; o.x = pk2(Hacc[hd][tp][0], Hacc[hd][tp][1]); o.y = pk2(Hacc[hd][tp][2], Hacc[hd][tp][3]);
                    *(LAS u32x2*)(L + hd * HS + S_HB + (size_t)((16 * tp + fr) * LDC + 16 * w + 4 * fq) * 2) = o; }
        }
        __syncthreads();
    }
    if (Tpend < WC_TILES) { WC_STORE(Tpend); }
    for (int k = ((cstep + 1) / 3) * 2 + ((cstep + 1) % 3 < 2 ? (cstep + 1) % 3 : 2); ; ++k) { const int T = WC_TILE_K(k); if (T >= WC_TILES) break; WC_LOAD(T); WC_STORE(T); }
}

__device__ __forceinline__ void combine_sc(Frame& F, const int part, const int nparts) {
    const bf16* scb = (const bf16*)(F.ws + WS_SCB); const bf16* cu = (const bf16*)(F.ws + WS_CU);
    unsigned char* a2 = (unsigned char*)(F.ws + WS_A2);
    const int c2 = (F.tid & 127) * 8, sub2 = F.tid >> 7;
    float k0[8], k1[8], k2[8];
#pragma unroll
    for (int e = 0; e < 8; ++e) { k0[e] = F.sc_conv_w[c2 + e]; k1[e] = F.sc_conv_w[1024 + c2 + e]; k2[e] = F.sc_conv_w[2048 + c2 + e]; }
    for (int it = F.vcu + part * F.G; it < TL / 64; it += nparts * F.G) {
        const int tb = it * 64;
        for (int i0 = 0; i0 < 16; i0 += 4) {
            const u32x4 zero = (u32x4){0u, 0u, 0u, 0u};
            u32x4 rp[4], rq[4], rn[4], rs_[4];
#pragma unroll
            for (int u = 0; u < 4; ++u) { const int t = tb + sub2 * 16 + i0 + u, tt = t & (SEQ - 1);
                rp[u] = tt >= 64 ? *(const u32x4*)(cu + (size_t)(t - 64) * 1024 + c2) : zero;
                rq[u] = *(const u32x4*)(cu + (size_t)t * 1024 + c2);
                rn[u] = tt + 64 < SEQ ? *(const u32x4*)(cu + (size_t)(t + 64) * 1024 + c2) : zero;
                rs_[u] = *(const u32x4*)(scb + (size_t)t * 1024 + c2); }
#pragma unroll
            for (int u = 0; u < 4; ++u) { const int t = tb + sub2 * 16 + i0 + u;
                float p[8], q[8], n[8], sb[8], o8[8]; unpack8(rp[u], p); unpack8(rq[u], q); unpack8(rn[u], n); unpack8(rs_[u], sb);
#pragma unroll
                for (int e = 0; e < 8; ++e) o8[e] = sb[e] * (k0[e] * p[e] + k1[e] * q[e] + k2[e] * n[e]);
                u32x2 o; o.x = pk4_fp8(o8[0], o8[1], o8[2], o8[3]); o.y = pk4_fp8(o8[4], o8[5], o8[6], o8[7]);
                *(u32x2*)(a2 + (size_t)t * 2048 + 1024 + c2) = o; }
        }
    }
}
__device__ __forceinline__ void combine_ssd(Frame& F) {
    const bf16* yf = (const bf16*)(F.ws + WS_YF); const bf16* yb = (const bf16*)(F.ws + WS_YB);
    unsigned char* a2 = (unsigned char*)(F.ws + WS_A2);
    const int g = F.wave & 1, sub = F.wave >> 1, c = g * 512 + F.lane * 8;
    for (int it = F.vcu; it < TL / 64; it += F.G) {
        const int tb = it * 64;
        for (int i0 = 0; i0 < 16; i0 += 4) {
            u32x4 ra[4], rb[4];
#pragma unroll
            for (int u = 0; u < 4; ++u) { const int t = tb + sub * 16 + i0 + u; ra[u] = *(const u32x4*)(yf + (size_t)t * 1024 + c); rb[u] = *(const u32x4*)(yb + (size_t)t * 1024 + c); }
#pragma unroll
            for (int u = 0; u < 4; ++u) { const int t = tb + sub * 16 + i0 + u;
                float a[8], b2[8], v[8]; float ss = 0.f; unpack8(ra[u], a); unpack8(rb[u], b2);
#pragma unroll
                for (int e = 0; e < 8; ++e) { v[e] = a[e] + b2[e]; ss += v[e] * v[e]; }
                const float rs = 1.0f / sqrtf(wave_sum(ss) * (1.f / 512.f) + NORM_EPS);
                u32x2 o; o.x = pk4_fp8(v[0] * rs, v[1] * rs, v[2] * rs, v[3] * rs); o.y = pk4_fp8(v[4] * rs, v[5] * rs, v[6] * rs, v[7] * rs);
                *(u32x2*)(a2 + (size_t)t * 2048 + c) = o; }
        }
    }
}

__device__ __forceinline__ void route_token(const float (&acc)[32], int tl, int lane, int myexp, float mybias, LAS int* lcnt, LAS int* tinfo) {
            float r16[16], r8[8], r4[4], r2[2], r1;
            { const bool hi = (lane & 32) != 0;
#pragma unroll
              for (int e = 0; e < 16; ++e) { const float send = hi ? acc[e] : acc[e + 16]; const float recv = __shfl_xor(send, 32); r16[e] = (hi ? acc[e + 16] : acc[e]) + recv; } }
            { const bool hi = (lane & 16) != 0;
#pragma unroll
              for (int e = 0; e < 8; ++e) { const float send = hi ? r16[e] : r16[e + 8]; const float recv = __shfl_xor(send, 16); r8[e] = (hi ? r16[e + 8] : r16[e]) + recv; } }
            { const bool hi = (lane & 8) != 0;
#pragma unroll
              for (int e = 0; e < 4; ++e) { const float send = hi ? r8[e] : r8[e + 4]; const float recv = __shfl_xor(send, 8); r4[e] = (hi ? r8[e + 4] : r8[e]) + recv; } }
            { const bool hi = (lane & 4) != 0;
#pragma unroll
              for (int e = 0; e < 2; ++e) { const float send = hi ? r4[e] : r4[e + 2]; const float recv = __shfl_xor(send, 4); r2[e] = (hi ? r4[e + 2] : r4[e]) + recv; } }
            { const bool hi = (lane & 2) != 0; const float send = hi ? r2[0] : r2[1]; const float recv = __shfl_xor(send, 2); r1 = (hi ? r2[1] : r2[0]) + recv; }
            r1 += __shfl_xor(r1, 1);
            float val = r1 + mybias;
            int sel[4]; float sv[4];
#pragma unroll
            for (int kk = 0; kk < 4; ++kk) {
                float bv = val; int bi = myexp;
#pragma unroll
                for (int o = 1; o < 64; o <<= 1) { const float ov = __shfl_xor(bv, o); const int oi = __shfl_xor(bi, o); if (ov > bv || (ov == bv && oi < bi)) { bv = ov; bi = oi; } }
                sel[kk] = bi; sv[kk] = bv; if (myexp == bi) val = -3.0e38f;
            }
            const float p1 = __expf(sv[1] - sv[0]), p2 = __expf(sv[2] - sv[0]), p3 = __expf(sv[3] - sv[0]);
            const float inv = 1.0f / (1.0f + p1 + p2 + p3);
            const float gt[4] = {inv, p1 * inv, p2 * inv, p3 * inv};
            if (lane < 4) {
                const int e = lane == 0 ? sel[0] : lane == 1 ? sel[1] : lane == 2 ? sel[2] : sel[3];
                const float gg = lane == 0 ? gt[0] : lane == 1 ? gt[1] : lane == 2 ? gt[2] : gt[3];
                const int ls = atomicAdd((int*)&lcnt[e], 1);
                tinfo[(tl * 4 + lane) * 3 + 0] = e; tinfo[(tl * 4 + lane) * 3 + 1] = ls; tinfo[(tl * 4 + lane) * 3 + 2] = __float_as_int(gg);
            }
}
__device__ __forceinline__ void router_setup(Frame& F, int blk) {
    const float* mod = (const float*)(F.ws + WS_MOD);
    LAS unsigned char* L = F.lds;
    constexpr int LDW = 1032;
    LAS unsigned short* Wh = (LAS unsigned short*)L;
    LAS unsigned short* Wl = (LAS unsigned short*)(L + 32 * LDW * 2);
    LAS float* mulv = (LAS float*)(L + 132096);
    LAS float* shv = mulv + 1024;
    LAS int* tinfo = (LAS int*)(L + 140288);
    LAS int* lcnt = (LAS int*)(F.cl + 128);
    LAS float* cbv = (LAS float*)(lcnt + 64);
    const int lane = F.lane, w = F.wave;
        const int bb = (blk * 128) >> 11;
        __syncthreads();
        for (int k = F.tid; k < 1024; k += 512) { mulv[k] = F.norm2_g[k] * (1.0f + mod[(size_t)bb * 6144 + 4 * 1024 + k]); shv[k] = mod[(size_t)bb * 6144 + 3 * 1024 + k]; }
        if (F.tid < 32) lcnt[F.tid] = 0;
        __syncthreads();
        { float part[4] = {0.f, 0.f, 0.f, 0.f}; const int e4 = F.tid & 7;
            for (int i = F.tid; i < 8192; i += 512) { const int k = i >> 3; const f32x4 wq = *(const f32x4*)(F.w_router + (size_t)k * 32 + e4 * 4); const float mk = mulv[k], sk = shv[k];
#pragma unroll
                for (int q = 0; q < 4; ++q) { const float wv = wq[q] * mk; const unsigned hi = f2bf(wv); const float lo = wv - bf2f(hi);
                    Wh[(e4 * 4 + q) * LDW + k] = (unsigned short)hi; Wl[(e4 * 4 + q) * LDW + k] = (unsigned short)f2bf(lo); part[q] += sk * wq[q]; } }
#pragma unroll
            for (int q = 0; q < 4; ++q) { part[q] += __shfl_xor(part[q], 8); part[q] += __shfl_xor(part[q], 16); part[q] += __shfl_xor(part[q], 32); }
            if (lane < 8) {
#pragma unroll
                for (int q = 0; q < 4; ++q) ((LAS float*)tinfo)[w * 32 + lane * 4 + q] = part[q]; } }
        __syncthreads();
        if (F.tid < 32) { float sm = F.b_router[F.tid];
            for (int ww = 0; ww < 8; ++ww) sm += ((LAS float*)tinfo)[ww * 32 + F.tid];
            cbv[F.tid] = sm; }
        __syncthreads();
}
__device__ __forceinline__ void phase_router(Frame& F, bool pre) {
    const float* mod = (const float*)(F.ws + WS_MOD); unsigned char* h2 = (unsigned char*)(F.ws + WS_HX);
    int* rowtok = (int*)(F.ws + WS_ROWTOK); int* tokes = (int*)(F.ws + WS_TOKES); float* tokg = (float*)(F.ws + WS_TOKG);
    const bf16* x1b = (const bf16*)(F.ws + WS_X1B);
    LAS unsigned char* L = F.lds;
    constexpr int LDW = 1032;
    LAS unsigned short* Wh = (LAS unsigned short*)L;
    LAS unsigned short* Wl = (LAS unsigned short*)(L + 32 * LDW * 2);
    LAS float* mulv = (LAS float*)(L + 132096);
    LAS float* shv = mulv + 1024;
    LAS int* tinfo = (LAS int*)(L + 140288);
    LAS int* lcnt = (LAS int*)(F.cl + 128);
    LAS int* lbase = lcnt + 32;
    LAS float* cbv = (LAS float*)(lcnt + 64);
    const int lane = F.lane, w = F.wave, c = lane & 15, g = lane >> 4;
    for (int blk = F.vcu; blk < TL / 128; blk += F.G) {
        if (!(pre && blk == F.vcu)) router_setup(F, blk);
        const int tl = w * 16 + c, t = blk * 128 + tl;
        const bf16* xr = x1b + (size_t)t * 1024 + 8 * g;
        f32x4 acc0 = (f32x4){0.f, 0.f, 0.f, 0.f}, acc1 = acc0; float ss = 0.f;
        const LAS unsigned char* wb = (const LAS unsigned char*)Wh + (size_t)(c * LDW + 8 * g) * 2;
#pragma unroll 4
        for (int ks = 0; ks < 32; ++ks) {
            const bf16x8 xb = *(const bf16x8*)(xr + 32 * ks);
            const bf16x8 a0h = *(const LAS bf16x8*)(wb + 64 * ks), a1h = *(const LAS bf16x8*)(wb + 64 * ks + 16 * LDW * 2);
            const bf16x8 a0l = *(const LAS bf16x8*)(wb + 64 * ks + 32 * LDW * 2), a1l = *(const LAS bf16x8*)(wb + 64 * ks + 48 * LDW * 2);
            acc0 = __builtin_amdgcn_mfma_f32_16x16x32_bf16(a0h, xb, acc0, 0, 0, 0); acc1 = __builtin_amdgcn_mfma_f32_16x16x32_bf16(a1h, xb, acc1, 0, 0, 0);
            acc0 = __builtin_amdgcn_mfma_f32_16x16x32_bf16(a0l, xb, acc0, 0, 0, 0); acc1 = __builtin_amdgcn_mfma_f32_16x16x32_bf16(a1l, xb, acc1, 0, 0, 0);
            float xf[8]; unpack8(__builtin_bit_cast(u32x4, xb), xf);
#pragma unroll
            for (int q = 0; q < 8; ++q) ss += xf[q] * xf[q];
        }
        ss += __shfl_xor(ss, 16); ss += __shfl_xor(ss, 32);
        const float rs = 1.0f / sqrtf(ss * (1.f / 1024.f) + NORM_EPS);
        float lv[8]; int li[8];
#pragma unroll
        for (int r = 0; r < 4; ++r) { li[r] = 4 * g + r; li[4 + r] = 16 + 4 * g + r; lv[r] = acc0[r] * rs + cbv[4 * g + r]; lv[4 + r] = acc1[r] * rs + cbv[16 + 4 * g + r]; }
        int sel[4]; float sv[4];
#pragma unroll
        for (int kk = 0; kk < 4; ++kk) {
            float bv = lv[0]; int bi = li[0];
#pragma unroll
            for (int q = 1; q < 8; ++q) if (lv[q] > bv) { bv = lv[q]; bi = li[q]; }
#pragma unroll
            for (int o = 16; o < 64; o <<= 1) { const float ov = __shfl_xor(bv, o); const int oi = __shfl_xor(bi, o); if (ov > bv || (ov == bv && oi < bi)) { bv = ov; bi = oi; } }
            sel[kk] = bi; sv[kk] = bv;
#pragma unroll
            for (int q = 0; q < 8; ++q) if (li[q] == bi) lv[q] = -3.0e38f;
        }
        { const float p1 = __expf(sv[1] - sv[0]), p2 = __expf(sv[2] - sv[0]), p3 = __expf(sv[3] - sv[0]);
          const float inv = 1.0f / (1.0f + p1 + p2 + p3);
          const int e = g == 0 ? sel[0] : g == 1 ? sel[1] : g == 2 ? sel[2] : sel[3];
          const float gg = g == 0 ? inv : g == 1 ? p1 * inv : g == 2 ? p2 * inv : p3 * inv;
          const int ls = atomicAdd((int*)&lcnt[e], 1);
          tinfo[(tl * 4 + g) * 3 + 0] = e; tinfo[(tl * 4 + g) * 3 + 1] = ls; tinfo[(tl * 4 + g) * 3 + 2] = __float_as_int(gg); }
#pragma unroll 4
        for (int ks = 0; ks < 32; ++ks) {
            const bf16x8 xb = *(const bf16x8*)(xr + 32 * ks);
            float xf[8]; unpack8(__builtin_bit_cast(u32x4, xb), xf);
            const f32x4 m0 = *(const LAS f32x4*)(mulv + 32 * ks + 8 * g), m1 = *(const LAS f32x4*)(mulv + 32 * ks + 8 * g + 4), s0 = *(const LAS f32x4*)(shv + 32 * ks + 8 * g), s1 = *(const LAS f32x4*)(shv + 32 * ks + 8 * g + 4);
            u32x2 o; o.x = pk4_fp8(xf[0] * rs * m0[0] + s0[0], xf[1] * rs * m0[1] + s0[1], xf[2] * rs * m0[2] + s0[2], xf[3] * rs * m0[3] + s0[3]);
            o.y = pk4_fp8(xf[4] * rs * m1[0] + s1[0], xf[5] * rs * m1[1] + s1[1], xf[6] * rs * m1[2] + s1[2], xf[7] * rs * m1[3] + s1[3]);
            *(u32x2*)(h2 + (size_t)t * 1024 + 32 * ks + 8 * g) = o;
        }
        __syncthreads();
        if (F.tid < 32) { const int n = lcnt[F.tid]; lbase[F.tid] = (int)__hip_atomic_fetch_add((unsigned*)(F.ctl + CW_ECNT + F.tid), (unsigned)n, RLX_AGENT); }
        __syncthreads();
        { const int tl2 = F.tid >> 2, kk = F.tid & 3, t2 = blk * 128 + tl2;
          const int e = tinfo[(tl2 * 4 + kk) * 3 + 0], ls = tinfo[(tl2 * 4 + kk) * 3 + 1]; const float gg = __int_as_float(tinfo[(tl2 * 4 + kk) * 3 + 2]);
          const int slot = lbase[e] + ls;
          rowtok[(size_t)e * CAP + slot] = t2; tokes[t2 * 4 + kk] = e * CAP + slot; tokg[t2 * 4 + kk] = gg; }
    }
    __syncthreads();
}

__device__ __forceinline__ void build_mt_table(Frame& F) {
    __syncthreads();
    if (F.tid < 64) {
        const int lane = F.lane, e = lane & 31;
        const int c = (int)__hip_atomic_load(F.ctl + CW_ECNT + e, RLX_AGENT);
        const int mtc = (c + 255) >> 8;
        int incl = mtc;
#pragma unroll
        for (int o = 1; o < 32; o <<= 1) { const int t = __shfl_up(incl, o); incl += (lane >= o && lane < 32) ? t : 0; }
        if (lane < 32) { F.cl[LW_CNT + e] = (unsigned)c; F.cl[LW_MTS + e] = (unsigned)(incl - mtc); }
        if (lane == 31) F.cl[LW_MTS + 32] = (unsigned)incl;
    }
    __syncthreads();
}

constexpr int FIN_META_OFF = 131072;
constexpr int FIN_LP = 4;
__device__ __forceinline__ void final_prefetch_lds(Frame& F) {
    const int gw = F.vcu * NWAVES + F.wave, NGW = F.G * NWAVES;
    const char* x1 = (const char*)(F.ws + WS_X1B);
#pragma unroll
    for (int s = 0; s < FIN_LP * 2; ++s) { const int t = gw + (2 + s) * NGW;
        if (t < TL) {
#pragma unroll
            for (int hf = 0; hf < 2; ++hf) __builtin_amdgcn_global_load_lds((const unsigned*)(x1 + (size_t)t * 2048 + hf * 1024 + F.lane * 16), (LAS unsigned*)(F.lds + F.wave * 16384 + s * 2048 + hf * 1024), 16, 0, 0); } }
    if (F.lane < 16) { const int t = gw + F.lane * NGW;
        if (t < TL) { const u32x4 a = *(const u32x4*)((const int*)(F.ws + WS_TOKES) + (size_t)t * 4), b = *(const u32x4*)((const float*)(F.ws + WS_TOKG) + (size_t)t * 4);
            LAS u32x4* mp = (LAS u32x4*)(F.lds + FIN_META_OFF + F.wave * 512 + F.lane * 32); mp[0] = a; mp[1] = b; } }
}
__device__ __forceinline__ void final_load_meta(const Frame& F, int t0, int NGW, int (&es)[2][4], float (&gk)[2][4], u32x4 (&xr)[2][2], const bool from_lds = false, const int lds_off = 0, const bool meta_lds = false, const int meta_tok = 0) {
    const int* tokes = (const int*)(F.ws + WS_TOKES); const float* tokg = (const float*)(F.ws + WS_TOKG); const bf16* x1b = (const bf16*)(F.ws + WS_X1B);
#pragma unroll
    for (int u = 0; u < 2; ++u) { const int t = t0 + u * NGW; if (t < TL) {
        if (meta_lds) { const LAS u32x4* mp = (const LAS u32x4*)(F.lds + FIN_META_OFF + F.wave * 512 + (meta_tok + u) * 32); const u32x4 a = mp[0], b = mp[1];
            es[u][0] = __builtin_amdgcn_readfirstlane((int)a.x); es[u][1] = __builtin_amdgcn_readfirstlane((int)a.y); es[u][2] = __builtin_amdgcn_readfirstlane((int)a.z); es[u][3] = __builtin_amdgcn_readfirstlane((int)a.w);
            gk[u][0] = __uint_as_float(b.x); gk[u][1] = __uint_as_float(b.y); gk[u][2] = __uint_as_float(b.z); gk[u][3] = __uint_as_float(b.w); }
        else {
#pragma unroll
            for (int kk = 0; kk < 4; ++kk) { es[u][kk] = tokes[t * 4 + kk]; gk[u][kk] = tokg[t * 4 + kk]; } }
        if (from_lds) { xr[u][0] = *(const LAS u32x4*)(F.lds + lds_off + u * 2048 + F.lane * 16); xr[u][1] = *(const LAS u32x4*)(F.lds + lds_off + u * 2048 + 1024 + F.lane * 16); }
        else { xr[u][0] = *(const u32x4*)(x1b + (size_t)t * 1024 + F.lane * 8); xr[u][1] = *(const u32x4*)(x1b + (size_t)t * 1024 + 512 + F.lane * 8); } } }
}
__device__ __forceinline__ void phase_final(Frame& F, bool pre, const int (&esP)[2][4], const float (&gkP)[2][4], const u32x4 (&xrP)[2][2]) {
    const float* mod = (const float*)(F.ws + WS_MOD); const unsigned char* yrows = (const unsigned char*)(F.ws + WS_YROWS);
    const int* tokes = (const int*)(F.ws + WS_TOKES); const float* tokg = (const float*)(F.ws + WS_TOKG);
    const int gw = F.vcu * NWAVES + F.wave, NGW = F.G * NWAVES, lane = F.lane;
    const bf16* x1b = (const bf16*)(F.ws + WS_X1B);
    constexpr int FT = 2;
    for (int t0 = gw; t0 < TL; t0 += FT * NGW) {
        u32x2 yr[FT][4][2]; u32x4 xr[FT][2]; float gk[FT][4]; int es[FT][4];
        if (pre && t0 == gw) {
#pragma unroll
            for (int u = 0; u < FT; ++u) { xr[u][0] = xrP[u][0]; xr[u][1] = xrP[u][1];
#pragma unroll
                for (int kk = 0; kk < 4; ++kk) { es[u][kk] = esP[u][kk]; gk[u][kk] = gkP[u][kk]; } }
        } else { const int pi = (t0 - gw) / (FT * NGW); const bool fl = pre && F.G == 256 && pi >= 1 && pi <= FIN_LP;
            final_load_meta(F, t0, NGW, es, gk, xr, fl, F.wave * 16384 + (pi - 1) * 4096, pre && F.G == 256, 2 * pi); }
#pragma unroll
        for (int u = 0; u < FT; ++u) { const int t = t0 + u * NGW; if (t < TL) {
#pragma unroll
            for (int kk = 0; kk < 4; ++kk) { const int e = es[u][kk] >> 15, slot = es[u][kk] & (CAP - 1);
                const size_t pos = (size_t)F.cl[LW_MTS + e] * 256 + slot;
                yr[u][kk][0] = *(const u32x2*)(yrows + pos * 1024 + lane * 8); yr[u][kk][1] = *(const u32x2*)(yrows + pos * 1024 + 512 + lane * 8); } } }
#pragma unroll
        for (int u = 0; u < FT; ++u) { const int t = t0 + u * NGW; if (t < TL) {
            const int b = t >> 11;
            float m[16];
#pragma unroll
            for (int e = 0; e < 16; ++e) m[e] = 0.f;
#pragma unroll
            for (int kk = 0; kk < 4; ++kk) { float y0[8], y1[8]; unpack8_fp8(yr[u][kk][0], y0); unpack8_fp8(yr[u][kk][1], y1);
#pragma unroll
                for (int q = 0; q < 8; ++q) { m[q] += gk[u][kk] * y0[q]; m[8 + q] += gk[u][kk] * y1[q]; } }
            float x2[16]; float ss = 0.f;
#pragma unroll
            for (int hf = 0; hf < 2; ++hf) { const int c = hf * 512 + lane * 8;
                float xv[8]; unpack8(xr[u][hf], xv);
                const f32x4 g0 = *(const f32x4*)(mod + (size_t)b * 6144 + 5 * 1024 + c), g1 = *(const f32x4*)(mod + (size_t)b * 6144 + 5 * 1024 + c + 4);
#pragma unroll
                for (int j = 0; j < 4; ++j) { const float v0 = xv[j] + g0[j] * m[hf * 8 + j], v1 = xv[4 + j] + g1[j] * m[hf * 8 + 4 + j];
                    x2[hf * 8 + j] = v0; x2[hf * 8 + 4 + j] = v1; ss += v0 * v0 + v1 * v1; } }
            const float rs = 1.0f / sqrtf(wave_sum(ss) * (1.f / 1024.f) + NORM_EPS);
#pragma unroll
            for (int hf = 0; hf < 2; ++hf)
#pragma unroll
                for (int q4 = 0; q4 < 2; ++q4) { const int c = hf * 512 + lane * 8 + q4 * 4;
                    const f32x4 fg = *(const f32x4*)(F.final_g + c); f32x4 o;
#pragma unroll
                    for (int j = 0; j < 4; ++j) o[j] = x2[hf * 8 + q4 * 4 + j] * rs * fg[j];
                    *(f32x4*)(F.out + (size_t)t * 1024 + c) = o; } } }
    }
}

constexpr int NPHASE = 11;
__global__ void __launch_bounds__(NWAVES * 64, 2) mk_fwd(Args args) {
    extern __shared__ __attribute__((aligned(16))) unsigned char lds_raw[];
    Frame F;
    F.lds = (LAS unsigned char*)lds_raw;
    F.cl = (volatile LAS unsigned*)(F.lds + CTLDS_OFF);
    F.tid = threadIdx.x; F.lane = F.tid & 63; F.wave = __builtin_amdgcn_readfirstlane(F.tid >> 6);
    F.G = gridDim.x; { const int bx = blockIdx.x; F.vcu = (F.G % 8 == 0) ? (bx % 8) * (F.G / 8) + bx / 8 : bx; }
    F.ws = args.ws; F.ctl = (gu32*)(args.ws + WS_CTL); F.out = args.out;
    F.x = args.in[0]; F.c = args.in[1]; F.ctx = args.in[2]; F.c_ctx = args.in[3]; F.w_mod = args.in[4]; F.b_mod = args.in[5]; F.norm1_g = args.in[6]; F.w_in = args.in[7];
    F.conv_w = args.in[8]; F.conv_b = args.in[9]; F.dt_bias = args.in[10]; F.a_log = args.in[11]; F.ssd_d = args.in[12]; F.ssd_norm_g = args.in[13]; F.sc_conv_w = args.in[14];
    F.w_out = args.in[15]; F.norm2_g = args.in[16]; F.w_router = args.in[17]; F.b_router = args.in[18]; F.w_gu = args.in[19]; F.b_gu = args.in[20]; F.w_dn = args.in[21]; F.b_dn = args.in[22]; F.final_g = args.in[23];
    for (int u = F.tid; u < (LDS_BYTES - CTLDS_OFF) / 4; u += NWAVES * 64) ((LAS unsigned*)(F.lds + CTLDS_OFF))[u] = 0u;
    __syncthreads();
    const int lo = args.ph_lo, hi = args.ph_hi;
    XcdBarrier bar; bar.bar = (unsigned*)(F.ctl + CW_BAR); bar.x = 0; bar.st = nullptr;
    if (hi - lo > 1) bar = xcd_barrier_post((unsigned*)(F.ctl + CW_BAR), F.cl + LW_BARST);
#define IN(k) (lo <= (k) && (k) < hi)
#define SEAM(k) do { if (IN(k) && IN((k) + 1)) xcd_barrier(bar); } while (0)

#define RUNPH(k, body) do { if (IN(k)) { body; if ((PROBE_DOUBLE >> (k)) & 1) { xcd_barrier(bar); body; } SEAM(k); } } while (0)
    f32x4 v1pre[3][4];
    if (IN(0)) { phase0(F); if (!IN(1)) phase0_copies(F, 0, 3856); if (IN(1)) { unsigned role_, gen_; xcd_barrier_arrive(bar, role_, gen_); phase0_copies(F, 0, IN(2) ? 2832 : 3856); { int rb_, re_; phase1_range(F, rb_, re_); phase1_load(F, rb_, re_, v1pre); } xcd_barrier_wait(bar, role_, gen_); } }
    if (IN(1)) { phase1(F, IN(0), v1pre); if (IN(2)) { unsigned role_, gen_; xcd_barrier_arrive(bar, role_, gen_); if (IN(0)) phase0_copies(F, 2832, 3856); xcd_barrier_wait(bar, role_, gen_); } }
#define BODY2 { SchedIn S{F.G, F.vcu, 1024, (const bf16*)(F.ws + WS_WIN)}; \
        EpiIn E{(bf16*)(F.ws + WS_XRAW), (float*)(F.ws + WS_DT), (bf16*)(F.ws + WS_SZ), (bf16*)(F.ws + WS_SCB), (bf16*)(F.ws + WS_CU), F.dt_bias}; \
        pg8::gemm_phase<EpiIn, SchedIn>(F.lds, (const bf16*)(F.ws + WS_HX), 1024, S, E, IN(3) ? 9 : -1, bar, role2_, gen2_); }
    float cw0[8], cw1[8], cw2[8], cbb[8];
    unsigned role2_ = 0u, gen2_ = 0u, rdum_ = 0u, gdum_ = 0u;
    if (IN(2)) { BODY2; if (IN(3)) { conv_load_w(F, cw0, cw1, cw2, cbb); xcd_barrier_wait(bar, role2_, gen2_); } }
    if (IN(3)) { if (!IN(2)) conv_load_w(F, cw0, cw1, cw2, cbb); phase_conv(F, cw0, cw1, cw2, cbb); if (IN(4)) { unsigned role_, gen_; xcd_barrier_arrive(bar, role_, gen_); if (IN(2)) combine_sc(F, 0, 2); xcd_barrier_wait(bar, role_, gen_); } }
    if (IN(4)) { phase_ssd(F); if (IN(5)) { unsigned role_, gen_; xcd_barrier_arrive(bar, role_, gen_); if (IN(2) && IN(3)) combine_sc(F, 1, 2); else combine_sc(F, 0, 1); xcd_barrier_wait(bar, role_, gen_); } }
    unsigned role6_ = 0u, gen6_ = 0u;
    const bool osplit_ = IN(2) && IN(3) && IN(4) && IN(5) && IN(6) && F.G == 256;
    if (IN(5)) { if (!IN(4)) combine_sc(F, 0, 1); combine_ssd(F); if (osplit_) xcd_barrier_arrive(bar, role6_, gen6_); else SEAM(5); }
#define BODY6 { SchedPlain S{F.G, F.vcu, 2048, 4, 512, (const bf16*)(F.ws + WS_WOUT)}; \
        EpiOut E{F.x, (bf16*)(F.ws + WS_X1B), (const float*)(F.ws + WS_MOD)}; \
        pg8::gemm_phase<EpiOut, SchedPlain>(F.lds, (const bf16*)(F.ws + WS_A2), 2048, S, E, -1, bar, role6_, gen6_, osplit_ ? 8 : 0, osplit_ ? 6 : -1); }
    if (IN(6)) { BODY6; if (IN(7)) { unsigned role_, gen_; xcd_barrier_arrive(bar, role_, gen_); router_setup(F, F.vcu); xcd_barrier_wait(bar, role_, gen_); } }
    if (IN(7)) { phase_router(F, IN(6)); SEAM(7); }
#define BODY8 { build_mt_table(F); \
        SchedMoe<true> S{F.G, F.vcu, 1024, 8, (const bf16*)(F.ws + WS_WGU), F.cl, (const int*)(F.ws + WS_ROWTOK), (const LAS unsigned short*)(F.lds + LDS_IDX_OFF)}; \
        build_unit_table(F, S); preload_row_indices(F, S); \
        EpiGU E{(unsigned char*)(F.ws + WS_ACT), F.b_gu}; \
        pg8::gemm_phase<EpiGU, SchedMoe<true>>(F.lds, (const bf16*)(F.ws + WS_HX), 1024, S, E, -1, bar, rdum_, gdum_); }
    if (IN(8)) { BODY8; if (IN(9)) { unsigned role_, gen_; xcd_barrier_arrive(bar, role_, gen_);
        { SchedMoe<false> S9{F.G, F.vcu, 1024, 4, (const bf16*)(F.ws + WS_WDN), F.cl, nullptr, nullptr}; build_unit_table(F, S9); }
        xcd_barrier_wait(bar, role_, gen_); } }
#define BODY9 { if (lo == 9) build_mt_table(F);     \
        SchedMoe<false> S{F.G, F.vcu, 1024, 4, (const bf16*)(F.ws + WS_WDN), F.cl, nullptr, nullptr}; \
        if (lo == 9) build_unit_table(F, S); \
        EpiDown E{(unsigned char*)(F.ws + WS_YROWS), F.b_dn}; \
        pg8::gemm_phase<EpiDown, SchedMoe<false>>(F.lds, (const bf16*)(F.ws + WS_ACT), 1024, S, E, -1, bar, rdum_, gdum_); }
    int fes[2][4]; float fgk[2][4]; u32x4 fxr[2][2];
    if (IN(9)) { BODY9; if (IN(10)) { unsigned role_, gen_; xcd_barrier_arrive(bar, role_, gen_); final_load_meta(F, F.vcu * NWAVES + F.wave, F.G * NWAVES, fes, fgk, fxr); if (F.G == 256) final_prefetch_lds(F); xcd_barrier_wait(bar, role_, gen_); } }
    if (IN(10)) { if (lo == 10) build_mt_table(F); phase_final(F, IN(9), fes, fgk, fxr); }
#undef IN
#undef SEAM
}

extern "C" void kernel_launch(void* const* d_in, const int* in_sizes, int n_in, void* d_out, int out_size, void* d_ws, size_t ws_size, hipStream_t stream) {
    static int grid = 0;
    if (grid == 0) {
        if (n_in != 24 || out_size != TL * D || ws_size < WS_END) { fprintf(stderr, "kernel_launch: unexpected shapes (n_in %d out %d ws %zu); nothing launched\n", n_in, out_size, ws_size); grid = -1; return; }
        int dev = 0, cus = 0;
        if (hipGetDevice(&dev) != hipSuccess || hipDeviceGetAttribute(&cus, hipDeviceAttributeMultiprocessorCount, dev) != hipSuccess) { grid = -1; return; }
        if (hipFuncSetAttribute((const void*)mk_fwd, hipFuncAttributeMaxDynamicSharedMemorySize, LDS_BYTES) != hipSuccess) { fprintf(stderr, "kernel_launch: hipFuncSetAttribute failed\n"); grid = -1; return; }
        int per_cu = 0;
        if (hipOccupancyMaxActiveBlocksPerMultiprocessor(&per_cu, (const void*)mk_fwd, NWAVES * 64, LDS_BYTES) != hipSuccess || per_cu < 1) fprintf(stderr, "kernel_launch: occupancy query says %d\n", per_cu);
        (void)hipGetLastError();
        grid = cus;
    }
    if (grid < 0) return;
    (void)hipMemsetAsync((char*)d_ws + WS_CTL, 0, CTL_ZERO_BYTES, stream);
    Args a{};
    for (int i = 0; i < 24; ++i) a.in[i] = (const float*)d_in[i];
    a.out = (float*)d_out; a.ws = (unsigned char*)d_ws;
#if MK_ONE_LAUNCH
    a.ph_lo = 0; a.ph_hi = NPHASE;
    hipLaunchKernelGGL(mk_fwd, dim3(grid), dim3(NWAVES * 64), LDS_BYTES, stream, a);
#else
    for (int p = 0; p < NPHASE; ++p) { a.ph_lo = p; a.ph_hi = p + 1; hipLaunchKernelGGL(mk_fwd, dim3(grid), dim3(NWAVES * 64), LDS_BYTES, stream, a); }
#endif
}
```
